# Optimizing an MI355X kernel written in HIP

```python
import math
import jax, jax.numpy as jnp
from jax import lax
import numpy as np

D_MODEL = 1024
BATCH = 16
SEQ = 2048
DEPTH = 2

GRID_W = 64
CTX_LEN = 256
N_MIXERS = 4
GROUP_W = D_MODEL // N_MIXERS
D_MIX = N_MIXERS * GROUP_W
LN_EPS = 1e-5
CONF_K = 31
CONF_GROUPS = 4
NA_HEADS = 4
HEAD_DIM = GROUP_W // NA_HEADS
NA_KH = 8
NA_KW = 16
ROPE_BASE = 10000.0
HY_SHORT = 3
HY_BANDS = 16
HY_EMB = 1 + 2 * HY_BANDS
HY_HIDDEN = 64
HY_SIN_FREQ = 1.0
HY_MIN_DECAY = 3.0
HY_MAX_DECAY = 15.0
SSD_HEADS = 4
SSD_HEAD_DIM = GROUP_W // SSD_HEADS
SSD_GROUPS = 2
SSD_STATE = 64
SSD_CONV = 3
SSD_CHUNK = 128
XBC_W = GROUP_W + 2 * SSD_GROUPS * SSD_STATE
IN_COLS = 2 * GROUP_W + 3 * GROUP_W + 3 * GROUP_W + GROUP_W + XBC_W + 2 * SSD_HEADS
PEER_HEADS = 8
PEER_KEYS = 128
PEER_TOPK = 16
PEER_QDIM = 256
N_EXPERTS = PEER_KEYS * PEER_KEYS
PEER_BLOCK = 128

kernel_name = 'hybrid_diffusion_block'


def _standardize(x):
    xf = x.astype(jnp.float32)
    mu = jnp.mean(xf, -1, keepdims=True)
    var = jnp.mean(jnp.square(xf - mu), -1, keepdims=True)
    return (xf - mu) * lax.rsqrt(var + LN_EPS)


def layer_norm(x, g, b):
    return (_standardize(x) * g + b).astype(x.dtype)


def dwconv(x, w):
    K, C = w.shape
    pad = (K - 1) // 2
    return lax.conv_general_dilated(x, w[:, None, :].astype(x.dtype), window_strides=(1,),
                                    padding=[(pad, pad)], dimension_numbers=('NWC', 'WIO', 'NWC'),
                                    feature_group_count=C)


def _split_cols(p):
    sizes = (2 * GROUP_W, 3 * GROUP_W, 3 * GROUP_W, GROUP_W, XBC_W, 2 * SSD_HEADS)
    points = [int(v) for v in np.cumsum(sizes)[:-1]]
    return jnp.split(p, points, axis=-1)


def conformer_conv(p, dw_w, dw_b, n_g, n_b):
    a, gate = jnp.split(p, 2, -1)
    u = a * jax.nn.sigmoid(gate)
    u = dwconv(u, dw_w) + dw_b
    Bsz, L, C = u.shape
    un = _standardize(u.reshape(Bsz, L, CONF_GROUPS, C // CONF_GROUPS)).reshape(Bsz, L, C)
    un = (un * n_g + n_b).astype(u.dtype)
    return jax.nn.silu(un)


def axial_rope(rows, head_dim):
    n_f = head_dim // 4
    inv = ROPE_BASE ** (-jnp.arange(n_f, dtype=jnp.float32) / n_f)
    t = jnp.arange(rows * GRID_W)
    r = (t // GRID_W).astype(jnp.float32)
    col = (t % GRID_W).astype(jnp.float32)
    ang = jnp.concatenate([r[:, None] * inv, col[:, None] * inv], -1)
    return jnp.cos(ang), jnp.sin(ang)


def apply_rope(x, cos, sin):
    x1, x2 = jnp.split(x.astype(jnp.float32), 2, -1)
    c = cos[None, :, None, :]
    s = sin[None, :, None, :]
    return jnp.concatenate([x1 * c - x2 * s, x1 * s + x2 * c], -1).astype(x.dtype)


def neighborhood_attention(q_rot, k_rot, v, q_plain, k_ctx, v_ctx, rpb):
    Bsz, S, H, d = q_rot.shape
    rows = S // GRID_W
    kh = min(NA_KH, rows)
    qg = q_rot.reshape(Bsz, rows, GRID_W, H, d)
    kg = k_rot.reshape(Bsz, rows, GRID_W, H, d)
    vg = v.reshape(Bsz, rows, GRID_W, H, d)
    qpg = q_plain.reshape(Bsz, rows, GRID_W, H, d)
    cq = jnp.arange(GRID_W)
    col_idx = jnp.clip(cq - NA_KW // 2, 0, GRID_W - NA_KW)[:, None] + jnp.arange(NA_KW)[None, :]
    col_bias_idx = col_idx - cq[:, None] + (NA_KW - 1)
    scale = d ** -0.5

    def row_block(r):
        rs = jnp.clip(r - kh // 2, 0, rows - kh)
        kr = lax.dynamic_slice_in_dim(kg, rs, kh, axis=1)[:, :, col_idx]
        vr = lax.dynamic_slice_in_dim(vg, rs, kh, axis=1)[:, :, col_idx]
        qr = lax.dynamic_index_in_dim(qg, r, axis=1, keepdims=False)
        qpr = lax.dynamic_index_in_dim(qpg, r, axis=1, keepdims=False)
        row_bias_idx = rs + jnp.arange(kh) - r + (NA_KH - 1)
        bias = rpb[:, row_bias_idx][:, :, col_bias_idx].transpose(0, 2, 1, 3)
        s_loc = jnp.einsum('bchd,bicjhd->bhcij', qr, kr).astype(jnp.float32) * scale + bias
        s_ctx = jnp.einsum('bchd,bnhd->bhcn', qpr, k_ctx).astype(jnp.float32) * scale
        logits = jnp.concatenate([s_loc.reshape(Bsz, H, GRID_W, kh * NA_KW), s_ctx], -1)
        p = jax.nn.softmax(logits, -1).astype(v.dtype)
        p_loc = p[..., :kh * NA_KW].reshape(Bsz, H, GRID_W, kh, NA_KW)
        p_ctx = p[..., kh * NA_KW:]
        return (jnp.einsum('bhcij,bicjhd->bchd', p_loc, vr)
                + jnp.einsum('bhcn,bnhd->bchd', p_ctx, v_ctx))

    out = lax.map(row_block, jnp.arange(rows))
    return out.transpose(1, 0, 2, 3, 4).reshape(Bsz, S, H * d)


def context_attention(q, k, v):
    s = jnp.einsum('bqhd,bkhd->bhqk', q, k).astype(jnp.float32) * (q.shape[-1] ** -0.5)
    p = jax.nn.softmax(s, -1).astype(v.dtype)
    return jnp.einsum('bhqk,bkhd->bqhd', p, v)


def hyena_filters(L, w1, b1, w2, b2, w3, decay):
    tn = jnp.arange(L, dtype=jnp.float32)[:, None] / L
    bands = jnp.arange(1, HY_BANDS + 1, dtype=jnp.float32)[None, :]
    ang = 2.0 * math.pi * bands * tn
    z = jnp.concatenate([tn, jnp.sin(ang), jnp.cos(ang)], -1)
    hmid = jnp.sin(HY_SIN_FREQ * (z @ w1.astype(jnp.float32) + b1.astype(jnp.float32)))
    hmid = jnp.sin(HY_SIN_FREQ * (hmid @ w2.astype(jnp.float32) + b2.astype(jnp.float32)))
    k = (hmid @ w3.astype(jnp.float32)) * jnp.exp(-tn * decay.astype(jnp.float32))
    k = k / (jnp.sum(jnp.abs(k), axis=0, keepdims=True) + 1e-6)
    return k[:, :GROUP_W], k[:, GROUP_W:]


def bidir_fftconv(u, k_fwd, k_bwd):
    L = u.shape[1]
    k2 = jnp.concatenate([k_fwd, jnp.zeros_like(k_fwd[:1]), k_bwd[1:][::-1]], 0)
    kf = jnp.fft.rfft(k2, n=2 * L, axis=0)
    uf = jnp.fft.rfft(u.astype(jnp.float32), n=2 * L, axis=1)
    return jnp.fft.irfft(uf * kf[None], n=2 * L, axis=1)[:, :L].astype(u.dtype)


def hyena(p, short_w, short_b, w1, b1, w2, b2, w3, decay, skip):
    L = p.shape[1]
    p = dwconv(p, short_w) + short_b
    x0, x1, v = jnp.split(p, 3, -1)
    k_fwd, k_bwd = hyena_filters(L, w1, b1, w2, b2, w3, decay)
    u = v * x1
    y = bidir_fftconv(u, k_fwd, k_bwd) + u * skip
    return y * x0


def segsum(a):
    T = a.shape[-1]
    a_rep = jnp.broadcast_to(a[..., None], a.shape + (T,))
    a_rep = jnp.where(jnp.tril(jnp.ones((T, T), bool), -1), a_rep, 0.0)
    s = jnp.cumsum(a_rep, axis=-2)
    return jnp.where(jnp.tril(jnp.ones((T, T), bool)), s, -jnp.inf)


def ssd_scan(x, dt, A, Bh, Ch, init_state, want_y):
    Bsz, L, H, P = x.shape
    N = Bh.shape[-1]
    nc = L // SSD_CHUNK
    xd = (x.astype(jnp.float32) * dt[..., None]).reshape(Bsz, nc, SSD_CHUNK, H, P)
    a = (dt * A).reshape(Bsz, nc, SSD_CHUNK, H).transpose(0, 3, 1, 2)
    Bc = Bh.astype(jnp.float32).reshape(Bsz, nc, SSD_CHUNK, H, N)
    Cc = Ch.astype(jnp.float32).reshape(Bsz, nc, SSD_CHUNK, H, N)
    a_cum = jnp.cumsum(a, -1)
    decay_states = jnp.exp(a_cum[..., -1:] - a_cum)
    states = jnp.einsum('bclhn,bhcl,bclhp->bchpn', Bc, decay_states, xd)
    states = jnp.concatenate([init_state[:, None], states], 1)
    decay_chunk = jnp.exp(segsum(jnp.pad(a_cum[..., -1], ((0, 0), (0, 0), (1, 0)))))
    new_states = jnp.einsum('bhzc,bchpn->bzhpn', decay_chunk, states)
    prev_states, final = new_states[:, :-1], new_states[:, -1]
    if not want_y:
        return None, final
    Lmat = jnp.exp(segsum(a))
    y_diag = jnp.einsum('bclhn,bcshn,bhcls,bcshp->bclhp', Cc, Bc, Lmat, xd)
    y_off = jnp.einsum('bclhn,bchpn,bhcl->bclhp', Cc, prev_states, jnp.exp(a_cum))
    return (y_diag + y_off).reshape(Bsz, L, H, P), final


def _flip(t):
    return jnp.flip(t, axis=1)


def ssd_bidir(z, xbc, dt_raw, init_f, init_b, want_y, conv_w, conv_b, a_log, dt_bias, d_skip, norm_g):
    Bsz, L, _ = xbc.shape
    xbc = jax.nn.silu(dwconv(xbc, conv_w) + conv_b)
    xs = xbc[..., :GROUP_W].reshape(Bsz, L, SSD_HEADS, SSD_HEAD_DIM)
    bc = xbc[..., GROUP_W:].reshape(Bsz, L, 2, SSD_GROUPS, SSD_STATE)
    rep = SSD_HEADS // SSD_GROUPS
    Bh = jnp.repeat(bc[:, :, 0], rep, axis=2)
    Ch = jnp.repeat(bc[:, :, 1], rep, axis=2)
    dt = jax.nn.softplus(dt_raw.astype(jnp.float32).reshape(Bsz, L, 2, SSD_HEADS) + dt_bias.astype(jnp.float32))
    A = -jnp.exp(a_log.astype(jnp.float32))
    y_f, s_f = ssd_scan(xs, dt[:, :, 0], A[0], Bh, Ch, init_f, want_y)
    y_b, s_b = ssd_scan(_flip(xs), _flip(dt[:, :, 1]), A[1], _flip(Bh), _flip(Ch), init_b, want_y)
    if not want_y:
        return None, s_f, s_b
    y = y_f + _flip(y_b) + xs.astype(jnp.float32) * d_skip.astype(jnp.float32)[:, None]
    yg = (y.reshape(Bsz, L, GROUP_W) * jax.nn.silu(z.astype(jnp.float32)))
    yg = yg.reshape(Bsz, L, SSD_GROUPS, GROUP_W // SSD_GROUPS)
    yg = yg * lax.rsqrt(jnp.mean(jnp.square(yg), -1, keepdims=True) + LN_EPS)
    return (yg.reshape(Bsz, L, GROUP_W) * norm_g).astype(z.dtype), s_f, s_b


def mixer_sublayer(h, hc, ctx_out, w_in, w_out, conf_dw_w, conf_dw_b, conf_norm_g, conf_norm_b, na_rpb,
                   hy_short_w, hy_short_b, hy_w1, hy_b1, hy_w2, hy_b2, hy_w3, hy_decay, hy_bias,
                   ssd_conv_w, ssd_conv_b, ssd_a_log, ssd_dt_bias, ssd_d, ssd_norm_g):
    Bsz, S, _ = h.shape
    Lc = hc.shape[1]
    pa, pb, py, pz, pxbc, pdt = _split_cols(h @ w_in)
    ca, cb, cy, cz, cxbc, cdt = _split_cols(hc @ w_in)
    qc, kc, vc = [t.reshape(Bsz, Lc, NA_HEADS, HEAD_DIM) for t in jnp.split(cb, 3, -1)]
    q, k, v = [t.reshape(Bsz, S, NA_HEADS, HEAD_DIM) for t in jnp.split(pb, 3, -1)]
    cos, sin = axial_rope(S // GRID_W, HEAD_DIM)
    y_b = neighborhood_attention(apply_rope(q, cos, sin), apply_rope(k, cos, sin), v, q, kc, vc, na_rpb)
    zero = jnp.zeros((Bsz, SSD_HEADS, SSD_HEAD_DIM, SSD_STATE), jnp.float32)
    y_dc, s_f, s_b = ssd_bidir(cz, cxbc, cdt, zero, zero, ctx_out, ssd_conv_w, ssd_conv_b,
                               ssd_a_log, ssd_dt_bias, ssd_d, ssd_norm_g)
    y_d, _, _ = ssd_bidir(pz, pxbc, pdt, s_f, s_b, True, ssd_conv_w, ssd_conv_b,
                          ssd_a_log, ssd_dt_bias, ssd_d, ssd_norm_g)
    y_a = conformer_conv(pa, conf_dw_w, conf_dw_b, conf_norm_g, conf_norm_b)
    y_c = hyena(py, hy_short_w, hy_short_b, hy_w1, hy_b1, hy_w2, hy_b2, hy_w3, hy_decay, hy_bias)
    y = jnp.concatenate([y_a, y_b, y_c, y_d], -1) @ w_out
    if not ctx_out:
        return y, None
    y_ac = conformer_conv(ca, conf_dw_w, conf_dw_b, conf_norm_g, conf_norm_b)
    y_bc = context_attention(qc, kc, vc).reshape(Bsz, Lc, GROUP_W)
    y_cc = hyena(cy, hy_short_w, hy_short_b, hy_w1, hy_b1, hy_w2, hy_b2, hy_w3, hy_decay, hy_bias)
    yc = jnp.concatenate([y_ac, y_bc, y_cc, y_dc], -1) @ w_out
    return y, yc


def peer(h, wq, sub_keys, u_tab, v_tab):
    Bsz, L, D = h.shape
    ht = h.reshape((Bsz * L) // PEER_BLOCK, PEER_BLOCK, D)
    K = PEER_TOPK

    def block(hb):
        q = (hb @ wq).reshape(PEER_BLOCK, PEER_HEADS, 2, PEER_QDIM // 2)
        s = jnp.einsum('thpk,hpnk->thpn', q, sub_keys).astype(jnp.float32)
        v1, i1 = lax.top_k(s[:, :, 0], K)
        v2, i2 = lax.top_k(s[:, :, 1], K)
        cand = (v1[..., :, None] + v2[..., None, :]).reshape(PEER_BLOCK, PEER_HEADS, K * K)
        cv, ci = lax.top_k(cand, K)
        e = (jnp.take_along_axis(i1, ci // K, axis=-1) * PEER_KEYS
             + jnp.take_along_axis(i2, ci % K, axis=-1)).reshape(PEER_BLOCK, PEER_HEADS * K)
        g = jax.nn.softmax(cv, -1).reshape(PEER_BLOCK, PEER_HEADS * K)
        act = jax.nn.gelu(jnp.einsum('td,ted->te', hb, u_tab[e]).astype(jnp.float32))
        w = (g * act).astype(hb.dtype)
        return jnp.einsum('te,ted->td', w, v_tab[e])

    return lax.map(block, ht).reshape(Bsz, L, D)


def setup_inputs(seed: int = 0) -> dict:
    key = jax.random.key(seed)
    ks = iter(jax.random.split(key, 48))
    f32 = jnp.float32
    Dp = DEPTH
    G = GROUP_W
    beta = (8.0 * DEPTH) ** -0.25

    def nrm(shape, scale):
        return jax.random.normal(next(ks), shape, f32) * scale

    x = nrm((BATCH, SEQ, D_MODEL), 1.0)
    c = nrm((BATCH, D_MODEL), 1.0)
    ctx = nrm((BATCH, CTX_LEN, D_MODEL), 1.0)
    c_ctx = nrm((D_MODEL,), 1.0)
    w_ada = nrm((Dp, D_MODEL, 6 * D_MODEL), D_MODEL ** -0.5)
    b_ada = nrm((Dp, 6 * D_MODEL), 0.02)
    w_in = nrm((Dp, D_MODEL, IN_COLS), D_MODEL ** -0.5)
    w_out = nrm((Dp, D_MIX, D_MODEL), D_MIX ** -0.5 * beta)
    ln1_g = 1.0 + nrm((Dp, D_MODEL), 0.02)
    ln1_b = nrm((Dp, D_MODEL), 0.02)
    ln2_g = 1.0 + nrm((Dp, D_MODEL), 0.02)
    ln2_b = nrm((Dp, D_MODEL), 0.02)
    conf_dw_w = nrm((Dp, CONF_K, G), CONF_K ** -0.5)
    conf_dw_b = nrm((Dp, G), 0.02)
    conf_norm_g = 1.0 + nrm((Dp, G), 0.02)
    conf_norm_b = nrm((Dp, G), 0.02)
    na_rpb = nrm((Dp, NA_HEADS, 2 * NA_KH - 1, 2 * NA_KW - 1), 0.1)
    hy_short_w = nrm((Dp, HY_SHORT, 3 * G), HY_SHORT ** -0.5)
    hy_short_b = nrm((Dp, 3 * G), 0.02)
    hy_w1 = nrm((Dp, HY_EMB, HY_HIDDEN), HY_EMB ** -0.5)
    hy_b1 = nrm((Dp, HY_HIDDEN), 0.1)
    hy_w2 = nrm((Dp, HY_HIDDEN, HY_HIDDEN), HY_HIDDEN ** -0.5)
    hy_b2 = nrm((Dp, HY_HIDDEN), 0.1)
    hy_w3 = nrm((Dp, HY_HIDDEN, 2 * G), HY_HIDDEN ** -0.5)
    hy_decay = jnp.broadcast_to(jnp.linspace(HY_MIN_DECAY, HY_MAX_DECAY, 2 * G, dtype=f32), (Dp, 2 * G)) * (1.0 + nrm((Dp, 2 * G), 0.05))
    hy_bias = nrm((Dp, G), 0.5)
    ssd_conv_w = nrm((Dp, SSD_CONV, XBC_W), SSD_CONV ** -0.5)
    ssd_conv_b = nrm((Dp, XBC_W), 0.02)
    ssd_a_log = jnp.log(jax.random.uniform(next(ks), (Dp, 2, SSD_HEADS), f32, minval=1.0, maxval=16.0))
    dt0 = jnp.exp(jax.random.uniform(next(ks), (Dp, 2, SSD_HEADS), f32, minval=math.log(1e-3), maxval=math.log(1e-1)))
    ssd_dt_bias = dt0 + jnp.log(-jnp.expm1(-dt0))
    ssd_d = 1.0 + nrm((Dp, SSD_HEADS), 0.02)
    ssd_norm_g = 1.0 + nrm((Dp, G), 0.02)
    peer_wq = nrm((Dp, D_MODEL, PEER_HEADS * PEER_QDIM), D_MODEL ** -0.5)
    peer_keys = nrm((Dp, PEER_HEADS, 2, PEER_KEYS, PEER_QDIM // 2), (PEER_QDIM // 2) ** -0.5)
    peer_u = nrm((Dp, N_EXPERTS, D_MODEL), D_MODEL ** -0.5)
    peer_v = nrm((Dp, N_EXPERTS, D_MODEL), (PEER_HEADS * PEER_TOPK) ** -0.5 * beta)
    return {'x': x, 'c': c, 'ctx': ctx, 'c_ctx': c_ctx, 'w_ada': w_ada, 'b_ada': b_ada,
            'w_in': w_in, 'w_out': w_out, 'ln1_g': ln1_g, 'ln1_b': ln1_b, 'ln2_g': ln2_g, 'ln2_b': ln2_b,
            'conf_dw_w': conf_dw_w, 'conf_dw_b': conf_dw_b, 'conf_norm_g': conf_norm_g, 'conf_norm_b': conf_norm_b,
            'na_rpb': na_rpb, 'hy_short_w': hy_short_w, 'hy_short_b': hy_short_b, 'hy_w1': hy_w1, 'hy_b1': hy_b1,
            'hy_w2': hy_w2, 'hy_b2': hy_b2, 'hy_w3': hy_w3, 'hy_decay': hy_decay, 'hy_bias': hy_bias,
            'ssd_conv_w': ssd_conv_w, 'ssd_conv_b': ssd_conv_b, 'ssd_a_log': ssd_a_log, 'ssd_dt_bias': ssd_dt_bias,
            'ssd_d': ssd_d, 'ssd_norm_g': ssd_norm_g, 'peer_wq': peer_wq, 'peer_keys': peer_keys,
            'peer_u': peer_u, 'peer_v': peer_v}


def reference(x, c, ctx, c_ctx, w_ada, b_ada, w_in, w_out, ln1_g, ln1_b, ln2_g, ln2_b,
              conf_dw_w, conf_dw_b, conf_norm_g, conf_norm_b, na_rpb, hy_short_w, hy_short_b,
              hy_w1, hy_b1, hy_w2, hy_b2, hy_w3, hy_decay, hy_bias, ssd_conv_w, ssd_conv_b,
              ssd_a_log, ssd_dt_bias, ssd_d, ssd_norm_g, peer_wq, peer_keys, peer_u, peer_v):
    alpha = (2.0 * DEPTH) ** 0.25
    s_c = jax.nn.silu(c)
    s_cc = jax.nn.silu(c_ctx)
    xc = ctx
    for l in range(DEPTH):
        ctx_out = l < DEPTH - 1
        mod = (s_c @ w_ada[l] + b_ada[l])[:, None, :]
        mod_c = (s_cc @ w_ada[l] + b_ada[l])[None, None, :]
        sh1, sc1, g1, sh2, sc2, g2 = jnp.split(mod, 6, -1)
        sh1c, sc1c, g1c, sh2c, sc2c, g2c = jnp.split(mod_c, 6, -1)
        y, yc = mixer_sublayer(x * (1.0 + sc1) + sh1, xc * (1.0 + sc1c) + sh1c, ctx_out,
                               w_in[l], w_out[l], conf_dw_w[l], conf_dw_b[l], conf_norm_g[l], conf_norm_b[l],
                               na_rpb[l], hy_short_w[l], hy_short_b[l], hy_w1[l], hy_b1[l], hy_w2[l], hy_b2[l],
                               hy_w3[l], hy_decay[l], hy_bias[l], ssd_conv_w[l], ssd_conv_b[l],
                               ssd_a_log[l], ssd_dt_bias[l], ssd_d[l], ssd_norm_g[l])
        x = layer_norm(alpha * x + g1 * y, ln1_g[l], ln1_b[l])
        x = layer_norm(alpha * x + g2 * peer(x * (1.0 + sc2) + sh2, peer_wq[l], peer_keys[l], peer_u[l], peer_v[l]),
                       ln2_g[l], ln2_b[l])
        if ctx_out:
            xc = layer_norm(alpha * xc + g1c * yc, ln1_g[l], ln1_b[l])
            xc = layer_norm(alpha * xc + g2c * peer(xc * (1.0 + sc2c) + sh2c, peer_wq[l], peer_keys[l], peer_u[l], peer_v[l]),
                            ln2_g[l], ln2_b[l])
    return x
```

```cpp
#include <hip/hip_runtime.h>
#include <hip/hip_cooperative_groups.h>
#include <cstdio>
#include <cstdint>
namespace cg = cooperative_groups;

#ifndef MULTI_LAUNCH
#define MULTI_LAUNCH 0
#endif

typedef unsigned short bf16_t;
typedef __attribute__((ext_vector_type(8))) short bf16x8;
typedef __attribute__((ext_vector_type(4))) float f32x4;

#define D_MODEL 1024
#define NB 16
#define SEQ 2048
#define CTXL 256
#define NLAT 32768
#define NTOK 36864
#define PST 2816
#define NCH 36
#define LDS_BYTES 53248
#define NTHREADS 256
#define ALPHA 1.41421356237f
#define LN_EPS 1e-5f

struct Params {
  const float *x, *c, *ctx, *c_ctx, *w_ada, *b_ada, *w_in, *w_out, *ln1_g, *ln1_b, *ln2_g, *ln2_b;
  const float *conf_dw_w, *conf_dw_b, *conf_norm_g, *conf_norm_b, *na_rpb, *hy_short_w, *hy_short_b;
  const float *hy_w1, *hy_b1, *hy_w2, *hy_b2, *hy_w3, *hy_decay, *hy_bias;
  const float *ssd_conv_w, *ssd_conv_b, *ssd_a_log, *ssd_dt_bias, *ssd_d, *ssd_norm_g;
  const float *peer_wq, *peer_keys, *peer_u, *peer_v;
  float* out;
  bf16_t* Pbuf;
  bf16_t* Ybuf;
  float*  xc;
  float*  dtbuf;
  bf16_t* wt_in;
  bf16_t* wt_out;
  bf16_t* wt_q;
  bf16_t* keysb;
  float*  modp;
  float*  mod;
  float*  hm2;
  bf16_t* gtab;
  float*  ropetab;
  bf16_t* krot;
  bf16_t* vt_lat;
  bf16_t* vt_ctx;
  float*  sst;
  float*  ssumA;
  bf16_t* uT;
  bf16_t* x0T;
  bf16_t* yT;
  bf16_t* tabu;
  bf16_t* tabv;
  int*    eidx;
  float*  egate;
  bf16_t* qbuf;
  unsigned* bar;
  float* pact;
  bf16_t* pout;
};

__device__ __forceinline__ bf16_t f2bf(float f) { unsigned u = __float_as_uint(f); u += 0x7FFFu + ((u >> 16) & 1u); return (bf16_t)(u >> 16); }
__device__ __forceinline__ float bf2f(bf16_t h) { return __uint_as_float(((unsigned)h) << 16); }
__device__ __forceinline__ unsigned pack2(float a, float b) { return (unsigned)f2bf(a) | ((unsigned)f2bf(b) << 16); }
__device__ __forceinline__ float lo2f(unsigned u) { return __uint_as_float(u << 16); }
__device__ __forceinline__ float hi2f(unsigned u) { return __uint_as_float(u & 0xFFFF0000u); }
__device__ __forceinline__ float sigmoidf_(float x) { return 1.f / (1.f + __expf(-x)); }
__device__ __forceinline__ float siluf_(float x) { return x / (1.f + __expf(-x)); }
__device__ __forceinline__ float wave_sum(float v) {
#pragma unroll
  for (int o = 32; o >= 1; o >>= 1) v += __shfl_xor(v, o);
  return v;
}
__device__ __forceinline__ void unpack8(uint4 v, float* f) {
  f[0] = lo2f(v.x); f[1] = hi2f(v.x); f[2] = lo2f(v.y); f[3] = hi2f(v.y);
  f[4] = lo2f(v.z); f[5] = hi2f(v.z); f[6] = lo2f(v.w); f[7] = hi2f(v.w);
}
__device__ __forceinline__ uint4 pack8(const float* f) {
  uint4 v; v.x = pack2(f[0], f[1]); v.y = pack2(f[2], f[3]); v.z = pack2(f[4], f[5]); v.w = pack2(f[6], f[7]); return v;
}
__device__ __forceinline__ bf16x8 as_bf8(uint4 v) { union { uint4 u; bf16x8 b; } x; x.u = v; return x.b; }
__device__ __forceinline__ f32x4 mfma16(bf16x8 a, bf16x8 b, f32x4 c) { return __builtin_amdgcn_mfma_f32_16x16x32_bf16(a, b, c, 0, 0, 0); }

__device__ __forceinline__ int tidx() { int t = threadIdx.x; asm volatile("" : "+v"(t)); return t; }
__device__ __forceinline__ void st_nt_u2(void* p, unsigned lo, unsigned hi) {
  __builtin_nontemporal_store(((unsigned long long)hi << 32) | (unsigned long long)lo, (unsigned long long*)p);
}
template <class Epi>
__device__ __forceinline__ void gemm_tile(const bf16_t* __restrict__ A, int lda, const bf16_t* __restrict__ Bt, int ldb,
                                          int K, int m0, int n0, unsigned char* smem, Epi epi) {
  bf16_t* As = (bf16_t*)smem;
  bf16_t* Bs = As + 3 * 128 * 40;
  const int tid = tidx(), lane = tid & 63, wave = tid >> 6;
  const int wm = wave >> 1, wn = wave & 1;
  const int lr = tid >> 1, lh = tid & 1;
  const bf16_t* ag = A + (size_t)(m0 + lr) * lda + lh * 16;
  const bf16_t* bg = Bt + (size_t)(n0 + lr) * ldb + lh * 16;
  f32x4 acc[4][4];
#pragma unroll
  for (int i = 0; i < 4; ++i)
#pragma unroll
    for (int j = 0; j < 4; ++j) acc[i][j] = (f32x4){0.f, 0.f, 0.f, 0.f};
  const int nk = K >> 5;
  uint4 pa0 = *(const uint4*)ag, pa1 = *(const uint4*)(ag + 8), pb0 = *(const uint4*)bg, pb1 = *(const uint4*)(bg + 8);
  uint4 qa0 = *(const uint4*)(ag + 32), qa1 = *(const uint4*)(ag + 40), qb0 = *(const uint4*)(bg + 32), qb1 = *(const uint4*)(bg + 40);
  __syncthreads();
  {
    bf16_t* wa = As + lr * 40 + lh * 16; bf16_t* wb = Bs + lr * 40 + lh * 16;
    *(uint4*)wa = pa0; *(uint4*)(wa + 8) = pa1; *(uint4*)wb = pb0; *(uint4*)(wb + 8) = pb1;
  }
  __syncthreads();
  int st = 0;
  auto compute = [&](int stage) {
    const bf16_t* as = As + stage * 5120 + (wm * 64 + (lane & 15)) * 40 + (lane >> 4) * 8;
    const bf16_t* bs = Bs + stage * 5120 + (wn * 64 + (lane & 15)) * 40 + (lane >> 4) * 8;
    bf16x8 afr[4];
#pragma unroll
    for (int j = 0; j < 4; ++j) afr[j] = *(const bf16x8*)(bs + j * 16 * 40);
#pragma unroll
    for (int i = 0; i < 4; ++i) {
      const bf16x8 bfr = *(const bf16x8*)(as + i * 16 * 40);
#pragma unroll
      for (int j = 0; j < 4; ++j) acc[i][j] = mfma16(afr[j], bfr, acc[i][j]);
    }
  };
  for (int kt = 0; kt < nk; kt += 2) {
    if (kt + 2 < nk) { const bf16_t* a2 = ag + (kt + 2) * 32; const bf16_t* b2 = bg + (kt + 2) * 32; pa0 = *(const uint4*)a2; pa1 = *(const uint4*)(a2 + 8); pb0 = *(const uint4*)b2; pb1 = *(const uint4*)(b2 + 8); }
    compute(st);
    {
      const int s1 = (st == 2) ? 0 : st + 1;
      bf16_t* wa = As + s1 * 5120 + lr * 40 + lh * 16; bf16_t* wb = Bs + s1 * 5120 + lr * 40 + lh * 16;
      *(uint4*)wa = qa0; *(uint4*)(wa + 8) = qa1; *(uint4*)wb = qb0; *(uint4*)(wb + 8) = qb1;
      st = s1;
    }
    __syncthreads();
    if (kt + 3 < nk) { const bf16_t* a2 = ag + (kt + 3) * 32; const bf16_t* b2 = bg + (kt + 3) * 32; qa0 = *(const uint4*)a2; qa1 = *(const uint4*)(a2 + 8); qb0 = *(const uint4*)b2; qb1 = *(const uint4*)(b2 + 8); }
    compute(st);
    if (kt + 2 < nk) {
      const int s1 = (st == 2) ? 0 : st + 1;
      bf16_t* wa = As + s1 * 5120 + lr * 40 + lh * 16; bf16_t* wb = Bs + s1 * 5120 + lr * 40 + lh * 16;
      *(uint4*)wa = pa0; *(uint4*)(wa + 8) = pa1; *(uint4*)wb = pb0; *(uint4*)(wb + 8) = pb1;
      st = s1;
    }
    __syncthreads();
  }
#pragma unroll
  for (int i = 0; i < 4; ++i)
#pragma unroll
    for (int j = 0; j < 4; ++j) {
      int m = m0 + wm * 64 + i * 16 + (lane & 15);
      int n = n0 + wn * 64 + j * 16 + (lane >> 4) * 4;
      epi(m, n, acc[i][j]);
    }
}

template <class Epi>
__device__ __forceinline__ void gemm_tile32(const bf16_t* __restrict__ A, int lda, const bf16_t* __restrict__ Bt, int ldb,
                                          int K, int m0, int n0, unsigned char* smem, Epi epi) {
  bf16_t* As = (bf16_t*)smem;
  bf16_t* Bs = As + 2 * 128 * 40;
  const int tid = tidx(), lane = tid & 63, wave = tid >> 6;
  const int wm = wave >> 1, wn = wave & 1;
  const int lr = tid >> 1, lh = tid & 1;
  const bf16_t* ag = A + (size_t)(m0 + lr) * lda + lh * 16;
  const bf16_t* bg = Bt + (size_t)(n0 + lr) * ldb + lh * 16;
  f32x4 acc[4][4];
#pragma unroll
  for (int i = 0; i < 4; ++i)
#pragma unroll
    for (int j = 0; j < 4; ++j) acc[i][j] = (f32x4){0.f, 0.f, 0.f, 0.f};
  uint4 ra0 = *(const uint4*)ag, ra1 = *(const uint4*)(ag + 8);
  uint4 rb0 = *(const uint4*)bg, rb1 = *(const uint4*)(bg + 8);
  __syncthreads();
  {
    bf16_t* pa = As + lr * 40 + lh * 16; bf16_t* pb = Bs + lr * 40 + lh * 16;
    *(uint4*)pa = ra0; *(uint4*)(pa + 8) = ra1; *(uint4*)pb = rb0; *(uint4*)(pb + 8) = rb1;
  }
  __syncthreads();
  const int nk = K >> 5;
  for (int kt = 0; kt < nk; ++kt) {
    const int cur = kt & 1;
    if (kt + 1 < nk) {
      const bf16_t* a2 = ag + (kt + 1) * 32; const bf16_t* b2 = bg + (kt + 1) * 32;
      ra0 = *(const uint4*)a2; ra1 = *(const uint4*)(a2 + 8); rb0 = *(const uint4*)b2; rb1 = *(const uint4*)(b2 + 8);
    }
    const bf16_t* as = As + cur * 5120 + (wm * 64 + (lane & 15)) * 40 + (lane >> 4) * 8;
    const bf16_t* bs = Bs + cur * 5120 + (wn * 64 + (lane & 15)) * 40 + (lane >> 4) * 8;
    bf16x8 afr[4];
#pragma unroll
    for (int j = 0; j < 4; ++j) afr[j] = *(const bf16x8*)(bs + j * 16 * 40);
#pragma unroll
    for (int i = 0; i < 4; ++i) {
      const bf16x8 bfr = *(const bf16x8*)(as + i * 16 * 40);
#pragma unroll
      for (int j = 0; j < 4; ++j) acc[i][j] = mfma16(afr[j], bfr, acc[i][j]);
    }
    if (kt + 1 < nk) {
      bf16_t* pa = As + (cur ^ 1) * 5120 + lr * 40 + lh * 16; bf16_t* pb = Bs + (cur ^ 1) * 5120 + lr * 40 + lh * 16;
      *(uint4*)pa = ra0; *(uint4*)(pa + 8) = ra1; *(uint4*)pb = rb0; *(uint4*)(pb + 8) = rb1;
    }
    __syncthreads();
  }
#pragma unroll
  for (int i = 0; i < 4; ++i)
#pragma unroll
    for (int j = 0; j < 4; ++j) {
      int m = m0 + wm * 64 + i * 16 + (lane & 15);
      int n = n0 + wn * 64 + j * 16 + (lane >> 4) * 4;
      epi(m, n, acc[i][j]);
    }
}

__device__ __forceinline__ void transpose_task(const float* __restrict__ src, bf16_t* __restrict__ dst, int K, int N, int k0, int n0, unsigned char* smem) {
  float* tile = (float*)smem;
  const int tid = tidx();
  __syncthreads();
  {
    int r = tid >> 4, c4 = tid & 15;
#pragma unroll
    for (int rr = 0; rr < 4; ++rr) {
      int row = rr * 16 + r;
      float4 v = make_float4(0.f, 0.f, 0.f, 0.f);
      if (n0 + c4 * 4 < N) v = *(const float4*)(src + (size_t)(k0 + row) * N + n0 + c4 * 4);
      float* t = tile + row * 65 + c4 * 4;
      t[0] = v.x; t[1] = v.y; t[2] = v.z; t[3] = v.w;
    }
  }
  __syncthreads();
  {
    int n = tid >> 2, kq = tid & 3;
    float f[16];
#pragma unroll
    for (int i = 0; i < 16; ++i) f[i] = tile[(kq * 16 + i) * 65 + n];
    bf16_t* d = dst + (size_t)(n0 + n) * K + k0 + kq * 16;
    *(uint4*)d = pack8(f); *(uint4*)(d + 8) = pack8(f + 8);
  }
}

__device__ __forceinline__ void modpart_task(const Params& P, int l, int ks, int cb, unsigned char* smem) {
  float* s = (float*)smem;
  const int tid = tidx();
  __syncthreads();
  for (int i = tid; i < 17 * 64; i += NTHREADS) {
    int r = i >> 6, k = i & 63;
    float v = (r < 16) ? P.c[r * 1024 + ks * 64 + k] : P.c_ctx[ks * 64 + k];
    s[i] = siluf_(v);
  }
  __syncthreads();
  float acc[17];
#pragma unroll
  for (int r = 0; r < 17; ++r) acc[r] = 0.f;
  const int col = cb * 256 + tid;
  const float* w = P.w_ada + ((size_t)l * 1024 + ks * 64) * 6144 + col;
#pragma unroll 8
  for (int k = 0; k < 64; ++k) {
    float wv = w[(size_t)k * 6144];
#pragma unroll
    for (int r = 0; r < 17; ++r) acc[r] += s[r * 64 + k] * wv;
  }
#pragma unroll
  for (int r = 0; r < 17; ++r) P.modp[(((size_t)l * 16 + ks) * 17 + r) * 6144 + col] = acc[r];
}

__device__ __forceinline__ void hm2_task(const Params& P, int l, int lsel, int t4, unsigned char* smem) {
  float* z = (float*)smem;
  float* h1 = z + 4 * 36;
  const int tid = tidx(), tt = tid >> 6, j = tid & 63;
  const int L = lsel ? 256 : 2048;
  const int t = t4 * 4 + tt;
  const float tn = (float)t / (float)L;
  __syncthreads();
  if (j < 33) {
    float v;
    if (j == 0) v = tn;
    else if (j <= 16) v = sinf((6.2831855f * (float)j) * tn);
    else v = cosf((6.2831855f * (float)(j - 16)) * tn);
    z[tt * 36 + j] = v;
  }
  __syncthreads();
  float a = P.hy_b1[l * 64 + j];
  for (int i = 0; i < 33; ++i) a += z[tt * 36 + i] * P.hy_w1[(l * 33 + i) * 64 + j];
  h1[tt * 64 + j] = sinf(a);
  __syncthreads();
  float b = P.hy_b2[l * 64 + j];
  for (int i = 0; i < 64; ++i) b += h1[tt * 64 + i] * P.hy_w2[(l * 64 + i) * 64 + j];
  P.hm2[(((size_t)l * 2 + lsel) * 2048 + t) * 64 + j] = sinf(b);
}

__device__ __forceinline__ bf16_t* gtab_ptr(const Params& P, int l, int lsel, int c) {
  bf16_t* base = P.gtab + (size_t)l * (256 * 2 * 4096 + 256 * 2 * 512);
  return lsel ? base + 256 * 2 * 4096 + (size_t)c * 1024 : base + (size_t)c * 8192;
}

__device__ __forceinline__ void filt_task(const Params& P, int l, int lsel, int col, unsigned char* smem) {
  float* kv = (float*)smem;
  float* red = kv + 2048;
  float* w3s = red + 8;
  const int tid = tidx();
  const int L = lsel ? 256 : 2048;
  __syncthreads();
  if (tid < 64) w3s[tid] = P.hy_w3[(l * 64 + tid) * 512 + col];
  __syncthreads();
  const float dec = P.hy_decay[l * 512 + col];
  float asum = 0.f;
  for (int t = tid; t < L; t += NTHREADS) {
    const float* h = P.hm2 + (((size_t)l * 2 + lsel) * 2048 + t) * 64;
    float a = 0.f;
#pragma unroll 8
    for (int i = 0; i < 64; ++i) a += h[i] * w3s[i];
    float tn = (float)t / (float)L;
    a *= expf(-tn * dec);
    kv[t] = a; asum += fabsf(a);
  }
  asum = wave_sum(asum);
  if ((tid & 63) == 0) red[tid >> 6] = asum;
  __syncthreads();
  const float inv = 1.f / (red[0] + red[1] + red[2] + red[3] + 1e-6f);
  const int c = col & 255;
  const bool bwd = col >= 256;
  bf16_t* g0 = gtab_ptr(P, l, lsel, c);
  bf16_t* g1 = g0 + 2 * L;
  for (int d = tid; d < L; d += NTHREADS) {
    if (bwd && d == 0) continue;
    int i = bwd ? (L - 1 + d) : (L - 1 - d);
    bf16_t v = f2bf(kv[d] * inv);
    g0[i] = v;
    if (i >= 1) g1[i - 1] = v;
  }
}

__device__ __forceinline__ int mod_row(int T) { return T < NLAT ? (T >> 11) : 16; }

__device__ __forceinline__ void hmod0_token(const Params& P, int T, int lane) {
  const float* xr = (T < NLAT) ? P.x + (size_t)T * 1024 : P.ctx + (size_t)(T - NLAT) * 1024;
  const float* m = P.mod + (size_t)mod_row(T) * 6144;
#pragma unroll
  for (int i = 0; i < 2; ++i) {
    int d = i * 512 + lane * 8;
    float f[8];
#pragma unroll
    for (int j = 0; j < 8; ++j) f[j] = xr[d + j] * (1.f + m[1024 + d + j]) + m[d + j];
    *(uint4*)(P.Ybuf + (size_t)T * 1024 + d) = pack8(f);
  }
}

__device__ __forceinline__ void r1_token(const Params& P, int l, int T, int lane, const bool dry) {
  const float* xr;
  float* xw;
  if (T < NLAT) { xr = (l == 0) ? P.x + (size_t)T * 1024 : P.out + (size_t)T * 1024; xw = P.out + (size_t)T * 1024; }
  else { xr = (l == 0) ? P.ctx + (size_t)(T - NLAT) * 1024 : P.xc + (size_t)(T - NLAT) * 1024; xw = P.xc + (size_t)(T - NLAT) * 1024; }
  bf16_t* hw = P.Ybuf + (size_t)T * 1024;
  if (dry) { xw = (float*)P.uT + (size_t)(T & 2047) * 1024; hw = P.x0T + (size_t)(T & 2047) * 1024; }
  const float* m = P.mod + ((size_t)l * 17 + mod_row(T)) * 6144;
  const bf16_t* yo = P.Pbuf + (size_t)T * 1024;
  float v[16];
  float s = 0.f;
#pragma unroll
  for (int i = 0; i < 2; ++i) {
    int d = i * 512 + lane * 8;
    float y[8]; unpack8(*(const uint4*)(yo + d), y);
#pragma unroll
    for (int j = 0; j < 8; ++j) { v[i * 8 + j] = ALPHA * xr[d + j] + m[2048 + d + j] * y[j]; s += v[i * 8 + j]; }
  }
  float mean = wave_sum(s) * (1.f / 1024.f);
  float q = 0.f;
#pragma unroll
  for (int i = 0; i < 16; ++i) { v[i] -= mean; q += v[i] * v[i]; }
  float rstd = rsqrtf(wave_sum(q) * (1.f / 1024.f) + LN_EPS);
#pragma unroll
  for (int i = 0; i < 2; ++i) {
    int d = i * 512 + lane * 8;
    float h[8];
#pragma unroll
    for (int j = 0; j < 8; ++j) {
      float x1 = v[i * 8 + j] * rstd * P.ln1_g[l * 1024 + d + j] + P.ln1_b[l * 1024 + d + j];
      xw[d + j] = x1;
      h[j] = x1 * (1.f + m[4096 + d + j]) + m[3072 + d + j];
    }
    *(uint4*)(hw + d) = pack8(h);
  }
}

__device__ __forceinline__ float gelu_tanh(float x) {
  float u = 0.7978845608f * (x + 0.044715f * x * x * x);
  float t = 1.f - 2.f / (1.f + __expf(2.f * u));
  return 0.5f * x * (1.f + t);
}

typedef float f32x2 __attribute__((ext_vector_type(2)));
__device__ __forceinline__ unsigned pack4_fp8(float a, float b, float c, float d) {
  int v = 0;
  v = __builtin_amdgcn_cvt_pk_fp8_f32(a, b, v, false);
  v = __builtin_amdgcn_cvt_pk_fp8_f32(c, d, v, true);
  return (unsigned)v;
}
__device__ __forceinline__ float dot16_fp8(uint4 v, const float* h) {
  f32x2 acc = (f32x2){0.f, 0.f};
  unsigned w[4] = {v.x, v.y, v.z, v.w};
#pragma unroll
  for (int q = 0; q < 4; ++q) {
    acc += __builtin_amdgcn_cvt_pk_f32_fp8((int)w[q], false) * (f32x2){h[q * 4], h[q * 4 + 1]};
    acc += __builtin_amdgcn_cvt_pk_f32_fp8((int)w[q], true) * (f32x2){h[q * 4 + 2], h[q * 4 + 3]};
  }
  return acc[0] + acc[1];
}
typedef float f32x4_t __attribute__((ext_vector_type(4)));
__device__ __forceinline__ void peer_u_phase(const Params& P, int sl, int Tfirst, int Tstride, int ntok, int lane, int* li) {
  const int m = lane & 15, quad = lane >> 4;
  const unsigned char* tu = (const unsigned char*)P.tabu + (size_t)sl * 16384 * 128 + quad * 32;
  const int wpos = (lane & 15) * 8 + (lane >> 4);
  for (int T0 = Tfirst; T0 < ntok; T0 += 4 * Tstride) {
    int Tk[4];
    {
      int ir[4][2];
#pragma unroll
      for (int k = 0; k < 4; ++k) {
        Tk[k] = min(T0 + k * Tstride, ntok - 1);
        const int* er = P.eidx + (size_t)Tk[k] * 128;
        ir[k][0] = er[lane]; ir[k][1] = er[64 + lane];
      }
#pragma unroll
      for (int k = 0; k < 4; ++k) { li[k * 128 + wpos] = ir[k][0]; li[k * 128 + wpos + 4] = ir[k][1]; }
    }
#pragma unroll 1
    for (int k = 0; k < 4; ++k) {
      const int Tc = min(T0 + k * Tstride, ntok - 1);
      uint4 hr[4];
      const bf16_t* hp = P.Ybuf + (size_t)Tc * 1024 + sl * 128 + quad * 32;
#pragma unroll
      for (int q = 0; q < 4; ++q) hr[q] = *(const uint4*)(hp + q * 8);
      uint4 rv[16];
      {
        int idx[8];
#pragma unroll
        for (int q = 0; q < 2; ++q) { int4 v = *(const int4*)(li + k * 128 + m * 8 + q * 4); idx[q * 4] = v.x; idx[q * 4 + 1] = v.y; idx[q * 4 + 2] = v.z; idx[q * 4 + 3] = v.w; }
#pragma unroll
        for (int t = 0; t < 8; ++t) { const unsigned char* rp = tu + (size_t)idx[t] * 128; rv[2 * t] = *(const uint4*)rp; rv[2 * t + 1] = *(const uint4*)(rp + 16); }
      }
      long hb[4];
#pragma unroll
      for (int q = 0; q < 4; ++q) {
        float f[8]; unpack8(hr[q], f);
        unsigned lo = pack4_fp8(f[0], f[1], f[2], f[3]), hi = pack4_fp8(f[4], f[5], f[6], f[7]);
        hb[q] = (long)(((unsigned long long)hi << 32) | (unsigned long long)lo);
      }
      const bool live = (T0 + k * Tstride) < ntok;
      float* po = P.pact + ((size_t)sl * NTOK + Tc) * 128 + quad * 4;
#pragma unroll
      for (int t = 0; t < 8; ++t) {
        f32x4_t acc = (f32x4_t){0.f, 0.f, 0.f, 0.f};
        const uint4 r0 = rv[2 * t], r1 = rv[2 * t + 1];
        acc = __builtin_amdgcn_mfma_f32_16x16x32_fp8_fp8((long)(((unsigned long long)r0.y << 32) | r0.x), hb[0], acc, 0, 0, 0);
        acc = __builtin_amdgcn_mfma_f32_16x16x32_fp8_fp8((long)(((unsigned long long)r0.w << 32) | r0.z), hb[1], acc, 0, 0, 0);
        acc = __builtin_amdgcn_mfma_f32_16x16x32_fp8_fp8((long)(((unsigned long long)r1.y << 32) | r1.x), hb[2], acc, 0, 0, 0);
        acc = __builtin_amdgcn_mfma_f32_16x16x32_fp8_fp8((long)(((unsigned long long)r1.w << 32) | r1.z), hb[3], acc, 0, 0, 0);
        if (m == 0 && live) *(float4*)(po + t * 16) = make_float4(acc[0], acc[1], acc[2], acc[3]);
      }
    }
  }
}
__device__ __forceinline__ void peer_v_phase(const Params& P, int sl, int Tfirst, int Tstride, int ntok, int lane, int* li) {
  const int grp = lane >> 3, j8 = lane & 7;
  const unsigned char* tv = (const unsigned char*)P.tabv + (size_t)sl * 16384 * 128 + j8 * 16;
  float* lw = (float*)(li + 512);
  const int wpos = (lane & 7) * 16 + (lane >> 3);
  for (int T0 = Tfirst; T0 < ntok; T0 += 4 * Tstride) {
    int Tk[4];
    {
      int ir[4][2]; float wr[4][2];
#pragma unroll
      for (int k = 0; k < 4; ++k) {
        Tk[k] = min(T0 + k * Tstride, ntok - 1);
        const int* er = P.eidx + (size_t)Tk[k] * 128; const float* gr = P.egate + (size_t)Tk[k] * 128;
        ir[k][0] = er[lane]; ir[k][1] = er[64 + lane]; wr[k][0] = gr[lane]; wr[k][1] = gr[64 + lane];
      }
#pragma unroll
      for (int k = 0; k < 4; ++k) { li[k * 128 + wpos] = ir[k][0]; li[k * 128 + wpos + 8] = ir[k][1]; lw[k * 128 + wpos] = wr[k][0]; lw[k * 128 + wpos + 8] = wr[k][1]; }
    }
    uint4 rv[1][16];
#pragma unroll
    for (int k = 0; k < 4; ++k) {
      {
        int idx[16];
#pragma unroll
        for (int q = 0; q < 4; ++q) { int4 v = *(const int4*)(li + k * 128 + grp * 16 + q * 4); idx[q * 4] = v.x; idx[q * 4 + 1] = v.y; idx[q * 4 + 2] = v.z; idx[q * 4 + 3] = v.w; }
#pragma unroll
        for (int t = 0; t < 16; ++t) rv[0][t] = *(const uint4*)(tv + (size_t)idx[t] * 128);
      }
      {
        const int kk = k;
        float w[16];
#pragma unroll
        for (int q = 0; q < 4; ++q) { float4 f = *(const float4*)(lw + kk * 128 + grp * 16 + q * 4); w[q * 4] = f.x; w[q * 4 + 1] = f.y; w[q * 4 + 2] = f.z; w[q * 4 + 3] = f.w; }
        f32x2 o[8];
#pragma unroll
        for (int i = 0; i < 8; ++i) o[i] = (f32x2){0.f, 0.f};
#pragma unroll
        for (int t = 0; t < 16; ++t) {
          const f32x2 w2 = (f32x2){w[t], w[t]};
          const uint4 r = rv[0][t];
          unsigned ww[4] = {r.x, r.y, r.z, r.w};
#pragma unroll
          for (int q = 0; q < 4; ++q) {
            o[q * 2] += w2 * __builtin_amdgcn_cvt_pk_f32_fp8((int)ww[q], false);
            o[q * 2 + 1] += w2 * __builtin_amdgcn_cvt_pk_f32_fp8((int)ww[q], true);
          }
        }
        float of[16];
#pragma unroll
        for (int i = 0; i < 8; ++i) { of[2 * i] = o[i][0]; of[2 * i + 1] = o[i][1]; }
#pragma unroll
        for (int i = 0; i < 16; ++i) { of[i] += __shfl_xor(of[i], 8); of[i] += __shfl_xor(of[i], 16); of[i] += __shfl_xor(of[i], 32); }
        if (grp == 0 && (T0 + kk * Tstride) < ntok) {
#pragma unroll
          for (int i = 0; i < 16; ++i) of[i] *= (1.f / 256.f);
          bf16_t* d = P.pout + (size_t)Tk[kk] * 1024 + sl * 128 + j8 * 16;
          *(uint4*)d = pack8(of); *(uint4*)(d + 8) = pack8(of + 8);
        }
      }
    }
  }
}
__device__ __forceinline__ void ln2_token(const Params& P, int l, int T, int lane) {
  float* xw = (T < NLAT) ? P.out + (size_t)T * 1024 : P.xc + (size_t)(T - NLAT) * 1024;
  bf16_t* hw = P.Ybuf + (size_t)T * 1024;
  const float* m = P.mod + ((size_t)l * 17 + mod_row(T)) * 6144;
  const int d0 = lane * 16;
  float o[16];
  unpack8(*(const uint4*)(P.pout + (size_t)T * 1024 + d0), o); unpack8(*(const uint4*)(P.pout + (size_t)T * 1024 + d0 + 8), o + 8);
  float s = 0.f;
#pragma unroll
  for (int i = 0; i < 16; ++i) { o[i] = ALPHA * xw[d0 + i] + m[5120 + d0 + i] * o[i]; s += o[i]; }
  float mean = wave_sum(s) * (1.f / 1024.f);
  float q = 0.f;
#pragma unroll
  for (int i = 0; i < 16; ++i) { o[i] -= mean; q += o[i] * o[i]; }
  float rstd = rsqrtf(wave_sum(q) * (1.f / 1024.f) + LN_EPS);
  const float* mn = P.mod + ((size_t)(l + 1) * 17 + mod_row(T)) * 6144;
  float hh[16];
#pragma unroll
  for (int i = 0; i < 16; ++i) {
    float x2 = o[i] * rstd * P.ln2_g[l * 1024 + d0 + i] + P.ln2_b[l * 1024 + d0 + i];
    o[i] = x2;
    if (l == 0) hh[i] = x2 * (1.f + mn[1024 + d0 + i]) + mn[d0 + i];
  }
#pragma unroll
  for (int i = 0; i < 4; ++i) *(float4*)(xw + d0 + i * 4) = make_float4(o[i * 4], o[i * 4 + 1], o[i * 4 + 2], o[i * 4 + 3]);
  if (l == 0) { *(uint4*)(hw + d0) = pack8(hh); *(uint4*)(hw + d0 + 8) = pack8(hh + 8); }
}

__device__ __forceinline__ void peer_token(const Params& P, int l, int T, int lane, float* wl, const bool dry) {
  const int sub = lane >> 4, j16 = lane & 15;
  float h[64];
  {
    const bf16_t* hr = P.Ybuf + (size_t)T * 1024 + j16 * 16;
#pragma unroll
    for (int i = 0; i < 4; ++i) { unpack8(*(const uint4*)(hr + i * 256), h + i * 16); unpack8(*(const uint4*)(hr + i * 256 + 8), h + i * 16 + 8); }
  }
  const int* er = P.eidx + (size_t)T * 128;
  const float* gr = P.egate + (size_t)T * 128;
  const unsigned char* tu = (const unsigned char*)P.tabu;
  const unsigned char* tv = (const unsigned char*)P.tabv;
  for (int it = 0; it < 32; it += 2) {
    uint4 rv[2][4];
#pragma unroll
    for (int u2 = 0; u2 < 2; ++u2) {
      int e = er[(it + u2) * 4 + sub];
      const unsigned char* row = tu + (size_t)e * 1024 + j16 * 16;
#pragma unroll
      for (int i = 0; i < 4; ++i) rv[u2][i] = *(const uint4*)(row + i * 256);
    }
#pragma unroll
    for (int u2 = 0; u2 < 2; ++u2) {
      float acc = 0.f;
#pragma unroll
      for (int i = 0; i < 4; ++i) acc += dot16_fp8(rv[u2][i], h + i * 16);
      acc += __shfl_xor(acc, 1); acc += __shfl_xor(acc, 2); acc += __shfl_xor(acc, 4); acc += __shfl_xor(acc, 8);
      if (j16 == 0) wl[(it + u2) * 4 + sub] = gr[(it + u2) * 4 + sub] * gelu_tanh(acc * (1.f / 256.f));
    }
  }
  float o[16];
#pragma unroll
  for (int i = 0; i < 16; ++i) o[i] = 0.f;
  for (int e8 = 0; e8 < 128; e8 += 8) {
    uint4 rv[8];
    float w[8];
#pragma unroll
    for (int k = 0; k < 8; ++k) {
      int e = er[e8 + k];
      rv[k] = *(const uint4*)(tv + (size_t)e * 1024 + lane * 16);
      w[k] = wl[e8 + k];
    }
#pragma unroll
    for (int k = 0; k < 8; ++k) {
      unsigned ww[4] = {rv[k].x, rv[k].y, rv[k].z, rv[k].w};
#pragma unroll
      for (int q = 0; q < 4; ++q) {
        f32x2 lo = __builtin_amdgcn_cvt_pk_f32_fp8((int)ww[q], false);
        f32x2 hi = __builtin_amdgcn_cvt_pk_f32_fp8((int)ww[q], true);
        o[q * 4] += w[k] * lo[0]; o[q * 4 + 1] += w[k] * lo[1]; o[q * 4 + 2] += w[k] * hi[0]; o[q * 4 + 3] += w[k] * hi[1];
      }
    }
  }
  float* xw = (T < NLAT) ? P.out + (size_t)T * 1024 : P.xc + (size_t)(T - NLAT) * 1024;
  const float* xrd = xw;
  bf16_t* hw = P.Ybuf + (size_t)T * 1024;
  if (dry) { xw = (float*)P.uT + (size_t)(T & 2047) * 1024; hw = P.x0T + (size_t)(T & 2047) * 1024; }
  const float* m = P.mod + ((size_t)l * 17 + mod_row(T)) * 6144;
  const int d0 = lane * 16;
  float s = 0.f;
#pragma unroll
  for (int i = 0; i < 16; ++i) { o[i] = ALPHA * xrd[d0 + i] + m[5120 + d0 + i] * (o[i] * (1.f / 256.f)); s += o[i]; }
  float mean = wave_sum(s) * (1.f / 1024.f);
  float q = 0.f;
#pragma unroll
  for (int i = 0; i < 16; ++i) { o[i] -= mean; q += o[i] * o[i]; }
  float rstd = rsqrtf(wave_sum(q) * (1.f / 1024.f) + LN_EPS);
  const float* mn = P.mod + ((size_t)(l + 1) * 17 + mod_row(T)) * 6144;
  float hh[16];
#pragma unroll
  for (int i = 0; i < 16; ++i) {
    float x2 = o[i] * rstd * P.ln2_g[l * 1024 + d0 + i] + P.ln2_b[l * 1024 + d0 + i];
    o[i] = x2;
    if (l == 0) hh[i] = x2 * (1.f + mn[1024 + d0 + i]) + mn[d0 + i];
  }
#pragma unroll
  for (int i = 0; i < 4; ++i) *(float4*)(xw + d0 + i * 4) = make_float4(o[i * 4], o[i * 4 + 1], o[i * 4 + 2], o[i * 4 + 3]);
  if (l == 0) { *(uint4*)(hw + d0) = pack8(hh); *(uint4*)(hw + d0 + 8) = pack8(hh + 8); }
}

__device__ __forceinline__ void conf_task(const Params& P, int l, int tok_base, int len, int pos0, unsigned char* smem) {
  _Float16* u = (_Float16*)smem;
  const int c = tidx();
  __syncthreads();
  for (int i = 0; i < 94; ++i) {
    int pos = pos0 - 15 + i;
    float v = 0.f;
    if (pos >= 0 && pos < len) {
      const bf16_t* pr = P.Pbuf + (size_t)(tok_base + pos) * PST;
      v = bf2f(pr[c]) * sigmoidf_(bf2f(pr[256 + c]));
    }
    u[i * 256 + c] = (_Float16)v;
  }
  __syncthreads();
  float w[31];
#pragma unroll
  for (int j = 0; j < 31; ++j) w[j] = P.conf_dw_w[(l * 31 + j) * 256 + c];
  const float bias = P.conf_dw_b[l * 256 + c], ng = P.conf_norm_g[l * 256 + c], nb = P.conf_norm_b[l * 256 + c];
  for (int t = 0; t < 64; ++t) {
    float acc = bias;
#pragma unroll
    for (int j = 0; j < 31; ++j) acc += w[j] * (float)u[(t + j) * 256 + c];
    float mean = wave_sum(acc) * (1.f / 64.f);
    float d = acc - mean;
    float var = wave_sum(d * d) * (1.f / 64.f);
    float un = d * rsqrtf(var + LN_EPS) * ng + nb;
    P.Ybuf[(size_t)(tok_base + pos0 + t) * 1024 + c] = f2bf(siluf_(un));
  }
}

__device__ __forceinline__ void prep_task(const Params& P, int l, bool lat, int b, int pos0) {
  const int c = tidx();
  const int len = lat ? 2048 : 256;
  const int tok0 = lat ? b * 2048 + pos0 : NLAT + b * 256 + pos0;
  {
    bf16_t* dst = (lat ? P.vt_lat : P.vt_ctx) + ((size_t)b * 256 + c) * len + pos0;
    for (int t8 = 0; t8 < 8; ++t8) {
      unsigned wv[4];
#pragma unroll
      for (int k = 0; k < 4; ++k) {
        unsigned a = P.Pbuf[(size_t)(tok0 + t8 * 8 + k * 2) * PST + 1024 + c];
        unsigned bb = P.Pbuf[(size_t)(tok0 + t8 * 8 + k * 2 + 1) * PST + 1024 + c];
        wv[k] = a | (bb << 16);
      }
      *(uint4*)(dst + t8 * 8) = make_uint4(wv[0], wv[1], wv[2], wv[3]);
    }
  }
  if (lat) {
    const int hd = c & 63, i = hd & 31, hbase = c & ~63;
    const bool hi = hd >= 32;
    const int row = pos0 >> 6;
    const float* tc = P.ropetab; const float* ts = P.ropetab + 1024;
    for (int t = 0; t < 64; ++t) {
      const bf16_t* kr = P.Pbuf + (size_t)(tok0 + t) * PST + 768 + hbase;
      float x1 = bf2f(kr[i]), x2 = bf2f(kr[32 + i]);
      int pos = (i < 16) ? row : t;
      float cs = tc[pos * 16 + (i & 15)], sn = ts[pos * 16 + (i & 15)];
      float o = hi ? (x1 * sn + x2 * cs) : (x1 * cs - x2 * sn);
      P.krot[(size_t)(tok0 + t) * 256 + c] = f2bf(o);
    }
  }
  {
    float w[3][3], bsv[3];
#pragma unroll
    for (int q = 0; q < 3; ++q) {
      bsv[q] = P.hy_short_b[l * 768 + q * 256 + c];
#pragma unroll
      for (int k = 0; k < 3; ++k) w[q][k] = P.hy_short_w[(l * 3 + k) * 768 + q * 256 + c];
    }
    const size_t seqoff = lat ? ((size_t)b * 256 + c) * 2048 : (size_t)16 * 256 * 2048 + ((size_t)b * 256 + c) * 256;
    float pv[3], cu[3], nx[3];
#pragma unroll
    for (int q = 0; q < 3; ++q) {
      pv[q] = (pos0 > 0) ? bf2f(P.Pbuf[(size_t)(tok0 - 1) * PST + 1280 + q * 256 + c]) : 0.f;
      cu[q] = bf2f(P.Pbuf[(size_t)tok0 * PST + 1280 + q * 256 + c]);
    }
    for (int t8 = 0; t8 < 8; ++t8) {
      float uo[8], xo[8];
#pragma unroll
      for (int k = 0; k < 8; ++k) {
        int t = t8 * 8 + k;
        float r[3];
#pragma unroll
        for (int q = 0; q < 3; ++q) {
          nx[q] = (pos0 + t + 1 < len) ? bf2f(P.Pbuf[(size_t)(tok0 + t + 1) * PST + 1280 + q * 256 + c]) : 0.f;
          r[q] = w[q][0] * pv[q] + w[q][1] * cu[q] + w[q][2] * nx[q] + bsv[q];
          pv[q] = cu[q]; cu[q] = nx[q];
        }
        xo[k] = r[0]; uo[k] = r[2] * r[1];
      }
      *(uint4*)(P.uT + seqoff + pos0 + t8 * 8) = pack8(uo);
      *(uint4*)(P.x0T + seqoff + pos0 + t8 * 8) = pack8(xo);
    }
  }
}

__device__ __forceinline__ void hyfin_task(const Params& P, int l, bool lat, int b, int pos0) {
  const int c = tidx();
  const int tok0 = lat ? b * 2048 + pos0 : NLAT + b * 256 + pos0;
  const size_t seqoff = lat ? ((size_t)b * 256 + c) * 2048 : (size_t)16 * 256 * 2048 + ((size_t)b * 256 + c) * 256;
  const float skip = P.hy_bias[l * 256 + c];
  for (int t8 = 0; t8 < 8; ++t8) {
    float y[8], u[8], x0[8];
    unpack8(*(const uint4*)(P.yT + seqoff + pos0 + t8 * 8), y);
    unpack8(*(const uint4*)(P.uT + seqoff + pos0 + t8 * 8), u);
    unpack8(*(const uint4*)(P.x0T + seqoff + pos0 + t8 * 8), x0);
#pragma unroll
    for (int k = 0; k < 8; ++k)
      P.Ybuf[(size_t)(tok0 + t8 * 8 + k) * 1024 + 512 + c] = f2bf((y[k] + u[k] * skip) * x0[k]);
  }
}

__device__ __forceinline__ void hyconv_task(const Params& P, int l, bool lat, int c, int tb, unsigned char* smem) {
  const int L = lat ? 2048 : 256;
  unsigned* g = (unsigned*)smem;
  const int tid = tidx(), lane = tid & 63, wave = tid >> 6;
  __syncthreads();
  {
    const uint4* src = (const uint4*)gtab_ptr(P, l, lat ? 0 : 1, c);
    const int n16 = (4 * L * 2) / 16;
    for (int i = tid; i < n16; i += NTHREADS) ((uint4*)g)[i] = src[i];
  }
  __syncthreads();
  const int m = lane & 15, quad = lane >> 4;
  const size_t seqbase = lat ? 0 : (size_t)16 * 256 * 2048;
  const bf16_t* ub = P.uT + seqbase + ((size_t)m * 256 + c) * L + quad * 8;
  const int t0 = tb + wave * 64;
  f32x4 acc[4];
#pragma unroll
  for (int i = 0; i < 4; ++i) acc[i] = (f32x4){0.f, 0.f, 0.f, 0.f};
  for (int s0 = 0; s0 < L; s0 += 256) {
    bf16x8 ufr[8];
#pragma unroll
    for (int q = 0; q < 8; ++q) ufr[q] = *(const bf16x8*)(ub + s0 + q * 32);
#pragma unroll
    for (int q = 0; q < 8; ++q) {
#pragma unroll
      for (int i = 0; i < 4; ++i) {
        int o = (L - 1) + s0 + q * 32 - (t0 + i * 16) + quad * 8 - m;
        const unsigned* gp = g + (o & 1) * L + (o >> 1);
        uint4 tv = make_uint4(gp[0], gp[1], gp[2], gp[3]);
        acc[i] = mfma16(as_bf8(tv), ufr[q], acc[i]);
      }
    }
  }
  bf16_t* yb = P.yT + seqbase + ((size_t)m * 256 + c) * L;
#pragma unroll
  for (int i = 0; i < 4; ++i) {
    uint2 v; v.x = pack2(acc[i][0], acc[i][1]); v.y = pack2(acc[i][2], acc[i][3]);
    *(uint2*)(yb + t0 + i * 16 + quad * 4) = v;
  }
}

template <bool LOCAL>
__device__ __forceinline__ void attn_task(const Params& P, int l, int b, int r, int c0, int h, int lane) {
  const int n = lane & 15, quad = lane >> 4;
  const int qtok = LOCAL ? (b * 2048 + r * 64 + c0 + n) : (NLAT + b * 256 + c0 + n);
  const bf16_t* pq = P.Pbuf + (size_t)qtok * PST + 512 + h * 64 + quad * 8;
  const uint4 q0 = *(const uint4*)pq, q1 = *(const uint4*)(pq + 32);
  const bf16x8 qp0 = as_bf8(q0), qp1 = as_bf8(q1);
  bf16x8 qr0 = qp0, qr1 = qp1;
  const int rs = min(max(r - 4, 0), 24), kc0 = min(max(c0 - 8, 0), 32);
  const int cq = c0 + n, cs_ = min(max(cq - 8, 0), 48);
  const float* rpb = P.na_rpb + ((size_t)l * 4 + h) * 15 * 31;
  if (LOCAL) {
    float x1[8], x2[8], a[8], bq[8];
    unpack8(q0, x1); unpack8(q1, x2);
    const int pos = (quad < 2) ? r : (c0 + n);
    const float* tc = P.ropetab + pos * 16 + (quad & 1) * 8;
    const float* ts = tc + 1024;
#pragma unroll
    for (int j = 0; j < 8; ++j) { float cs = tc[j], sn = ts[j]; a[j] = x1[j] * cs - x2[j] * sn; bq[j] = x1[j] * sn + x2[j] * cs; }
    qr0 = as_bf8(pack8(a)); qr1 = as_bf8(pack8(bq));
  }
  auto local_scores = [&](int g) -> f32x4 {
    const int i = g >> 1, half = g & 1;
    const int ktok = b * 2048 + (rs + i) * 64 + kc0 + half * 16 + n;
    const bf16_t* kp = P.krot + (size_t)ktok * 256 + h * 64 + quad * 8;
    f32x4 acc = (f32x4){0.f, 0.f, 0.f, 0.f};
    acc = mfma16(*(const bf16x8*)kp, qr0, acc);
    acc = mfma16(*(const bf16x8*)(kp + 32), qr1, acc);
    const float* rb = rpb + (rs + i - r + 7) * 31;
    f32x4 o;
#pragma unroll
    for (int rr = 0; rr < 4; ++rr) {
      int kcol = kc0 + half * 16 + quad * 4 + rr;
      bool valid = (kcol >= cs_) && (kcol < cs_ + 16);
      int bi = min(max(kcol - cq + 15, 0), 30);
      o[rr] = valid ? (acc[rr] * 0.125f + rb[bi]) : -1e30f;
    }
    return o;
  };
  auto ctx_scores = [&](int g) -> f32x4 {
    const int ktok = NLAT + b * 256 + g * 16 + n;
    const bf16_t* kp = P.Pbuf + (size_t)ktok * PST + 768 + h * 64 + quad * 8;
    f32x4 acc = (f32x4){0.f, 0.f, 0.f, 0.f};
    acc = mfma16(*(const bf16x8*)kp, qp0, acc);
    acc = mfma16(*(const bf16x8*)(kp + 32), qp1, acc);
    return acc * 0.125f;
  };
  float mx = -1e30f;
  if (LOCAL) {
#pragma unroll 2
    for (int g = 0; g < 16; ++g) { f32x4 v = local_scores(g); mx = fmaxf(mx, fmaxf(fmaxf(v[0], v[1]), fmaxf(v[2], v[3]))); }
  }
#pragma unroll 2
  for (int g = 0; g < 16; ++g) { f32x4 v = ctx_scores(g); mx = fmaxf(mx, fmaxf(fmaxf(v[0], v[1]), fmaxf(v[2], v[3]))); }
  mx = fmaxf(mx, __shfl_xor(mx, 16)); mx = fmaxf(mx, __shfl_xor(mx, 32));
  float sum = 0.f;
  f32x4 O[4];
#pragma unroll
  for (int i = 0; i < 4; ++i) O[i] = (f32x4){0.f, 0.f, 0.f, 0.f};
  if (LOCAL) {
#pragma unroll 1
    for (int i = 0; i < 8; ++i) {
      f32x4 va = local_scores(2 * i), vb = local_scores(2 * i + 1);
      float pa[4], pbv[4];
#pragma unroll
      for (int rr = 0; rr < 4; ++rr) { pa[rr] = __expf(va[rr] - mx); pbv[rr] = __expf(vb[rr] - mx); sum += pa[rr] + pbv[rr]; }
      uint4 pb; pb.x = pack2(pa[0], pa[1]); pb.y = pack2(pa[2], pa[3]); pb.z = pack2(pbv[0], pbv[1]); pb.w = pack2(pbv[2], pbv[3]);
      const int tbase = (rs + i) * 64 + kc0 + quad * 4;
#pragma unroll
      for (int dt = 0; dt < 4; ++dt) {
        const bf16_t* vp = P.vt_lat + ((size_t)(b * 4 + h) * 64 + dt * 16 + n) * 2048 + tbase;
        uint2 lo = *(const uint2*)vp, hi = *(const uint2*)(vp + 16);
        O[dt] = mfma16(as_bf8(make_uint4(lo.x, lo.y, hi.x, hi.y)), as_bf8(pb), O[dt]);
      }
    }
  }
#pragma unroll 1
  for (int k = 0; k < 8; ++k) {
    f32x4 va = ctx_scores(2 * k), vb = ctx_scores(2 * k + 1);
    float pa[4], pbv[4];
#pragma unroll
    for (int rr = 0; rr < 4; ++rr) { pa[rr] = __expf(va[rr] - mx); pbv[rr] = __expf(vb[rr] - mx); sum += pa[rr] + pbv[rr]; }
    uint4 pb; pb.x = pack2(pa[0], pa[1]); pb.y = pack2(pa[2], pa[3]); pb.z = pack2(pbv[0], pbv[1]); pb.w = pack2(pbv[2], pbv[3]);
#pragma unroll
    for (int dt = 0; dt < 4; ++dt) {
      const bf16_t* vp = P.vt_ctx + ((size_t)(b * 4 + h) * 64 + dt * 16 + n) * 256 + k * 32 + quad * 4;
      uint2 lo = *(const uint2*)vp, hi = *(const uint2*)(vp + 16);
      O[dt] = mfma16(as_bf8(make_uint4(lo.x, lo.y, hi.x, hi.y)), as_bf8(pb), O[dt]);
    }
  }
  sum += __shfl_xor(sum, 16); sum += __shfl_xor(sum, 32);
  const float inv = 1.f / sum;
  bf16_t* yo = P.Ybuf + (size_t)qtok * 1024 + 256 + h * 64 + quad * 4;
#pragma unroll
  for (int dt = 0; dt < 4; ++dt) {
    uint2 v; v.x = pack2(O[dt][0] * inv, O[dt][1] * inv); v.y = pack2(O[dt][2] * inv, O[dt][3] * inv);
    *(uint2*)(yo + dt * 16) = v;
  }
}

template <bool PASS3>
__device__ __forceinline__ void ssd_task(const Params& P, int l, int b, int g, int ch, unsigned char* smem) {
  _Float16* xs = (_Float16*)smem;
  _Float16* Bs = xs + 64 * 128;
  _Float16* Cs = Bs + 64 * 64;
  float* dts = (float*)(Cs + 64 * 64);
  float* decs = dts + 256;
  float* as_ = decs + 256;
  _Float16* yt = (_Float16*)(as_ + 256);
  const int tid = tidx();
  const bool lat = ch >= 4;
  const int len = lat ? 2048 : 256;
  const int pos0 = lat ? (ch - 4) * 64 : ch * 64;
  const int tok0 = lat ? b * 2048 + pos0 : NLAT + b * 256 + pos0;
  __syncthreads();
  {
    const int col = (tid < 128) ? g * 128 + tid : (tid < 192 ? 256 + g * 64 + (tid - 128) : 384 + g * 64 + (tid - 192));
    const float w0 = P.ssd_conv_w[(l * 3 + 0) * 512 + col], w1 = P.ssd_conv_w[(l * 3 + 1) * 512 + col], w2 = P.ssd_conv_w[(l * 3 + 2) * 512 + col];
    const float bs = P.ssd_conv_b[l * 512 + col];
    const bf16_t* pp = P.Pbuf + (size_t)tok0 * PST + 2304 + col;
    float pv = (pos0 > 0) ? bf2f(pp[-(ptrdiff_t)PST]) : 0.f;
    float cu = bf2f(pp[0]);
    _Float16* dst = (tid < 128) ? xs + tid : (tid < 192 ? Bs + (tid - 128) : Cs + (tid - 192));
    const int dstride = (tid < 128) ? 128 : 64;
    for (int t = 0; t < 64; ++t) {
      float nx = (pos0 + t + 1 < len) ? bf2f(pp[(size_t)(t + 1) * PST]) : 0.f;
      float v = siluf_(w0 * pv + w1 * cu + w2 * nx + bs);
      dst[t * dstride] = (_Float16)v;
      pv = cu; cu = nx;
    }
    {
      const int t = tid >> 2, k = tid & 3, dir = k >> 1, hh = k & 1, head = g * 2 + hh;
      float raw = P.dtbuf[(size_t)(tok0 + t) * 8 + dir * 4 + head] + P.ssd_dt_bias[(l * 2 + dir) * 4 + head];
      float dtv = (raw > 20.f) ? raw : log1pf(expf(raw));
      float a = -dtv * expf(P.ssd_a_log[(l * 2 + dir) * 4 + head]);
      dts[tid] = dtv; as_[tid] = a; decs[tid] = expf(a);
    }
    if (PASS3) for (int i = tid; i < 64 * 128; i += NTHREADS) yt[i] = (_Float16)0.f;
  }
  __syncthreads();
  const int hh = tid >> 7, p = (tid >> 1) & 63, nh = tid & 1;
  const int head = g * 2 + hh;
  float stf[32], stb[32];
  float* sf = P.sst + ((((size_t)b * 2 + 0) * 4 + head) * NCH + ch) * 4096 + p * 64 + nh * 32;
  float* sb = P.sst + ((((size_t)b * 2 + 1) * 4 + head) * NCH + ch) * 4096 + p * 64 + nh * 32;
  if (PASS3) {
#pragma unroll
    for (int i = 0; i < 8; ++i) {
      float4 a = *(const float4*)(sf + i * 4); stf[i * 4] = a.x; stf[i * 4 + 1] = a.y; stf[i * 4 + 2] = a.z; stf[i * 4 + 3] = a.w;
      float4 c = *(const float4*)(sb + i * 4); stb[i * 4] = c.x; stb[i * 4 + 1] = c.y; stb[i * 4 + 2] = c.z; stb[i * 4 + 3] = c.w;
    }
  } else {
#pragma unroll
    for (int i = 0; i < 32; ++i) { stf[i] = 0.f; stb[i] = 0.f; }
  }
  for (int k = 0; k < 64; ++k) {
    {
      const float dtv = dts[k * 4 + hh], dec = decs[k * 4 + hh];
      const float xd = (float)xs[k * 128 + hh * 64 + p] * dtv;
      const _Float16* br = Bs + k * 64 + nh * 32;
#pragma unroll
      for (int i = 0; i < 32; ++i) stf[i] = stf[i] * dec + xd * (float)br[i];
      if (PASS3) {
        const _Float16* cr = Cs + k * 64 + nh * 32;
        float y0 = 0.f, y1 = 0.f, y2 = 0.f, y3 = 0.f;
#pragma unroll
        for (int i = 0; i < 32; i += 4) { y0 += stf[i] * (float)cr[i]; y1 += stf[i + 1] * (float)cr[i + 1]; y2 += stf[i + 2] * (float)cr[i + 2]; y3 += stf[i + 3] * (float)cr[i + 3]; }
        float y = (y0 + y1) + (y2 + y3);
        y += __shfl_xor(y, 1);
        if (nh == 0) { _Float16* yp = yt + k * 128 + hh * 64 + p; *yp = (_Float16)((float)*yp + y); }
      }
    }
    {
      const int kk = 63 - k;
      const float dtv = dts[kk * 4 + 2 + hh], dec = decs[kk * 4 + 2 + hh];
      const float xd = (float)xs[kk * 128 + hh * 64 + p] * dtv;
      const _Float16* br = Bs + kk * 64 + nh * 32;
#pragma unroll
      for (int i = 0; i < 32; ++i) stb[i] = stb[i] * dec + xd * (float)br[i];
      if (PASS3) {
        const _Float16* cr = Cs + kk * 64 + nh * 32;
        float y0 = 0.f, y1 = 0.f, y2 = 0.f, y3 = 0.f;
#pragma unroll
        for (int i = 0; i < 32; i += 4) { y0 += stb[i] * (float)cr[i]; y1 += stb[i + 1] * (float)cr[i + 1]; y2 += stb[i + 2] * (float)cr[i + 2]; y3 += stb[i + 3] * (float)cr[i + 3]; }
        float y = (y0 + y1) + (y2 + y3);
        y += __shfl_xor(y, 1);
        if (nh == 0) { _Float16* yp = yt + kk * 128 + hh * 64 + p; *yp = (_Float16)((float)*yp + y); }
      }
    }
  }
  if (!PASS3) {
#pragma unroll
    for (int i = 0; i < 8; ++i) {
      *(float4*)(sf + i * 4) = make_float4(stf[i * 4], stf[i * 4 + 1], stf[i * 4 + 2], stf[i * 4 + 3]);
      *(float4*)(sb + i * 4) = make_float4(stb[i * 4], stb[i * 4 + 1], stb[i * 4 + 2], stb[i * 4 + 3]);
    }
    if (tid < 4) {
      const int dir = tid >> 1, h2 = tid & 1;
      float a = 0.f;
      for (int t = 0; t < 64; ++t) a += as_[t * 4 + tid];
      P.ssumA[(((size_t)b * 2 + dir) * 4 + g * 2 + h2) * NCH + ch] = a;
    }
  } else {
    __syncthreads();
    const int t = tid >> 2, part = tid & 3;
    const int hd = g * 2 + (part >> 1);
    const float dsk = P.ssd_d[l * 4 + hd];
    float val[32];
    float sq = 0.f;
    const bf16_t* zr = P.Pbuf + (size_t)(tok0 + t) * PST + 2048 + g * 128 + part * 32;
#pragma unroll
    for (int i = 0; i < 32; ++i) {
      int cc = part * 32 + i;
      float y = (float)yt[t * 128 + cc] + (float)xs[t * 128 + cc] * dsk;
      float z = bf2f(zr[i]);
      y *= siluf_(z);
      val[i] = y; sq += y * y;
    }
    sq += __shfl_xor(sq, 1); sq += __shfl_xor(sq, 2);
    const float rinv = rsqrtf(sq * (1.f / 128.f) + LN_EPS);
    bf16_t* yo = P.Ybuf + (size_t)(tok0 + t) * 1024 + 768 + g * 128 + part * 32;
    const float* ngp = P.ssd_norm_g + l * 256 + g * 128 + part * 32;
#pragma unroll
    for (int i8 = 0; i8 < 4; ++i8) {
      float f[8];
#pragma unroll
      for (int j = 0; j < 8; ++j) f[j] = val[i8 * 8 + j] * rinv * ngp[i8 * 8 + j];
      *(uint4*)(yo + i8 * 8) = pack8(f);
    }
  }
}

__device__ __forceinline__ void ssd_prefix_task(const Params& P, int bdh, int part) {
  const int dir = (bdh >> 2) & 1;
  float* base = P.sst + (size_t)bdh * NCH * 4096 + part * 256 + tidx();
  const float* sa = P.ssumA + (size_t)bdh * NCH;
  float carry = 0.f;
  for (int i = 0; i < NCH; ++i) {
    int ch = dir ? (i < 4 ? 3 - i : 39 - i) : i;
    float loc = base[(size_t)ch * 4096];
    base[(size_t)ch * 4096] = carry;
    carry = expf(sa[ch]) * carry + loc;
  }
}

__device__ __forceinline__ int f2key(float f) { int b = __float_as_int(f); return b ^ ((b >> 31) & 0x7FFFFFFF); }
__device__ __forceinline__ float key2f(int k) { return __int_as_float(k ^ ((k >> 31) & 0x7FFFFFFF)); }
#define CE_DESC(a, b) { int _x = max(a, b); int _y = min(a, b); a = _x; b = _y; }
#define CE_ASC(a, b) { int _x = min(a, b); int _y = max(a, b); a = _x; b = _y; }
__device__ __forceinline__ void sort16_desc(int* a) {
#pragma unroll
  for (int k = 2; k <= 16; k <<= 1)
#pragma unroll
    for (int j = k >> 1; j > 0; j >>= 1)
#pragma unroll
      for (int i = 0; i < 16; ++i) {
        int lq = i ^ j;
        if (lq > i) { if ((i & k) == 0) CE_DESC(a[i], a[lq]) else CE_ASC(a[i], a[lq]) }
      }
}
__device__ __forceinline__ void merge16_desc(int* a, const int* b) {
#pragma unroll
  for (int i = 0; i < 16; ++i) a[i] = max(a[i], b[15 - i]);
#pragma unroll
  for (int j = 8; j > 0; j >>= 1)
#pragma unroll
    for (int i = 0; i < 16; ++i) {
      int lq = i ^ j;
      if (lq > i) CE_DESC(a[i], a[lq])
    }
}

__device__ __forceinline__ void gemm_acc32(const bf16_t* __restrict__ A, int lda, const bf16_t* __restrict__ Bt, int ldb,
                                           int K, int m0, int n0, unsigned char* smem, f32x4 (&acc)[4][4]) {
  bf16_t* As = (bf16_t*)smem;
  bf16_t* Bs = As + 2 * 128 * 40;
  const int tid = tidx(), lane = tid & 63, wave = tid >> 6;
  const int wm = wave >> 1, wn = wave & 1;
  const int lr = tid >> 1, lh = tid & 1;
  const bf16_t* ag = A + (size_t)(m0 + lr) * lda + lh * 16;
  const bf16_t* bg = Bt + (size_t)(n0 + lr) * ldb + lh * 16;
#pragma unroll
  for (int i = 0; i < 4; ++i)
#pragma unroll
    for (int j = 0; j < 4; ++j) acc[i][j] = (f32x4){0.f, 0.f, 0.f, 0.f};
  uint4 ra0 = *(const uint4*)ag, ra1 = *(const uint4*)(ag + 8);
  uint4 rb0 = *(const uint4*)bg, rb1 = *(const uint4*)(bg + 8);
  __syncthreads();
  {
    bf16_t* pa = As + lr * 40 + lh * 16; bf16_t* pb = Bs + lr * 40 + lh * 16;
    *(uint4*)pa = ra0; *(uint4*)(pa + 8) = ra1; *(uint4*)pb = rb0; *(uint4*)(pb + 8) = rb1;
  }
  __syncthreads();
  const int nk = K >> 5;
  for (int kt = 0; kt < nk; ++kt) {
    const int cur = kt & 1;
    if (kt + 1 < nk) {
      const bf16_t* a2 = ag + (kt + 1) * 32; const bf16_t* b2 = bg + (kt + 1) * 32;
      ra0 = *(const uint4*)a2; ra1 = *(const uint4*)(a2 + 8); rb0 = *(const uint4*)b2; rb1 = *(const uint4*)(b2 + 8);
    }
    const bf16_t* as = As + cur * 5120 + (wm * 64 + (lane & 15)) * 40 + (lane >> 4) * 8;
    const bf16_t* bs = Bs + cur * 5120 + (wn * 64 + (lane & 15)) * 40 + (lane >> 4) * 8;
    bf16x8 afr[4];
#pragma unroll
    for (int j = 0; j < 4; ++j) afr[j] = *(const bf16x8*)(bs + j * 16 * 40);
#pragma unroll
    for (int i = 0; i < 4; ++i) {
      const bf16x8 bfr = *(const bf16x8*)(as + i * 16 * 40);
#pragma unroll
      for (int j = 0; j < 4; ++j) acc[i][j] = mfma16(afr[j], bfr, acc[i][j]);
    }
    if (kt + 1 < nk) {
      bf16_t* pa = As + (cur ^ 1) * 5120 + lr * 40 + lh * 16; bf16_t* pb = Bs + (cur ^ 1) * 5120 + lr * 40 + lh * 16;
      *(uint4*)pa = ra0; *(uint4*)(pa + 8) = ra1; *(uint4*)pb = rb0; *(uint4*)(pb + 8) = rb1;
    }
    __syncthreads();
  }
}

__device__ __forceinline__ void peer_topk_task(const Params& P, int l, int tm, int h, unsigned char* smem) {
  float* sc = (float*)smem;
  int* fin = (int*)(smem + 33280);
  const int tid = tidx(), lane = tid & 63, wave = tid >> 6;
  const int wm = wave >> 1, wn = wave & 1;
  const int row64 = tid & 63, quarter = tid >> 6;
  int* K1 = (int*)(smem + 40960);
  int* K2a = (int*)(smem + 49152);
#pragma unroll
  for (int pp = 0; pp < 2; ++pp) {
    const bf16_t* A = P.qbuf + (h * 2 + pp) * 128;
    const bf16_t* Bt = P.keysb + ((size_t)(l * 8 + h) * 2 + pp) * 128 * 128;
#pragma unroll 1
    for (int half = 0; half < 2; ++half) {
      {
        f32x4 acc[4][4];
        gemm_acc32(A, 2048, Bt, 128, 128, tm * 128, 0, smem, acc);
        if (wm == half) {
#pragma unroll
          for (int i = 0; i < 4; ++i)
#pragma unroll
            for (int j = 0; j < 4; ++j) {
              float* d = sc + (i * 16 + (lane & 15)) * 129 + wn * 64 + j * 16 + (lane >> 4) * 4;
              d[0] = acc[i][j][0]; d[1] = acc[i][j][1]; d[2] = acc[i][j][2]; d[3] = acc[i][j][3];
            }
        }
      }
      __syncthreads();
      int run[16];
#pragma unroll
      for (int i = 0; i < 16; ++i) run[i] = (int)0x80000000;
#pragma unroll 1
      for (int grp = 0; grp < 2; ++grp) {
        int cur[16];
#pragma unroll
        for (int i = 0; i < 16; ++i) {
          int col = quarter * 32 + grp * 16 + i;
          cur[i] = (f2key(sc[row64 * 129 + col]) & ~127) | col;
        }
        sort16_desc(cur);
        merge16_desc(run, cur);
      }
      if (quarter != 0) {
#pragma unroll
        for (int i = 0; i < 16; ++i) sc[row64 * 129 + quarter * 32 + i] = __int_as_float(run[i]);
      }
      __syncthreads();
      if (quarter == 0) {
#pragma unroll 1
        for (int q = 1; q < 4; ++q) {
          int oth[16];
#pragma unroll
          for (int i = 0; i < 16; ++i) oth[i] = __float_as_int(sc[row64 * 129 + q * 32 + i]);
          merge16_desc(run, oth);
        }
        if (half == 0) {
#pragma unroll
          for (int i = 0; i < 16; ++i) { if (pp == 0) K1[row64 * 16 + i] = run[i]; else K2a[row64 * 16 + i] = run[i]; }
        } else {
#pragma unroll
          for (int i = 0; i < 16; ++i) fin[row64 * 16 + i] = run[i];
        }
      }
      __syncthreads();
    }
    if (pp == 0 && tid >= 64 && tid < 128) {
#pragma unroll
      for (int i = 0; i < 16; ++i) K1[tid * 16 + i] = fin[(tid - 64) * 16 + i];
    }
    __syncthreads();
  }
  const int row = tid & 127, half = tid >> 7;
  int* lists = (int*)smem;
  if (half == 0) {
#pragma unroll
    for (int i = 0; i < 16; ++i) { lists[row * 33 + i] = K1[row * 16 + i]; lists[row * 33 + 16 + i] = (row < 64) ? K2a[row * 16 + i] : fin[(row - 64) * 16 + i]; }
  }
  if (half == 0) {
    float v2[16];
#pragma unroll
    for (int i = 0; i < 16; ++i) v2[i] = key2f(lists[row * 33 + 16 + i] & ~127);
    int run[16];
    {
      const float v0 = key2f(lists[row * 33] & ~127);
#pragma unroll
      for (int j = 0; j < 16; ++j) run[j] = (f2key(v0 + v2[j]) & ~255) | (15 - j);
    }
#pragma unroll 1
    for (int i = 1; i < 16; ++i) {
      int cur[16];
      const float vi = key2f(lists[row * 33 + i] & ~127);
#pragma unroll
      for (int j = 0; j < 16; ++j) cur[j] = (f2key(vi + v2[j]) & ~255) | (i * 16 + 15 - j);
      merge16_desc(run, cur);
    }
    const float c0 = key2f(run[0] & ~255);
    float sum = 0.f;
#pragma unroll
    for (int k = 0; k < 16; ++k) sum += __expf(key2f(run[k] & ~255) - c0);
    const float inv = 1.f / sum;
    const int T = tm * 128 + row;
    int* eo = P.eidx + (size_t)T * 128 + h * 16;
    float* go = P.egate + (size_t)T * 128 + h * 16;
#pragma unroll
    for (int k = 0; k < 16; ++k) {
      int ci = run[k] & 255;
      int i = ci >> 4, j = 15 - (ci & 15);
      int i1 = lists[row * 33 + i] & 127, i2 = lists[row * 33 + 16 + j] & 127;
      eo[k] = i1 * 128 + i2;
      go[k] = __expf(key2f(run[k] & ~255) - c0) * inv;
    }
  }
}

#define XB_TMO      128
#define XB_XCNT(j)  (256  + 64 * (j))
#define XB_XSUB(j)  (1280 + 64 * (j))
#define XB_XGEN(j)  (2304 + 64 * (j))
#define XB_TOP      3328
#define XB_TOPGEN   3392
#define XCD_BAR_WORDS 3456
#define XB_SPIN_CAP (1u << 18)
#define LAS __attribute__((address_space(3)))

__device__ __forceinline__ unsigned xb_ld(unsigned* p)              { return __hip_atomic_load(p, __ATOMIC_RELAXED, __HIP_MEMORY_SCOPE_AGENT); }
__device__ __forceinline__ unsigned xb_add(unsigned* p, unsigned v) { return __hip_atomic_fetch_add(p, v, __ATOMIC_RELAXED, __HIP_MEMORY_SCOPE_AGENT); }
__device__ __forceinline__ unsigned xb_xcc_id() { return (unsigned)__builtin_amdgcn_s_getreg((3 << 11) | 20) & 0xFu; }
#define XB_SPIN(cond, bar) do { unsigned _sp = 0; while (cond) { __builtin_amdgcn_s_sleep(1); \
    if ((++_sp & 255u) == 0u) { if (xb_ld(&(bar)[XB_TMO])) break; if (_sp > XB_SPIN_CAP) { atomicAdd(&(bar)[XB_TMO], 1u); break; } } } } while (0)

struct XcdBarrier {
    unsigned* bar; unsigned x;
    volatile LAS unsigned* st;
};

__device__ __forceinline__ XcdBarrier xcd_barrier_post(unsigned* bar, volatile LAS unsigned* st) {
    XcdBarrier b; b.bar = bar; b.x = xb_xcc_id(); b.st = st;
    if (threadIdx.x == 0) (void)xb_add(&bar[XB_XCNT(b.x)], 1u);
    return b;
}
__device__ __forceinline__ void xcd_barrier_complete(unsigned* bar, unsigned x, unsigned& nloc, unsigned& nx) {
    const unsigned G = gridDim.x * gridDim.y * gridDim.z;
    unsigned sum, cnt, mine, sp = 0u;
    for (;;) {
        sum = 0u; cnt = 0u; mine = 0u;
#pragma unroll
        for (unsigned j = 0; j < 16; ++j) { const unsigned c = xb_ld(&bar[XB_XCNT(j)]); sum += c; cnt += (c > 0u) ? 1u : 0u; mine = (j == x) ? c : mine; }
        if (sum == G) break;
        __builtin_amdgcn_s_sleep(1);
        if ((++sp & 255u) == 0u) { if (xb_ld(&bar[XB_TMO])) break; if (sp > XB_SPIN_CAP) { atomicAdd(&bar[XB_TMO], 1u); break; } }
    }
    nloc = mine > 0u ? mine : 1u; nx = cnt > 0u ? cnt : 1u;
}

__device__ __forceinline__ void xcd_barrier(const XcdBarrier& b) {
    asm volatile("s_waitcnt vmcnt(0)" ::: "memory");
    __syncthreads();
    if (threadIdx.x == 0) {
        unsigned* bar = b.bar;
        __builtin_amdgcn_s_waitcnt(0);
        unsigned nloc = b.st[0], nx = b.st[1];
        if (nloc == 0u) { xcd_barrier_complete(bar, b.x, nloc, nx); b.st[0] = nloc; b.st[1] = nx; }
        const unsigned old = xb_add(&bar[XB_XSUB(b.x)], 1u);
        const unsigned gen = old / nloc;
        if (old + 1u == (gen + 1u) * nloc) {
            __builtin_amdgcn_fence(__ATOMIC_RELEASE, "agent");
            asm volatile("s_waitcnt vmcnt(0)" ::: "memory");
            const unsigned og = xb_add(&bar[XB_TOP], 1u);
            const unsigned tg = og / nx;
            if (og + 1u == (tg + 1u) * nx) xb_add(&bar[XB_TOPGEN], 1u);
            else XB_SPIN(xb_ld(&bar[XB_TOPGEN]) == tg, bar);
            __builtin_amdgcn_fence(__ATOMIC_ACQUIRE, "agent");
            xb_add(&bar[XB_XGEN(b.x)], 1u);
            asm volatile("s_waitcnt vmcnt(0)" ::: "memory");
        } else {
            XB_SPIN(xb_ld(&bar[XB_XGEN(b.x)]) == gen, bar);
            __builtin_amdgcn_fence(__ATOMIC_ACQUIRE, "agent");
            asm volatile("s_waitcnt vmcnt(0)" ::: "memory");
        }
    }
    __syncthreads();
}


__device__ __forceinline__ int next_task(unsigned* cnt, int* slot) {
  __syncthreads();
  if (tidx() == 0) *slot = (int)__hip_atomic_fetch_add(cnt, 1u, __ATOMIC_RELAXED, __HIP_MEMORY_SCOPE_AGENT);
  __syncthreads();
  return *slot;
}
enum { PH_PRE0 = 0, PH_PRE1, PH_PRE2, PH_L1, PH_L2, PH_L3, PH_L4, PH_L5, PH_L6, PH_L7, PH_L8, PH_L9, PH_L9W, PH_L9B, PH_L9C, PH_COUNT };
struct XInfo { int slot, nx, rank, nloc; };
#define QCNT(i) (XCD_BAR_WORDS + 16 * 64 + 64 * (i))

template <int ph>
__device__ __forceinline__ void run_phase(const Params& P, const XInfo& X, int l, unsigned char* smem, const bool rep = false) {
  const int nb = gridDim.x, bid = blockIdx.x, tid = tidx(), lane = tid & 63, wave = tid >> 6;
  const int rbid = nb - 1 - bid;
  __shared__ int sQ;
  const int ntok = (l == 0) ? NTOK : NLAT;
  const int mt_out = ntok / 128;
  switch (ph) {
    case PH_PRE0: {
      for (int u = bid; u < 768; u += nb) modpart_task(P, u / 384, (u / 24) % 16, u % 24, smem);
      for (int u = rbid; u < 2 * 46 * 16; u += nb) { int ll = u / 736, r = u % 736; transpose_task(P.w_in + (size_t)ll * 1024 * 2824, P.wt_in + (size_t)ll * 2944 * 1024, 1024, 2824, (r % 16) * 64, (r / 16) * 64, smem); }
      for (int u = bid; u < 2 * 16 * 16; u += nb) { int ll = u / 256, r = u % 256; transpose_task(P.w_out + (size_t)ll * 1024 * 1024, P.wt_out + (size_t)ll * 1024 * 1024, 1024, 1024, (r % 16) * 64, (r / 16) * 64, smem); }
      for (int u = rbid; u < 2 * 32 * 16; u += nb) { int ll = u / 512, r = u % 512; transpose_task(P.peer_wq + (size_t)ll * 1024 * 2048, P.wt_q + (size_t)ll * 2048 * 1024, 1024, 2048, (r % 16) * 64, (r / 16) * 64, smem); }
      for (int u = bid; u < 256; u += nb) {
        size_t o = ((size_t)u * 256 + tid) * 8; float f[8];
#pragma unroll
        for (int j = 0; j < 8; ++j) f[j] = P.peer_keys[o + j];
        *(uint4*)(P.keysb + o) = pack8(f);
      }
      for (int u = rbid; u < 2 * 576; u += nb) { int ll = u / 576, r = u % 576; if (r < 512) hm2_task(P, ll, 0, r, smem); else hm2_task(P, ll, 1, r - 512, smem); }
      if (bid == nb - 1) {
        for (int i = tid; i < 1024; i += NTHREADS) {
          int pos = i >> 4, f = i & 15;
          float inv = powf(10000.f, -(float)f / 16.f);
          float ang = (float)pos * inv;
          P.ropetab[i] = cosf(ang); P.ropetab[1024 + i] = sinf(ang);
        }
      }
    } break;
    case PH_PRE1: {
      for (int t = bid; t < 816; t += nb) {
        int i = t * 256 + tid;
        int ll = i / (17 * 6144), rem = i % (17 * 6144), col = rem % 6144;
        float a = P.b_ada[ll * 6144 + col];
#pragma unroll
        for (int ks = 0; ks < 16; ++ks) a += P.modp[((size_t)ll * 16 + ks) * 17 * 6144 + rem];
        P.mod[i] = a;
      }
      for (int u = rbid; u < 2048; u += nb) filt_task(P, u >> 10, (u >> 9) & 1, u & 511, smem);
    } break;
    case PH_PRE2: {
      for (int T = bid * 4 + wave; T < NTOK; T += nb * 4) hmod0_token(P, T, lane);
    } break;
    case PH_L1: {
      const int ntile = (NTOK / 128) * 23;
      bf16_t* Pb = P.Pbuf; float* dtb = P.dtbuf;
      const bf16_t* Ain = P.Ybuf; const bf16_t* Win = P.wt_in + (size_t)l * 2944 * 1024;
      for (int t = bid; t < ntile; t += nb) {
        int tm = t / 23, tn = t % 23;
        gemm_tile32(Ain, 1024, Win, 1024, 1024, tm * 128, tn * 128, smem, [&](int m, int n, f32x4 v) {
          if (n < 2816) { st_nt_u2(Pb + (size_t)m * PST + n, pack2(v[0], v[1]), pack2(v[2], v[3])); }
          else if (n < 2824) { *(float4*)(dtb + (size_t)m * 8 + (n - 2816)) = make_float4(v[0], v[1], v[2], v[3]); }
        });
      }
    } break;
    case PH_L2: {
      const int nS = NB * 2 * NCH, nCf = 512 + (l == 0 ? 64 : 0), nPr = 576;
      unsigned* cnt = P.bar + QCNT(l * 3 + 0);
      for (;;) {
        int u = next_task(cnt, &sQ);
        if (u >= nS + nCf + nPr) break;
        if (u < nS) { ssd_task<false>(P, l, u / (2 * NCH), (u / NCH) & 1, u % NCH, smem); continue; }
        u -= nS;
        if (u < nCf) { if (u < 512) conf_task(P, l, (u >> 5) * 2048, 2048, (u & 31) * 64, smem); else { int v = u - 512; conf_task(P, l, NLAT + (v >> 2) * 256, 256, (v & 3) * 64, smem); } continue; }
        u -= nCf;
        if (u < 512) prep_task(P, l, true, u >> 5, (u & 31) * 64); else { int v = u - 512; prep_task(P, l, false, v >> 2, (v & 3) * 64); }
      }
    } break;
    case PH_L3: {
      const int nH = 2048 + (l == 0 ? 256 : 0), nA = 2048, nAc = (l == 0 ? 256 : 0), nPf = rep ? 0 : 2048;
      unsigned* cnt = P.bar + QCNT(l * 3 + 1);
      for (;;) {
        int u = next_task(cnt, &sQ);
        if (u >= nH + nA + nAc + nPf) break;
        if (u < nH) { if (u < 2048) hyconv_task(P, l, true, u >> 3, (u & 7) * 256, smem); else hyconv_task(P, l, false, u - 2048, 0, smem); continue; }
        u -= nH;
        if (u < nA) { int b = u >> 7, r = (u >> 2) & 31, c0 = (u & 3) * 16; attn_task<true>(P, l, b, r, c0, wave, lane); continue; }
        u -= nA;
        if (u < nAc) { attn_task<false>(P, l, u >> 4, 0, (u & 15) * 16, wave, lane); continue; }
        u -= nAc;
        ssd_prefix_task(P, u >> 4, u & 15);
      }
    } break;
    case PH_L4: {
      const int nS = (l == 0) ? NB * 2 * NCH : NB * 2 * 32, nHf = 512 + (l == 0 ? 64 : 0);
      unsigned* cnt = P.bar + QCNT(l * 3 + 2);
      for (;;) {
        int u = next_task(cnt, &sQ);
        if (u >= nS + nHf) break;
        if (u < nS) {
          if (l == 0) ssd_task<true>(P, l, u / (2 * NCH), (u / NCH) & 1, u % NCH, smem);
          else ssd_task<true>(P, l, u / 64, (u / 32) & 1, 4 + (u % 32), smem);
          continue;
        }
        u -= nS;
        if (u < 512) hyfin_task(P, l, true, u >> 5, (u & 31) * 64); else { int v = u - 512; hyfin_task(P, l, false, v >> 2, (v & 3) * 64); }
      }
    } break;
    case PH_L5: {
      const int ng = mt_out * 8;
      bf16_t* Yo = P.Pbuf;
      const bf16_t* Ain = P.Ybuf; const bf16_t* Wt = P.wt_out + (size_t)l * 1024 * 1024;
      for (int t = bid; t < ng; t += nb) {
        int tm = t >> 3, tn = t & 7;
        gemm_tile32(Ain, 1024, Wt, 1024, 1024, tm * 128, tn * 128, smem, [&](int m, int n, f32x4 v) {
          st_nt_u2(Yo + (size_t)m * 1024 + n, pack2(v[0], v[1]), pack2(v[2], v[3]));
        });
      }
      for (int u = rbid; u < 4096; u += nb) {
        const bool isv = u >= 2048;
        const int e0 = (u & 2047) * 8;
        const float* src = (isv ? P.peer_v : P.peer_u) + (size_t)l * 16384 * 1024 + (size_t)e0 * 1024;
        unsigned char* dstb = (unsigned char*)(isv ? P.tabv : P.tabu);
#pragma unroll
        for (int i = 0; i < 2; ++i) {
          int o = (i * 256 + tid) * 16;
          float4 a = *(const float4*)(src + o), bq = *(const float4*)(src + o + 4), c = *(const float4*)(src + o + 8), d = *(const float4*)(src + o + 12);
          uint4 r;
          r.x = pack4_fp8(a.x * 256.f, a.y * 256.f, a.z * 256.f, a.w * 256.f);
          r.y = pack4_fp8(bq.x * 256.f, bq.y * 256.f, bq.z * 256.f, bq.w * 256.f);
          r.z = pack4_fp8(c.x * 256.f, c.y * 256.f, c.z * 256.f, c.w * 256.f);
          r.w = pack4_fp8(d.x * 256.f, d.y * 256.f, d.z * 256.f, d.w * 256.f);
          *(uint4*)(dstb + (size_t)e0 * 1024 + o) = r;
        }
      }
    } break;
    case PH_L6: {
      for (int T = bid * 4 + wave; T < ntok; T += nb * 4) r1_token(P, l, T, lane, rep);
    } break;
    case PH_L7: {
      const int ng = mt_out * 16;
      bf16_t* Q = P.qbuf;
      for (int t = bid; t < ng; t += nb) {
        int tm = t >> 4, tn = t & 15;
        gemm_tile32(P.Ybuf, 1024, P.wt_q + (size_t)l * 2048 * 1024, 1024, 1024, tm * 128, tn * 128, smem, [&](int m, int n, f32x4 v) {
          st_nt_u2(Q + (size_t)m * 2048 + n, pack2(v[0], v[1]), pack2(v[2], v[3]));
        });
      }
    } break;
    case PH_L8: {
      const int ng = mt_out * 8;
      for (int t = bid; t < ng; t += nb) peer_topk_task(P, l, t >> 3, t & 7, smem);
    } break;
    case PH_L9: {
      float* wl = (float*)smem + wave * 128;
      __syncthreads();
      for (int T0 = bid * 4 + wave; T0 < ntok; T0 += nb * 4) { const int T = __builtin_amdgcn_readfirstlane(T0); peer_token(P, l, T, lane, wl, false); }
    } break;
    case PH_L9W: {
      const size_t n = (size_t)ntok * 128;
      for (size_t i = (size_t)bid * 256 + tid; i < n; i += (size_t)nb * 256) {
        float a = 0.f;
#pragma unroll
        for (int x = 0; x < 8; ++x) a += P.pact[(size_t)x * NTOK * 128 + i];
        P.egate[i] = P.egate[i] * gelu_tanh(a * (1.f / 256.f));
      }
    } break;
    case PH_L9B: {
      int* li = (int*)smem + wave * 1024;
      __syncthreads();
      for (int sl = X.slot; sl < 8; sl += X.nx)
        { const int pw = (ntok + X.nloc * 4 - 1) / (X.nloc * 4); const int tf = __builtin_amdgcn_readfirstlane((X.rank * 4 + wave) * pw); peer_v_phase(P, sl, tf, 1, min(ntok, tf + pw), lane, li); }
    } break;
    case PH_L9C: {
      for (int T0 = bid * 4 + wave; T0 < ntok; T0 += nb * 4) { const int T = __builtin_amdgcn_readfirstlane(T0); ln2_token(P, l, T, lane); }
    } break;
  }
}

#if MULTI_LAUNCH
__global__ void __launch_bounds__(NTHREADS) phase_kernel(Params P, int ph, int l) {
  extern __shared__ __attribute__((aligned(16))) unsigned char smem[];
  __shared__ Params sP;
  if (threadIdx.x == 0) sP = P;
  __syncthreads();
  switch (ph) {
    case 0: run_phase<0>(sP, sX, l, smem); break; case 1: run_phase<1>(sP, sX, l, smem); break; case 2: run_phase<2>(sP, sX, l, smem); break;
    case 3: run_phase<3>(sP, sX, l, smem); break; case 4: run_phase<4>(sP, sX, l, smem); break; case 5: run_phase<5>(sP, sX, l, smem); break;
    case 6: run_phase<6>(sP, sX, l, smem); break; case 7: run_phase<7>(sP, sX, l, smem); break; case 8: run_phase<8>(sP, sX, l, smem); break;
    case 9: run_phase<9>(sP, sX, l, smem); break; case 10: run_phase<10>(sP, sX, l, smem); break; case 11: run_phase<11>(sP, sX, l, smem); break;
  }
}
#else
__global__ void __launch_bounds__(NTHREADS, 3) mega_kernel(Params P) {
  extern __shared__ __attribute__((aligned(16))) unsigned char smem[];
  cg::grid_group grid = cg::this_grid();
  __shared__ uint4 xb_words;
  if (threadIdx.x == 0) xb_words = make_uint4(0u, 0u, 0u, 0u);
  __syncthreads();
  XcdBarrier xb = xcd_barrier_post(P.bar, (volatile LAS unsigned*)&xb_words);
  __shared__ XInfo sX;
  if (threadIdx.x == 0) sX.rank = (int)xb_add(&P.bar[XCD_BAR_WORDS + 64 * xb.x], 1u);
  run_phase<PH_PRE0>(P, sX, 0, smem);
  if (P.bar == nullptr) grid.sync();
  xcd_barrier(xb);
  if (threadIdx.x == 0) {
    int slot = 0, nx = 0, nloc = 1;
    for (unsigned j = 0; j < 16; ++j) {
      const int c = (int)xb_ld(&P.bar[XCD_BAR_WORDS + 64 * j]);
      if (c > 0) { if (j < xb.x) ++slot; ++nx; }
      if (j == xb.x) nloc = c > 0 ? c : 1;
    }
    sX.slot = slot; sX.nx = nx > 0 ? nx : 1; sX.nloc = nloc;
  }
  __syncthreads();
  run_phase<PH_PRE1>(P, sX, 0, smem); xcd_barrier(xb);
  run_phase<PH_PRE2>(P, sX, 0, smem); xcd_barrier(xb);
  {
    constexpr int l = 0;
    run_phase<PH_L1>(P, sX, l, smem); xcd_barrier(xb);
#if defined(REPEAT_PH)
    if (REPEAT_PH == PH_L1) { run_phase<PH_L1>(P, sX, l, smem, true); xcd_barrier(xb); }
#endif
    run_phase<PH_L2>(P, sX, l, smem); xcd_barrier(xb);
#if defined(REPEAT_PH)
    if (REPEAT_PH == PH_L2) { run_phase<PH_L2>(P, sX, l, smem, true); xcd_barrier(xb); }
#endif
    run_phase<PH_L3>(P, sX, l, smem); xcd_barrier(xb);
#if defined(REPEAT_PH)
    if (REPEAT_PH == PH_L3) { run_phase<PH_L3>(P, sX, l, smem, true); xcd_barrier(xb); }
#endif
    run_phase<PH_L4>(P, sX, l, smem); xcd_barrier(xb);
#if defined(REPEAT_PH)
    if (REPEAT_PH == PH_L4) { run_phase<PH_L4>(P, sX, l, smem, true); xcd_barrier(xb); }
#endif
    run_phase<PH_L5>(P, sX, l, smem); xcd_barrier(xb);
#if defined(REPEAT_PH)
    if (REPEAT_PH == PH_L5) { run_phase<PH_L5>(P, sX, l, smem, true); xcd_barrier(xb); }
#endif
    run_phase<PH_L6>(P, sX, l, smem); xcd_barrier(xb);
#if defined(REPEAT_PH)
    if (REPEAT_PH == PH_L6) { run_phase<PH_L6>(P, sX, l, smem, true); xcd_barrier(xb); }
#endif
    run_phase<PH_L7>(P, sX, l, smem); xcd_barrier(xb);
#if defined(REPEAT_PH)
    if (REPEAT_PH == PH_L7) { run_phase<PH_L7>(P, sX, l, smem, true); xcd_barrier(xb); }
#endif
    run_phase<PH_L8>(P, sX, l, smem); xcd_barrier(xb);
#if defined(REPEAT_PH)
    if (REPEAT_PH == PH_L8) { run_phase<PH_L8>(P, sX, l, smem, true); xcd_barrier(xb); }
#endif
    run_phase<PH_L9>(P, sX, l, smem); xcd_barrier(xb);
#if defined(REPEAT_PH)
    if (REPEAT_PH == PH_L9) { run_phase<PH_L9>(P, sX, l, smem, true); xcd_barrier(xb); }
#endif
  }
  {
    constexpr int l = 1;
    run_phase<PH_L1>(P, sX, l, smem); xcd_barrier(xb);
#if defined(REPEAT_PH)
    if (REPEAT_PH == PH_L1) { run_phase<PH_L1>(P, sX, l, smem, true); xcd_barrier(xb); }
#endif
    run_phase<PH_L2>(P, sX, l, smem); xcd_barrier(xb);
#if defined(REPEAT_PH)
    if (REPEAT_PH == PH_L2) { run_phase<PH_L2>(P, sX, l, smem, true); xcd_barrier(xb); }
#endif
    run_phase<PH_L3>(P, sX, l, smem); xcd_barrier(xb);
#if defined(REPEAT_PH)
    if (REPEAT_PH == PH_L3) { run_phase<PH_L3>(P, sX, l, smem, true); xcd_barrier(xb); }
#endif
    run_phase<PH_L4>(P, sX, l, smem); xcd_barrier(xb);
#if defined(REPEAT_PH)
    if (REPEAT_PH == PH_L4) { run_phase<PH_L4>(P, sX, l, smem, true); xcd_barrier(xb); }
#endif
    run_phase<PH_L5>(P, sX, l, smem); xcd_barrier(xb);
#if defined(REPEAT_PH)
    if (REPEAT_PH == PH_L5) { run_phase<PH_L5>(P, sX, l, smem, true); xcd_barrier(xb); }
#endif
    run_phase<PH_L6>(P, sX, l, smem); xcd_barrier(xb);
#if defined(REPEAT_PH)
    if (REPEAT_PH == PH_L6) { run_phase<PH_L6>(P, sX, l, smem, true); xcd_barrier(xb); }
#endif
    run_phase<PH_L7>(P, sX, l, smem); xcd_barrier(xb);
#if defined(REPEAT_PH)
    if (REPEAT_PH == PH_L7) { run_phase<PH_L7>(P, sX, l, smem, true); xcd_barrier(xb); }
#endif
    run_phase<PH_L8>(P, sX, l, smem); xcd_barrier(xb);
#if defined(REPEAT_PH)
    if (REPEAT_PH == PH_L8) { run_phase<PH_L8>(P, sX, l, smem, true); xcd_barrier(xb); }
#endif
    run_phase<PH_L9>(P, sX, l, smem); xcd_barrier(xb);
#if defined(REPEAT_PH)
    if (REPEAT_PH == PH_L9) { run_phase<PH_L9>(P, sX, l, smem, true); xcd_barrier(xb); }
#endif
  }
}
#endif

extern "C" void kernel_launch(void* const* d_in, const int* in_sizes, int n_in, void* d_out, int out_size, void* d_ws, size_t ws_size, hipStream_t stream) {
  Params P{};
  const float** pf = (const float**)&P;
  for (int i = 0; i < 36; ++i) pf[i] = (const float*)d_in[i];
  P.out = (float*)d_out;
  unsigned char* w = (unsigned char*)d_ws;
  size_t off = 0;
  auto take = [&](size_t bytes) { unsigned char* p = w + off; off += (bytes + 255) & ~(size_t)255; return p; };
  P.Pbuf = (bf16_t*)take((size_t)NTOK * PST * 2);
  P.Ybuf = (bf16_t*)take((size_t)NTOK * 1024 * 2);
  P.xc = (float*)take((size_t)4096 * 1024 * 4);
  P.dtbuf = (float*)take((size_t)NTOK * 8 * 4);
  P.wt_in = (bf16_t*)take((size_t)2 * 2944 * 1024 * 2);
  P.wt_out = (bf16_t*)take((size_t)2 * 1024 * 1024 * 2);
  P.wt_q = (bf16_t*)take((size_t)2 * 2048 * 1024 * 2);
  P.keysb = (bf16_t*)take((size_t)2 * 8 * 2 * 128 * 128 * 2);
  P.modp = (float*)take((size_t)2 * 16 * 17 * 6144 * 4);
  P.mod = (float*)take((size_t)3 * 17 * 6144 * 4);
  P.hm2 = (float*)take((size_t)2 * 2 * 2048 * 64 * 4);
  P.gtab = (bf16_t*)take((size_t)2 * (256 * 2 * 4096 + 256 * 2 * 512) * 2);
  P.ropetab = (float*)take(2048 * 4);
  P.bar = (unsigned*)take((XCD_BAR_WORDS + 16 * 64 + 8 * 64) * 4);
  unsigned char* treg = w + off;
  P.krot = (bf16_t*)take((size_t)NLAT * 256 * 2);
  P.vt_lat = (bf16_t*)take((size_t)16 * 256 * 2048 * 2);
  P.vt_ctx = (bf16_t*)take((size_t)16 * 256 * 256 * 2);
  P.sst = (float*)take((size_t)16 * 2 * 4 * NCH * 4096 * 4);
  P.ssumA = (float*)take((size_t)16 * 2 * 4 * NCH * 4);
  const size_t hysz = (size_t)16 * 256 * (2048 + 256) * 2;
  P.uT = (bf16_t*)take(hysz);
  P.x0T = (bf16_t*)take(hysz);
  P.yT = (bf16_t*)take(hysz);
  P.tabu = (bf16_t*)treg;
  P.tabv = (bf16_t*)(treg + (size_t)16384 * 1024);
  P.pout = (bf16_t*)(treg + (size_t)40 * 1024 * 1024);
  P.pact = (float*)P.Pbuf;
  P.qbuf = P.Pbuf;
  P.eidx = (int*)((unsigned char*)P.Pbuf + (size_t)NTOK * 2048 * 2);
  P.egate = (float*)((unsigned char*)P.eidx + (size_t)NTOK * 128 * 4);
  if (off > ws_size || n_in != 36) { fprintf(stderr, "kernel_launch: workspace too small (%zu > %zu) or n_in %d != 36\n", off, ws_size, n_in); return; }

  static int grid = 0;
#if MULTI_LAUNCH
  if (!grid) {
    hipFuncSetAttribute((const void*)phase_kernel, hipFuncAttributeMaxDynamicSharedMemorySize, LDS_BYTES);
    grid = 512;
  }
  hipLaunchKernelGGL(phase_kernel, dim3(grid), dim3(NTHREADS), LDS_BYTES, stream, P, PH_PRE0, 0);
  hipLaunchKernelGGL(phase_kernel, dim3(grid), dim3(NTHREADS), LDS_BYTES, stream, P, PH_PRE1, 0);
  hipLaunchKernelGGL(phase_kernel, dim3(grid), dim3(NTHREADS), LDS_BYTES, stream, P, PH_PRE2, 0);
  for (int l = 0; l < 2; ++l)
    for (int ph = PH_L1; ph <= PH_L9; ++ph) hipLaunchKernelGGL(phase_kernel, dim3(grid), dim3(NTHREADS), LDS_BYTES, stream, P, ph, l);
#else
  if (!grid) {
    int dev = 0, cus = 0, per_cu = 0;
    hipGetDevice(&dev);
    hipDeviceGetAttribute(&cus, hipDeviceAttributeMultiprocessorCount, dev);
    hipFuncSetAttribute((const void*)mega_kernel, hipFuncAttributeMaxDynamicSharedMemorySize, LDS_BYTES);
    hipOccupancyMaxActiveBlocksPerMultiprocessor(&per_cu, (const void*)mega_kernel, NTHREADS, LDS_BYTES);
    if (per_cu < 1) { fprintf(stderr, "kernel_launch: occupancy query returned %d\n", per_cu); per_cu = 1; }
    if (per_cu > 3) per_cu = 3;
    grid = cus * per_cu;
  }
  if (hipMemsetAsync(P.bar, 0, (XCD_BAR_WORDS + 16 * 64 + 8 * 64) * 4, stream) != hipSuccess) { fprintf(stderr, "kernel_launch: memset of barrier words failed\n"); return; }
  void* args[] = {&P};
  hipError_t e = hipLaunchCooperativeKernel((const void*)mega_kernel, dim3(grid), dim3(NTHREADS), args, LDS_BYTES, stream);
  if (e != hipSuccess) fprintf(stderr, "cooperative launch failed: %s (grid %d)\n", hipGetErrorString(e), grid);
#endif
}
```

```cpp
#include <hip/hip_runtime.h>
#include <hip/hip_cooperative_groups.h>
#include <cstdio>
#include <cstdint>
namespace cg = cooperative_groups;

#ifndef MULTI_LAUNCH
#define MULTI_LAUNCH 0
#endif

typedef unsigned short bf16_t;
typedef __attribute__((ext_vector_type(8))) short bf16x8;
typedef __attribute__((ext_vector_type(4))) float f32x4;

#define D_MODEL 1024
#define NB 16
#define SEQ 2048
#define CTXL 256
#define NLAT 32768
#define NTOK 36864
#define PST 2816
#define NCH 36
#define LDS_BYTES 53248
#define NTHREADS 256
#define ALPHA 1.41421356237f
#define LN_EPS 1e-5f

struct Params {
  const float *x, *c, *ctx, *c_ctx, *w_ada, *b_ada, *w_in, *w_out, *ln1_g, *ln1_b, *ln2_g, *ln2_b;
  const float *conf_dw_w, *conf_dw_b, *conf_norm_g, *conf_norm_b, *na_rpb, *hy_short_w, *hy_short_b;
  const float *hy_w1, *hy_b1, *hy_w2, *hy_b2, *hy_w3, *hy_decay, *hy_bias;
  const float *ssd_conv_w, *ssd_conv_b, *ssd_a_log, *ssd_dt_bias, *ssd_d, *ssd_norm_g;
  const float *peer_wq, *peer_keys, *peer_u, *peer_v;
  float* out;
  bf16_t* Pbuf;
  bf16_t* Ybuf;
  float*  xc;
  float*  dtbuf;
  bf16_t* wt_in;
  bf16_t* wt_out;
  bf16_t* wt_q;
  bf16_t* keysb;
  float*  modp;
  float*  mod;
  float*  hm2;
  bf16_t* gtab;
  float*  ropetab;
  bf16_t* krot;
  bf16_t* vt_lat;
  bf16_t* vt_ctx;
  float*  sst;
  float*  ssumA;
  bf16_t* uT;
  bf16_t* x0T;
  bf16_t* yT;
  bf16_t* tabu;
  bf16_t* tabv;
  int*    eidx;
  float*  egate;
  bf16_t* qbuf;
  unsigned* bar;
  float* pact;
  bf16_t* pout;
};

__device__ __forceinline__ bf16_t f2bf(float f) { unsigned u = __float_as_uint(f); u += 0x7FFFu + ((u >> 16) & 1u); return (bf16_t)(u >> 16); }
__device__ __forceinline__ float bf2f(bf16_t h) { return __uint_as_float(((unsigned)h) << 16); }
__device__ __forceinline__ unsigned pack2(float a, float b) { return (unsigned)f2bf(a) | ((unsigned)f2bf(b) << 16); }
__device__ __forceinline__ float lo2f(unsigned u) { return __uint_as_float(u << 16); }
__device__ __forceinline__ float hi2f(unsigned u) { return __uint_as_float(u & 0xFFFF0000u); }
__device__ __forceinline__ float sigmoidf_(float x) { return 1.f / (1.f + __expf(-x)); }
__device__ __forceinline__ float siluf_(float x) { return x / (1.f + __expf(-x)); }
__device__ __forceinline__ float wave_sum(float v) {
#pragma unroll
  for (int o = 32; o >= 1; o >>= 1) v += __shfl_xor(v, o);
  return v;
}
__device__ __forceinline__ void unpack8(uint4 v, float* f) {
  f[0] = lo2f(v.x); f[1] = hi2f(v.x); f[2] = lo2f(v.y); f[3] = hi2f(v.y);
  f[4] = lo2f(v.z); f[5] = hi2f(v.z); f[6] = lo2f(v.w); f[7] = hi2f(v.w);
}
__device__ __forceinline__ uint4 pack8(const float* f) {
  uint4 v; v.x = pack2(f[0], f[1]); v.y = pack2(f[2], f[3]); v.z = pack2(f[4], f[5]); v.w = pack2(f[6], f[7]); return v;
}
__device__ __forceinline__ bf16x8 as_bf8(uint4 v) { union { uint4 u; bf16x8 b; } x; x.u = v; return x.b; }
__device__ __forceinline__ f32x4 mfma16(bf16x8 a, bf16x8 b, f32x4 c) { return __builtin_amdgcn_mfma_f32_16x16x32_bf16(a, b, c, 0, 0, 0); }

__device__ __forceinline__ int tidx() { int t = threadIdx.x; asm volatile("" : "+v"(t)); return t; }
template <class Epi>
__device__ __forceinline__ void gemm_tile(const bf16_t* __restrict__ A, int lda, const bf16_t* __restrict__ Bt, int ldb,
                                          int K, int m0, int n0, unsigned char* smem, Epi epi) {
  bf16_t* As = (bf16_t*)smem;
  bf16_t* Bs = As + 3 * 128 * 40;
  const int tid = tidx(), lane = tid & 63, wave = tid >> 6;
  const int wm = wave >> 1, wn = wave & 1;
  const int lr = tid >> 1, lh = tid & 1;
  const bf16_t* ag = A + (size_t)(m0 + lr) * lda + lh * 16;
  const bf16_t* bg = Bt + (size_t)(n0 + lr) * ldb + lh * 16;
  f32x4 acc[4][4];
#pragma unroll
  for (int i = 0; i < 4; ++i)
#pragma unroll
    for (int j = 0; j < 4; ++j) acc[i][j] = (f32x4){0.f, 0.f, 0.f, 0.f};
  const int nk = K >> 5;
  uint4 pa0 = *(const uint4*)ag, pa1 = *(const uint4*)(ag + 8), pb0 = *(const uint4*)bg, pb1 = *(const uint4*)(bg + 8);
  uint4 qa0 = *(const uint4*)(ag + 32), qa1 = *(const uint4*)(ag + 40), qb0 = *(const uint4*)(bg + 32), qb1 = *(const uint4*)(bg + 40);
  __syncthreads();
  {
    bf16_t* wa = As + lr * 40 + lh * 16; bf16_t* wb = Bs + lr * 40 + lh * 16;
    *(uint4*)wa = pa0; *(uint4*)(wa + 8) = pa1; *(uint4*)wb = pb0; *(uint4*)(wb + 8) = pb1;
  }
  __syncthreads();
  int st = 0;
  auto compute = [&](int stage) {
    const bf16_t* as = As + stage * 5120 + (wm * 64 + (lane & 15)) * 40 + (lane >> 4) * 8;
    const bf16_t* bs = Bs + stage * 5120 + (wn * 64 + (lane & 15)) * 40 + (lane >> 4) * 8;
    bf16x8 afr[4];
#pragma unroll
    for (int j = 0; j < 4; ++j) afr[j] = *(const bf16x8*)(bs + j * 16 * 40);
#pragma unroll
    for (int i = 0; i < 4; ++i) {
      const bf16x8 bfr = *(const bf16x8*)(as + i * 16 * 40);
#pragma unroll
      for (int j = 0; j < 4; ++j) acc[i][j] = mfma16(afr[j], bfr, acc[i][j]);
    }
  };
  for (int kt = 0; kt < nk; kt += 2) {
    if (kt + 2 < nk) { const bf16_t* a2 = ag + (kt + 2) * 32; const bf16_t* b2 = bg + (kt + 2) * 32; pa0 = *(const uint4*)a2; pa1 = *(const uint4*)(a2 + 8); pb0 = *(const uint4*)b2; pb1 = *(const uint4*)(b2 + 8); }
    compute(st);
    {
      const int s1 = (st == 2) ? 0 : st + 1;
      bf16_t* wa = As + s1 * 5120 + lr * 40 + lh * 16; bf16_t* wb = Bs + s1 * 5120 + lr * 40 + lh * 16;
      *(uint4*)wa = qa0; *(uint4*)(wa + 8) = qa1; *(uint4*)wb = qb0; *(uint4*)(wb + 8) = qb1;
      st = s1;
    }
    __syncthreads();
    if (kt + 3 < nk) { const bf16_t* a2 = ag + (kt + 3) * 32; const bf16_t* b2 = bg + (kt + 3) * 32; qa0 = *(const uint4*)a2; qa1 = *(const uint4*)(a2 + 8); qb0 = *(const uint4*)b2; qb1 = *(const uint4*)(b2 + 8); }
    compute(st);
    if (kt + 2 < nk) {
      const int s1 = (st == 2) ? 0 : st + 1;
      bf16_t* wa = As + s1 * 5120 + lr * 40 + lh * 16; bf16_t* wb = Bs + s1 * 5120 + lr * 40 + lh * 16;
      *(uint4*)wa = pa0; *(uint4*)(wa + 8) = pa1; *(uint4*)wb = pb0; *(uint4*)(wb + 8) = pb1;
      st = s1;
    }
    __syncthreads();
  }
#pragma unroll
  for (int i = 0; i < 4; ++i)
#pragma unroll
    for (int j = 0; j < 4; ++j) {
      int m = m0 + wm * 64 + i * 16 + (lane & 15);
      int n = n0 + wn * 64 + j * 16 + (lane >> 4) * 4;
      epi(m, n, acc[i][j]);
    }
}

template <class Epi>
__device__ __forceinline__ void gemm_tile32(const bf16_t* __restrict__ A, int lda, const bf16_t* __restrict__ Bt, int ldb,
                                          int K, int m0, int n0, unsigned char* smem, Epi epi) {
  bf16_t* As = (bf16_t*)smem;
  bf16_t* Bs = As + 2 * 128 * 40;
  const int tid = tidx(), lane = tid & 63, wave = tid >> 6;
  const int wm = wave >> 1, wn = wave & 1;
  const int lr = tid >> 1, lh = tid & 1;
  const bf16_t* ag = A + (size_t)(m0 + lr) * lda + lh * 16;
  const bf16_t* bg = Bt + (size_t)(n0 + lr) * ldb + lh * 16;
  f32x4 acc[4][4];
#pragma unroll
  for (int i = 0; i < 4; ++i)
#pragma unroll
    for (int j = 0; j < 4; ++j) acc[i][j] = (f32x4){0.f, 0.f, 0.f, 0.f};
  uint4 ra0 = *(const uint4*)ag, ra1 = *(const uint4*)(ag + 8);
  uint4 rb0 = *(const uint4*)bg, rb1 = *(const uint4*)(bg + 8);
  __syncthreads();
  {
    bf16_t* pa = As + lr * 40 + lh * 16; bf16_t* pb = Bs + lr * 40 + lh * 16;
    *(uint4*)pa = ra0; *(uint4*)(pa + 8) = ra1; *(uint4*)pb = rb0; *(uint4*)(pb + 8) = rb1;
  }
  __syncthreads();
  const int nk = K >> 5;
  for (int kt = 0; kt < nk; ++kt) {
    const int cur = kt & 1;
    if (kt + 1 < nk) {
      const bf16_t* a2 = ag + (kt + 1) * 32; const bf16_t* b2 = bg + (kt + 1) * 32;
      ra0 = *(const uint4*)a2; ra1 = *(const uint4*)(a2 + 8); rb0 = *(const uint4*)b2; rb1 = *(const uint4*)(b2 + 8);
    }
    const bf16_t* as = As + cur * 5120 + (wm * 64 + (lane & 15)) * 40 + (lane >> 4) * 8;
    const bf16_t* bs = Bs + cur * 5120 + (wn * 64 + (lane & 15)) * 40 + (lane >> 4) * 8;
    bf16x8 afr[4];
#pragma unroll
    for (int j = 0; j < 4; ++j) afr[j] = *(const bf16x8*)(bs + j * 16 * 40);
#pragma unroll
    for (int i = 0; i < 4; ++i) {
      const bf16x8 bfr = *(const bf16x8*)(as + i * 16 * 40);
#pragma unroll
      for (int j = 0; j < 4; ++j) acc[i][j] = mfma16(afr[j], bfr, acc[i][j]);
    }
    if (kt + 1 < nk) {
      bf16_t* pa = As + (cur ^ 1) * 5120 + lr * 40 + lh * 16; bf16_t* pb = Bs + (cur ^ 1) * 5120 + lr * 40 + lh * 16;
      *(uint4*)pa = ra0; *(uint4*)(pa + 8) = ra1; *(uint4*)pb = rb0; *(uint4*)(pb + 8) = rb1;
    }
    __syncthreads();
  }
#pragma unroll
  for (int i = 0; i < 4; ++i)
#pragma unroll
    for (int j = 0; j < 4; ++j) {
      int m = m0 + wm * 64 + i * 16 + (lane & 15);
      int n = n0 + wn * 64 + j * 16 + (lane >> 4) * 4;
      epi(m, n, acc[i][j]);
    }
}

__device__ __forceinline__ void transpose_task(const float* __restrict__ src, bf16_t* __restrict__ dst, int K, int N, int k0, int n0, unsigned char* smem) {
  float* tile = (float*)smem;
  const int tid = tidx();
  __syncthreads();
  {
    int r = tid >> 4, c4 = tid & 15;
#pragma unroll
    for (int rr = 0; rr < 4; ++rr) {
      int row = rr * 16 + r;
      float4 v = make_float4(0.f, 0.f, 0.f, 0.f);
      if (n0 + c4 * 4 < N) v = *(const float4*)(src + (size_t)(k0 + row) * N + n0 + c4 * 4);
      float* t = tile + row * 65 + c4 * 4;
      t[0] = v.x; t[1] = v.y; t[2] = v.z; t[3] = v.w;
    }
  }
  __syncthreads();
  {
    int n = tid >> 2, kq = tid & 3;
    float f[16];
#pragma unroll
    for (int i = 0; i < 16; ++i) f[i] = tile[(kq * 16 + i) * 65 + n];
    bf16_t* d = dst + (size_t)(n0 + n) * K + k0 + kq * 16;
    *(uint4*)d = pack8(f); *(uint4*)(d + 8) = pack8(f + 8);
  }
}

__device__ __forceinline__ void modpart_task(const Params& P, int l, int ks, int cb, unsigned char* smem) {
  float* s = (float*)smem;
  const int tid = tidx();
  __syncthreads();
  for (int i = tid; i < 17 * 64; i += NTHREADS) {
    int r = i >> 6, k = i & 63;
    float v = (r < 16) ? P.c[r * 1024 + ks * 64 + k] : P.c_ctx[ks * 64 + k];
    s[i] = siluf_(v);
  }
  __syncthreads();
  float acc[17];
#pragma unroll
  for (int r = 0; r < 17; ++r) acc[r] = 0.f;
  const int col = cb * 256 + tid;
  const float* w = P.w_ada + ((size_t)l * 1024 + ks * 64) * 6144 + col;
#pragma unroll 8
  for (int k = 0; k < 64; ++k) {
    float wv = w[(size_t)k * 6144];
#pragma unroll
    for (int r = 0; r < 17; ++r) acc[r] += s[r * 64 + k] * wv;
  }
#pragma unroll
  for (int r = 0; r < 17; ++r) P.modp[(((size_t)l * 16 + ks) * 17 + r) * 6144 + col] = acc[r];
}

__device__ __forceinline__ void hm2_task(const Params& P, int l, int lsel, int t4, unsigned char* smem) {
  float* z = (float*)smem;
  float* h1 = z + 4 * 36;
  const int tid = tidx(), tt = tid >> 6, j = tid & 63;
  const int L = lsel ? 256 : 2048;
  const int t = t4 * 4 + tt;
  const float tn = (float)t / (float)L;
  __syncthreads();
  if (j < 33) {
    float v;
    if (j == 0) v = tn;
    else if (j <= 16) v = sinf((6.2831855f * (float)j) * tn);
    else v = cosf((6.2831855f * (float)(j - 16)) * tn);
    z[tt * 36 + j] = v;
  }
  __syncthreads();
  float a = P.hy_b1[l * 64 + j];
  for (int i = 0; i < 33; ++i) a += z[tt * 36 + i] * P.hy_w1[(l * 33 + i) * 64 + j];
  h1[tt * 64 + j] = sinf(a);
  __syncthreads();
  float b = P.hy_b2[l * 64 + j];
  for (int i = 0; i < 64; ++i) b += h1[tt * 64 + i] * P.hy_w2[(l * 64 + i) * 64 + j];
  P.hm2[(((size_t)l * 2 + lsel) * 2048 + t) * 64 + j] = sinf(b);
}

__device__ __forceinline__ bf16_t* gtab_ptr(const Params& P, int l, int lsel, int c) {
  bf16_t* base = P.gtab + (size_t)l * (256 * 2 * 4096 + 256 * 2 * 512);
  return lsel ? base + 256 * 2 * 4096 + (size_t)c * 1024 : base + (size_t)c * 8192;
}

__device__ __forceinline__ void filt_task(const Params& P, int l, int lsel, int col, unsigned char* smem) {
  float* kv = (float*)smem;
  float* red = kv + 2048;
  float* w3s = red + 8;
  const int tid = tidx();
  const int L = lsel ? 256 : 2048;
  __syncthreads();
  if (tid < 64) w3s[tid] = P.hy_w3[(l * 64 + tid) * 512 + col];
  __syncthreads();
  const float dec = P.hy_decay[l * 512 + col];
  float asum = 0.f;
  for (int t = tid; t < L; t += NTHREADS) {
    const float* h = P.hm2 + (((size_t)l * 2 + lsel) * 2048 + t) * 64;
    float a = 0.f;
#pragma unroll 8
    for (int i = 0; i < 64; ++i) a += h[i] * w3s[i];
    float tn = (float)t / (float)L;
    a *= expf(-tn * dec);
    kv[t] = a; asum += fabsf(a);
  }
  asum = wave_sum(asum);
  if ((tid & 63) == 0) red[tid >> 6] = asum;
  __syncthreads();
  const float inv = 1.f / (red[0] + red[1] + red[2] + red[3] + 1e-6f);
  const int c = col & 255;
  const bool bwd = col >= 256;
  bf16_t* g0 = gtab_ptr(P, l, lsel, c);
  bf16_t* g1 = g0 + 2 * L;
  for (int d = tid; d < L; d += NTHREADS) {
    if (bwd && d == 0) continue;
    int i = bwd ? (L - 1 + d) : (L - 1 - d);
    bf16_t v = f2bf(kv[d] * inv);
    g0[i] = v;
    if (i >= 1) g1[i - 1] = v;
  }
}

__device__ __forceinline__ int mod_row(int T) { return T < NLAT ? (T >> 11) : 16; }

__device__ __forceinline__ void hmod0_token(const Params& P, int T, int lane) {
  const float* xr = (T < NLAT) ? P.x + (size_t)T * 1024 : P.ctx + (size_t)(T - NLAT) * 1024;
  const float* m = P.mod + (size_t)mod_row(T) * 6144;
#pragma unroll
  for (int i = 0; i < 2; ++i) {
    int d = i * 512 + lane * 8;
    float f[8];
#pragma unroll
    for (int j = 0; j < 8; ++j) f[j] = xr[d + j] * (1.f + m[1024 + d + j]) + m[d + j];
    *(uint4*)(P.Ybuf + (size_t)T * 1024 + d) = pack8(f);
  }
}

__device__ __forceinline__ void r1_token(const Params& P, int l, int T, int lane, const bool dry) {
  const float* xr;
  float* xw;
  if (T < NLAT) { xr = (l == 0) ? P.x + (size_t)T * 1024 : P.out + (size_t)T * 1024; xw = P.out + (size_t)T * 1024; }
  else { xr = (l == 0) ? P.ctx + (size_t)(T - NLAT) * 1024 : P.xc + (size_t)(T - NLAT) * 1024; xw = P.xc + (size_t)(T - NLAT) * 1024; }
  bf16_t* hw = P.Ybuf + (size_t)T * 1024;
  if (dry) { xw = (float*)P.uT + (size_t)(T & 2047) * 1024; hw = P.x0T + (size_t)(T & 2047) * 1024; }
  const float* m = P.mod + ((size_t)l * 17 + mod_row(T)) * 6144;
  const bf16_t* yo = P.Pbuf + (size_t)T * 1024;
  float v[16];
  float s = 0.f;
#pragma unroll
  for (int i = 0; i < 2; ++i) {
    int d = i * 512 + lane * 8;
    float y[8]; unpack8(*(const uint4*)(yo + d), y);
#pragma unroll
    for (int j = 0; j < 8; ++j) { v[i * 8 + j] = ALPHA * xr[d + j] + m[2048 + d + j] * y[j]; s += v[i * 8 + j]; }
  }
  float mean = wave_sum(s) * (1.f / 1024.f);
  float q = 0.f;
#pragma unroll
  for (int i = 0; i < 16; ++i) { v[i] -= mean; q += v[i] * v[i]; }
  float rstd = rsqrtf(wave_sum(q) * (1.f / 1024.f) + LN_EPS);
#pragma unroll
  for (int i = 0; i < 2; ++i) {
    int d = i * 512 + lane * 8;
    float h[8];
#pragma unroll
    for (int j = 0; j < 8; ++j) {
      float x1 = v[i * 8 + j] * rstd * P.ln1_g[l * 1024 + d + j] + P.ln1_b[l * 1024 + d + j];
      xw[d + j] = x1;
      h[j] = x1 * (1.f + m[4096 + d + j]) + m[3072 + d + j];
    }
    *(uint4*)(hw + d) = pack8(h);
  }
}

__device__ __forceinline__ float gelu_tanh(float x) {
  float u = 0.7978845608f * (x + 0.044715f * x * x * x);
  float t = 1.f - 2.f / (1.f + __expf(2.f * u));
  return 0.5f * x * (1.f + t);
}

typedef float f32x2 __attribute__((ext_vector_type(2)));
__device__ __forceinline__ unsigned pack4_fp8(float a, float b, float c, float d) {
  int v = 0;
  v = __builtin_amdgcn_cvt_pk_fp8_f32(a, b, v, false);
  v = __builtin_amdgcn_cvt_pk_fp8_f32(c, d, v, true);
  return (unsigned)v;
}
__device__ __forceinline__ float dot16_fp8(uint4 v, const float* h) {
  f32x2 acc = (f32x2){0.f, 0.f};
  unsigned w[4] = {v.x, v.y, v.z, v.w};
#pragma unroll
  for (int q = 0; q < 4; ++q) {
    acc += __builtin_amdgcn_cvt_pk_f32_fp8((int)w[q], false) * (f32x2){h[q * 4], h[q * 4 + 1]};
    acc += __builtin_amdgcn_cvt_pk_f32_fp8((int)w[q], true) * (f32x2){h[q * 4 + 2], h[q * 4 + 3]};
  }
  return acc[0] + acc[1];
}
typedef float f32x4_t __attribute__((ext_vector_type(4)));
__device__ __forceinline__ void peer_u_phase(const Params& P, int sl, int Tfirst, int Tstride, int ntok, int lane, int* li) {
  const int m = lane & 15, quad = lane >> 4;
  const unsigned char* tu = (const unsigned char*)P.tabu + (size_t)sl * 16384 * 128 + quad * 32;
  const int wpos = (lane & 15) * 8 + (lane >> 4);
  for (int T0 = Tfirst; T0 < ntok; T0 += 4 * Tstride) {
    int Tk[4];
    {
      int ir[4][2];
#pragma unroll
      for (int k = 0; k < 4; ++k) {
        Tk[k] = min(T0 + k * Tstride, ntok - 1);
        const int* er = P.eidx + (size_t)Tk[k] * 128;
        ir[k][0] = er[lane]; ir[k][1] = er[64 + lane];
      }
#pragma unroll
      for (int k = 0; k < 4; ++k) { li[k * 128 + wpos] = ir[k][0]; li[k * 128 + wpos + 4] = ir[k][1]; }
    }
#pragma unroll 1
    for (int k = 0; k < 4; ++k) {
      const int Tc = min(T0 + k * Tstride, ntok - 1);
      uint4 hr[4];
      const bf16_t* hp = P.Ybuf + (size_t)Tc * 1024 + sl * 128 + quad * 32;
#pragma unroll
      for (int q = 0; q < 4; ++q) hr[q] = *(const uint4*)(hp + q * 8);
      uint4 rv[16];
      {
        int idx[8];
#pragma unroll
        for (int q = 0; q < 2; ++q) { int4 v = *(const int4*)(li + k * 128 + m * 8 + q * 4); idx[q * 4] = v.x; idx[q * 4 + 1] = v.y; idx[q * 4 + 2] = v.z; idx[q * 4 + 3] = v.w; }
#pragma unroll
        for (int t = 0; t < 8; ++t) { const unsigned char* rp = tu + (size_t)idx[t] * 128; rv[2 * t] = *(const uint4*)rp; rv[2 * t + 1] = *(const uint4*)(rp + 16); }
      }
      long hb[4];
#pragma unroll
      for (int q = 0; q < 4; ++q) {
        float f[8]; unpack8(hr[q], f);
        unsigned lo = pack4_fp8(f[0], f[1], f[2], f[3]), hi = pack4_fp8(f[4], f[5], f[6], f[7]);
        hb[q] = (long)(((unsigned long long)hi << 32) | (unsigned long long)lo);
      }
      const bool live = (T0 + k * Tstride) < ntok;
      float* po = P.pact + ((size_t)sl * NTOK + Tc) * 128 + quad * 4;
#pragma unroll
      for (int t = 0; t < 8; ++t) {
        f32x4_t acc = (f32x4_t){0.f, 0.f, 0.f, 0.f};
        const uint4 r0 = rv[2 * t], r1 = rv[2 * t + 1];
        acc = __builtin_amdgcn_mfma_f32_16x16x32_fp8_fp8((long)(((unsigned long long)r0.y << 32) | r0.x), hb[0], acc, 0, 0, 0);
        acc = __builtin_amdgcn_mfma_f32_16x16x32_fp8_fp8((long)(((unsigned long long)r0.w << 32) | r0.z), hb[1], acc, 0, 0, 0);
        acc = __builtin_amdgcn_mfma_f32_16x16x32_fp8_fp8((long)(((unsigned long long)r1.y << 32) | r1.x), hb[2], acc, 0, 0, 0);
        acc = __builtin_amdgcn_mfma_f32_16x16x32_fp8_fp8((long)(((unsigned long long)r1.w << 32) | r1.z), hb[3], acc, 0, 0, 0);
        if (m == 0 && live) *(float4*)(po + t * 16) = make_float4(acc[0], acc[1], acc[2], acc[3]);
      }
    }
  }
}
__device__ __forceinline__ void peer_v_phase(const Params& P, int sl, int Tfirst, int Tstride, int ntok, int lane, int* li) {
  const int grp = lane >> 3, j8 = lane & 7;
  const unsigned char* tv = (const unsigned char*)P.tabv + (size_t)sl * 16384 * 128 + j8 * 16;
  float* lw = (float*)(li + 512);
  const int wpos = (lane & 7) * 16 + (lane >> 3);
  for (int T0 = Tfirst; T0 < ntok; T0 += 4 * Tstride) {
    int Tk[4];
    {
      int ir[4][2]; float wr[4][2];
#pragma unroll
      for (int k = 0; k < 4; ++k) {
        Tk[k] = min(T0 + k * Tstride, ntok - 1);
        const int* er = P.eidx + (size_t)Tk[k] * 128; const float* gr = P.egate + (size_t)Tk[k] * 128;
        ir[k][0] = er[lane]; ir[k][1] = er[64 + lane]; wr[k][0] = gr[lane]; wr[k][1] = gr[64 + lane];
      }
#pragma unroll
      for (int k = 0; k < 4; ++k) { li[k * 128 + wpos] = ir[k][0]; li[k * 128 + wpos + 8] = ir[k][1]; lw[k * 128 + wpos] = wr[k][0]; lw[k * 128 + wpos + 8] = wr[k][1]; }
    }
    uint4 rv[1][16];
#pragma unroll
    for (int k = 0; k < 4; ++k) {
      {
        int idx[16];
#pragma unroll
        for (int q = 0; q < 4; ++q) { int4 v = *(const int4*)(li + k * 128 + grp * 16 + q * 4); idx[q * 4] = v.x; idx[q * 4 + 1] = v.y; idx[q * 4 + 2] = v.z; idx[q * 4 + 3] = v.w; }
#pragma unroll
        for (int t = 0; t < 16; ++t) rv[0][t] = *(const uint4*)(tv + (size_t)idx[t] * 128);
      }
      {
        const int kk = k;
        float w[16];
#pragma unroll
        for (int q = 0; q < 4; ++q) { float4 f = *(const float4*)(lw + kk * 128 + grp * 16 + q * 4); w[q * 4] = f.x; w[q * 4 + 1] = f.y; w[q * 4 + 2] = f.z; w[q * 4 + 3] = f.w; }
        f32x2 o[8];
#pragma unroll
        for (int i = 0; i < 8; ++i) o[i] = (f32x2){0.f, 0.f};
#pragma unroll
        for (int t = 0; t < 16; ++t) {
          const f32x2 w2 = (f32x2){w[t], w[t]};
          const uint4 r = rv[0][t];
          unsigned ww[4] = {r.x, r.y, r.z, r.w};
#pragma unroll
          for (int q = 0; q < 4; ++q) {
            o[q * 2] += w2 * __builtin_amdgcn_cvt_pk_f32_fp8((int)ww[q], false);
            o[q * 2 + 1] += w2 * __builtin_amdgcn_cvt_pk_f32_fp8((int)ww[q], true);
          }
        }
        float of[16];
#pragma unroll
        for (int i = 0; i < 8; ++i) { of[2 * i] = o[i][0]; of[2 * i + 1] = o[i][1]; }
#pragma unroll
        for (int i = 0; i < 16; ++i) { of[i] += __shfl_xor(of[i], 8); of[i] += __shfl_xor(of[i], 16); of[i] += __shfl_xor(of[i], 32); }
        if (grp == 0 && (T0 + kk * Tstride) < ntok) {
#pragma unroll
          for (int i = 0; i < 16; ++i) of[i] *= (1.f / 256.f);
          bf16_t* d = P.pout + (size_t)Tk[kk] * 1024 + sl * 128 + j8 * 16;
          *(uint4*)d = pack8(of); *(uint4*)(d + 8) = pack8(of + 8);
        }
      }
    }
  }
}
__device__ __forceinline__ void ln2_token(const Params& P, int l, int T, int lane) {
  float* xw = (T < NLAT) ? P.out + (size_t)T * 1024 : P.xc + (size_t)(T - NLAT) * 1024;
  bf16_t* hw = P.Ybuf + (size_t)T * 1024;
  const float* m = P.mod + ((size_t)l * 17 + mod_row(T)) * 6144;
  const int d0 = lane * 16;
  float o[16];
  unpack8(*(const uint4*)(P.pout + (size_t)T * 1024 + d0), o); unpack8(*(const uint4*)(P.pout + (size_t)T * 1024 + d0 + 8), o + 8);
  float s = 0.f;
#pragma unroll
  for (int i = 0; i < 16; ++i) { o[i] = ALPHA * xw[d0 + i] + m[5120 + d0 + i] * o[i]; s += o[i]; }
  float mean = wave_sum(s) * (1.f / 1024.f);
  float q = 0.f;
#pragma unroll
  for (int i = 0; i < 16; ++i) { o[i] -= mean; q += o[i] * o[i]; }
  float rstd = rsqrtf(wave_sum(q) * (1.f / 1024.f) + LN_EPS);
  const float* mn = P.mod + ((size_t)(l + 1) * 17 + mod_row(T)) * 6144;
  float hh[16];
#pragma unroll
  for (int i = 0; i < 16; ++i) {
    float x2 = o[i] * rstd * P.ln2_g[l * 1024 + d0 + i] + P.ln2_b[l * 1024 + d0 + i];
    o[i] = x2;
    if (l == 0) hh[i] = x2 * (1.f + mn[1024 + d0 + i]) + mn[d0 + i];
  }
#pragma unroll
  for (int i = 0; i < 4; ++i) *(float4*)(xw + d0 + i * 4) = make_float4(o[i * 4], o[i * 4 + 1], o[i * 4 + 2], o[i * 4 + 3]);
  if (l == 0) { *(uint4*)(hw + d0) = pack8(hh); *(uint4*)(hw + d0 + 8) = pack8(hh + 8); }
}

__device__ __forceinline__ void peer_token(const Params& P, int l, int T, int lane, float* wl, const bool dry) {
  const int sub = lane >> 4, j16 = lane & 15;
  float h[64];
  {
    const bf16_t* hr = P.Ybuf + (size_t)T * 1024 + j16 * 16;
#pragma unroll
    for (int i = 0; i < 4; ++i) { unpack8(*(const uint4*)(hr + i * 256), h + i * 16); unpack8(*(const uint4*)(hr + i * 256 + 8), h + i * 16 + 8); }
  }
  const int* er = P.eidx + (size_t)T * 128;
  const float* gr = P.egate + (size_t)T * 128;
  const unsigned char* tu = (const unsigned char*)P.tabu;
  const unsigned char* tv = (const unsigned char*)P.tabv;
  for (int it = 0; it < 32; it += 2) {
    uint4 rv[2][4];
#pragma unroll
    for (int u2 = 0; u2 < 2; ++u2) {
      int e = er[(it + u2) * 4 + sub];
      const unsigned char* row = tu + (size_t)e * 1024 + j16 * 16;
#pragma unroll
      for (int i = 0; i < 4; ++i) rv[u2][i] = *(const uint4*)(row + i * 256);
    }
#pragma unroll
    for (int u2 = 0; u2 < 2; ++u2) {
      float acc = 0.f;
#pragma unroll
      for (int i = 0; i < 4; ++i) acc += dot16_fp8(rv[u2][i], h + i * 16);
      acc += __shfl_xor(acc, 1); acc += __shfl_xor(acc, 2); acc += __shfl_xor(acc, 4); acc += __shfl_xor(acc, 8);
      if (j16 == 0) wl[(it + u2) * 4 + sub] = gr[(it + u2) * 4 + sub] * gelu_tanh(acc * (1.f / 256.f));
    }
  }
  float o[16];
#pragma unroll
  for (int i = 0; i < 16; ++i) o[i] = 0.f;
  for (int e8 = 0; e8 < 128; e8 += 8) {
    uint4 rv[8];
    float w[8];
#pragma unroll
    for (int k = 0; k < 8; ++k) {
      int e = er[e8 + k];
      rv[k] = *(const uint4*)(tv + (size_t)e * 1024 + lane * 16);
      w[k] = wl[e8 + k];
    }
#pragma unroll
    for (int k = 0; k < 8; ++k) {
      unsigned ww[4] = {rv[k].x, rv[k].y, rv[k].z, rv[k].w};
#pragma unroll
      for (int q = 0; q < 4; ++q) {
        f32x2 lo = __builtin_amdgcn_cvt_pk_f32_fp8((int)ww[q], false);
        f32x2 hi = __builtin_amdgcn_cvt_pk_f32_fp8((int)ww[q], true);
        o[q * 4] += w[k] * lo[0]; o[q * 4 + 1] += w[k] * lo[1]; o[q * 4 + 2] += w[k] * hi[0]; o[q * 4 + 3] += w[k] * hi[1];
      }
    }
  }
  float* xw = (T < NLAT) ? P.out + (size_t)T * 1024 : P.xc + (size_t)(T - NLAT) * 1024;
  const float* xrd = xw;
  bf16_t* hw = P.Ybuf + (size_t)T * 1024;
  if (dry) { xw = (float*)P.uT + (size_t)(T & 2047) * 1024; hw = P.x0T + (size_t)(T & 2047) * 1024; }
  const float* m = P.mod + ((size_t)l * 17 + mod_row(T)) * 6144;
  const int d0 = lane * 16;
  float s = 0.f;
#pragma unroll
  for (int i = 0; i < 16; ++i) { o[i] = ALPHA * xrd[d0 + i] + m[5120 + d0 + i] * (o[i] * (1.f / 256.f)); s += o[i]; }
  float mean = wave_sum(s) * (1.f / 1024.f);
  float q = 0.f;
#pragma unroll
  for (int i = 0; i < 16; ++i) { o[i] -= mean; q += o[i] * o[i]; }
  float rstd = rsqrtf(wave_sum(q) * (1.f / 1024.f) + LN_EPS);
  const float* mn = P.mod + ((size_t)(l + 1) * 17 + mod_row(T)) * 6144;
  float hh[16];
#pragma unroll
  for (int i = 0; i < 16; ++i) {
    float x2 = o[i] * rstd * P.ln2_g[l * 1024 + d0 + i] + P.ln2_b[l * 1024 + d0 + i];
    o[i] = x2;
    if (l == 0) hh[i] = x2 * (1.f + mn[1024 + d0 + i]) + mn[d0 + i];
  }
#pragma unroll
  for (int i = 0; i < 4; ++i) *(float4*)(xw + d0 + i * 4) = make_float4(o[i * 4], o[i * 4 + 1], o[i * 4 + 2], o[i * 4 + 3]);
  if (l == 0) { *(uint4*)(hw + d0) = pack8(hh); *(uint4*)(hw + d0 + 8) = pack8(hh + 8); }
}

__device__ __forceinline__ void conf_task(const Params& P, int l, int tok_base, int len, int pos0, unsigned char* smem) {
  _Float16* u = (_Float16*)smem;
  const int c = tidx();
  __syncthreads();
  for (int i = 0; i < 94; ++i) {
    int pos = pos0 - 15 + i;
    float v = 0.f;
    if (pos >= 0 && pos < len) {
      const bf16_t* pr = P.Pbuf + (size_t)(tok_base + pos) * PST;
      v = bf2f(pr[c]) * sigmoidf_(bf2f(pr[256 + c]));
    }
    u[i * 256 + c] = (_Float16)v;
  }
  __syncthreads();
  float w[31];
#pragma unroll
  for (int j = 0; j < 31; ++j) w[j] = P.conf_dw_w[(l * 31 + j) * 256 + c];
  const float bias = P.conf_dw_b[l * 256 + c], ng = P.conf_norm_g[l * 256 + c], nb = P.conf_norm_b[l * 256 + c];
  for (int t = 0; t < 64; ++t) {
    float acc = bias;
#pragma unroll
    for (int j = 0; j < 31; ++j) acc += w[j] * (float)u[(t + j) * 256 + c];
    float mean = wave_sum(acc) * (1.f / 64.f);
    float d = acc - mean;
    float var = wave_sum(d * d) * (1.f / 64.f);
    float un = d * rsqrtf(var + LN_EPS) * ng + nb;
    P.Ybuf[(size_t)(tok_base + pos0 + t) * 1024 + c] = f2bf(siluf_(un));
  }
}

__device__ __forceinline__ void prep_task(const Params& P, int l, bool lat, int b, int pos0) {
  const int c = tidx();
  const int len = lat ? 2048 : 256;
  const int tok0 = lat ? b * 2048 + pos0 : NLAT + b * 256 + pos0;
  {
    bf16_t* dst = (lat ? P.vt_lat : P.vt_ctx) + ((size_t)b * 256 + c) * len + pos0;
    for (int t8 = 0; t8 < 8; ++t8) {
      unsigned wv[4];
#pragma unroll
      for (int k = 0; k < 4; ++k) {
        unsigned a = P.Pbuf[(size_t)(tok0 + t8 * 8 + k * 2) * PST + 1024 + c];
        unsigned bb = P.Pbuf[(size_t)(tok0 + t8 * 8 + k * 2 + 1) * PST + 1024 + c];
        wv[k] = a | (bb << 16);
      }
      *(uint4*)(dst + t8 * 8) = make_uint4(wv[0], wv[1], wv[2], wv[3]);
    }
  }
  if (lat) {
    const int hd = c & 63, i = hd & 31, hbase = c & ~63;
    const bool hi = hd >= 32;
    const int row = pos0 >> 6;
    const float* tc = P.ropetab; const float* ts = P.ropetab + 1024;
    for (int t = 0; t < 64; ++t) {
      const bf16_t* kr = P.Pbuf + (size_t)(tok0 + t) * PST + 768 + hbase;
      float x1 = bf2f(kr[i]), x2 = bf2f(kr[32 + i]);
      int pos = (i < 16) ? row : t;
      float cs = tc[pos * 16 + (i & 15)], sn = ts[pos * 16 + (i & 15)];
      float o = hi ? (x1 * sn + x2 * cs) : (x1 * cs - x2 * sn);
      P.krot[(size_t)(tok0 + t) * 256 + c] = f2bf(o);
    }
  }
  {
    float w[3][3], bsv[3];
#pragma unroll
    for (int q = 0; q < 3; ++q) {
      bsv[q] = P.hy_short_b[l * 768 + q * 256 + c];
#pragma unroll
      for (int k = 0; k < 3; ++k) w[q][k] = P.hy_short_w[(l * 3 + k) * 768 + q * 256 + c];
    }
    const size_t seqoff = lat ? ((size_t)b * 256 + c) * 2048 : (size_t)16 * 256 * 2048 + ((size_t)b * 256 + c) * 256;
    float pv[3], cu[3], nx[3];
#pragma unroll
    for (int q = 0; q < 3; ++q) {
      pv[q] = (pos0 > 0) ? bf2f(P.Pbuf[(size_t)(tok0 - 1) * PST + 1280 + q * 256 + c]) : 0.f;
      cu[q] = bf2f(P.Pbuf[(size_t)tok0 * PST + 1280 + q * 256 + c]);
    }
    for (int t8 = 0; t8 < 8; ++t8) {
      float uo[8], xo[8];
#pragma unroll
      for (int k = 0; k < 8; ++k) {
        int t = t8 * 8 + k;
        float r[3];
#pragma unroll
        for (int q = 0; q < 3; ++q) {
          nx[q] = (pos0 + t + 1 < len) ? bf2f(P.Pbuf[(size_t)(tok0 + t + 1) * PST + 1280 + q * 256 + c]) : 0.f;
          r[q] = w[q][0] * pv[q] + w[q][1] * cu[q] + w[q][2] * nx[q] + bsv[q];
          pv[q] = cu[q]; cu[q] = nx[q];
        }
        xo[k] = r[0]; uo[k] = r[2] * r[1];
      }
      *(uint4*)(P.uT + seqoff + pos0 + t8 * 8) = pack8(uo);
      *(uint4*)(P.x0T + seqoff + pos0 + t8 * 8) = pack8(xo);
    }
  }
}

__device__ __forceinline__ void hyfin_task(const Params& P, int l, bool lat, int b, int pos0) {
  const int c = tidx();
  const int tok0 = lat ? b * 2048 + pos0 : NLAT + b * 256 + pos0;
  const size_t seqoff = lat ? ((size_t)b * 256 + c) * 2048 : (size_t)16 * 256 * 2048 + ((size_t)b * 256 + c) * 256;
  const float skip = P.hy_bias[l * 256 + c];
  for (int t8 = 0; t8 < 8; ++t8) {
    float y[8], u[8], x0[8];
    unpack8(*(const uint4*)(P.yT + seqoff + pos0 + t8 * 8), y);
    unpack8(*(const uint4*)(P.uT + seqoff + pos0 + t8 * 8), u);
    unpack8(*(const uint4*)(P.x0T + seqoff + pos0 + t8 * 8), x0);
#pragma unroll
    for (int k = 0; k < 8; ++k)
      P.Ybuf[(size_t)(tok0 + t8 * 8 + k) * 1024 + 512 + c] = f2bf((y[k] + u[k] * skip) * x0[k]);
  }
}

__device__ __forceinline__ void hyconv_task(const Params& P, int l, bool lat, int c, int tb, unsigned char* smem) {
  const int L = lat ? 2048 : 256;
  unsigned* g = (unsigned*)smem;
  const int tid = tidx(), lane = tid & 63, wave = tid >> 6;
  __syncthreads();
  {
    const uint4* src = (const uint4*)gtab_ptr(P, l, lat ? 0 : 1, c);
    const int n16 = (4 * L * 2) / 16;
    for (int i = tid; i < n16; i += NTHREADS) ((uint4*)g)[i] = src[i];
  }
  __syncthreads();
  const int m = lane & 15, quad = lane >> 4;
  const size_t seqbase = lat ? 0 : (size_t)16 * 256 * 2048;
  const bf16_t* ub = P.uT + seqbase + ((size_t)m * 256 + c) * L + quad * 8;
  const int t0 = tb + wave * 64;
  f32x4 acc[4];
#pragma unroll
  for (int i = 0; i < 4; ++i) acc[i] = (f32x4){0.f, 0.f, 0.f, 0.f};
  for (int s0 = 0; s0 < L; s0 += 256) {
    bf16x8 ufr[8];
#pragma unroll
    for (int q = 0; q < 8; ++q) ufr[q] = *(const bf16x8*)(ub + s0 + q * 32);
#pragma unroll
    for (int q = 0; q < 8; ++q) {
#pragma unroll
      for (int i = 0; i < 4; ++i) {
        int o = (L - 1) + s0 + q * 32 - (t0 + i * 16) + quad * 8 - m;
        const unsigned* gp = g + (o & 1) * L + (o >> 1);
        uint4 tv = make_uint4(gp[0], gp[1], gp[2], gp[3]);
        acc[i] = mfma16(as_bf8(tv), ufr[q], acc[i]);
      }
    }
  }
  bf16_t* yb = P.yT + seqbase + ((size_t)m * 256 + c) * L;
#pragma unroll
  for (int i = 0; i < 4; ++i) {
    uint2 v; v.x = pack2(acc[i][0], acc[i][1]); v.y = pack2(acc[i][2], acc[i][3]);
    *(uint2*)(yb + t0 + i * 16 + quad * 4) = v;
  }
}

template <bool LOCAL>
__device__ __forceinline__ void attn_task(const Params& P, int l, int b, int r, int c0, int h, int lane) {
  const int n = lane & 15, quad = lane >> 4;
  const int qtok = LOCAL ? (b * 2048 + r * 64 + c0 + n) : (NLAT + b * 256 + c0 + n);
  const bf16_t* pq = P.Pbuf + (size_t)qtok * PST + 512 + h * 64 + quad * 8;
  const uint4 q0 = *(const uint4*)pq, q1 = *(const uint4*)(pq + 32);
  const bf16x8 qp0 = as_bf8(q0), qp1 = as_bf8(q1);
  bf16x8 qr0 = qp0, qr1 = qp1;
  const int rs = min(max(r - 4, 0), 24), kc0 = min(max(c0 - 8, 0), 32);
  const int cq = c0 + n, cs_ = min(max(cq - 8, 0), 48);
  const float* rpb = P.na_rpb + ((size_t)l * 4 + h) * 15 * 31;
  if (LOCAL) {
    float x1[8], x2[8], a[8], bq[8];
    unpack8(q0, x1); unpack8(q1, x2);
    const int pos = (quad < 2) ? r : (c0 + n);
    const float* tc = P.ropetab + pos * 16 + (quad & 1) * 8;
    const float* ts = tc + 1024;
#pragma unroll
    for (int j = 0; j < 8; ++j) { float cs = tc[j], sn = ts[j]; a[j] = x1[j] * cs - x2[j] * sn; bq[j] = x1[j] * sn + x2[j] * cs; }
    qr0 = as_bf8(pack8(a)); qr1 = as_bf8(pack8(bq));
  }
  auto local_scores = [&](int g) -> f32x4 {
    const int i = g >> 1, half = g & 1;
    const int ktok = b * 2048 + (rs + i) * 64 + kc0 + half * 16 + n;
    const bf16_t* kp = P.krot + (size_t)ktok * 256 + h * 64 + quad * 8;
    f32x4 acc = (f32x4){0.f, 0.f, 0.f, 0.f};
    acc = mfma16(*(const bf16x8*)kp, qr0, acc);
    acc = mfma16(*(const bf16x8*)(kp + 32), qr1, acc);
    const float* rb = rpb + (rs + i - r + 7) * 31;
    f32x4 o;
#pragma unroll
    for (int rr = 0; rr < 4; ++rr) {
      int kcol = kc0 + half * 16 + quad * 4 + rr;
      bool valid = (kcol >= cs_) && (kcol < cs_ + 16);
      int bi = min(max(kcol - cq + 15, 0), 30);
      o[rr] = valid ? (acc[rr] * 0.125f + rb[bi]) : -1e30f;
    }
    return o;
  };
  auto ctx_scores = [&](int g) -> f32x4 {
    const int ktok = NLAT + b * 256 + g * 16 + n;
    const bf16_t* kp = P.Pbuf + (size_t)ktok * PST + 768 + h * 64 + quad * 8;
    f32x4 acc = (f32x4){0.f, 0.f, 0.f, 0.f};
    acc = mfma16(*(const bf16x8*)kp, qp0, acc);
    acc = mfma16(*(const bf16x8*)(kp + 32), qp1, acc);
    return acc * 0.125f;
  };
  float mx = -1e30f;
  if (LOCAL) {
#pragma unroll 2
    for (int g = 0; g < 16; ++g) { f32x4 v = local_scores(g); mx = fmaxf(mx, fmaxf(fmaxf(v[0], v[1]), fmaxf(v[2], v[3]))); }
  }
#pragma unroll 2
  for (int g = 0; g < 16; ++g) { f32x4 v = ctx_scores(g); mx = fmaxf(mx, fmaxf(fmaxf(v[0], v[1]), fmaxf(v[2], v[3]))); }
  mx = fmaxf(mx, __shfl_xor(mx, 16)); mx = fmaxf(mx, __shfl_xor(mx, 32));
  float sum = 0.f;
  f32x4 O[4];
#pragma unroll
  for (int i = 0; i < 4; ++i) O[i] = (f32x4){0.f, 0.f, 0.f, 0.f};
  if (LOCAL) {
#pragma unroll 1
    for (int i = 0; i < 8; ++i) {
      f32x4 va = local_scores(2 * i), vb = local_scores(2 * i + 1);
      float pa[4], pbv[4];
#pragma unroll
      for (int rr = 0; rr < 4; ++rr) { pa[rr] = __expf(va[rr] - mx); pbv[rr] = __expf(vb[rr] - mx); sum += pa[rr] + pbv[rr]; }
      uint4 pb; pb.x = pack2(pa[0], pa[1]); pb.y = pack2(pa[2], pa[3]); pb.z = pack2(pbv[0], pbv[1]); pb.w = pack2(pbv[2], pbv[3]);
      const int tbase = (rs + i) * 64 + kc0 + quad * 4;
#pragma unroll
      for (int dt = 0; dt < 4; ++dt) {
        const bf16_t* vp = P.vt_lat + ((size_t)(b * 4 + h) * 64 + dt * 16 + n) * 2048 + tbase;
        uint2 lo = *(const uint2*)vp, hi = *(const uint2*)(vp + 16);
        O[dt] = mfma16(as_bf8(make_uint4(lo.x, lo.y, hi.x, hi.y)), as_bf8(pb), O[dt]);
      }
    }
  }
#pragma unroll 1
  for (int k = 0; k < 8; ++k) {
    f32x4 va = ctx_scores(2 * k), vb = ctx_scores(2 * k + 1);
    float pa[4], pbv[4];
#pragma unroll
    for (int rr = 0; rr < 4; ++rr) { pa[rr] = __expf(va[rr] - mx); pbv[rr] = __expf(vb[rr] - mx); sum += pa[rr] + pbv[rr]; }
    uint4 pb; pb.x = pack2(pa[0], pa[1]); pb.y = pack2(pa[2], pa[3]); pb.z = pack2(pbv[0], pbv[1]); pb.w = pack2(pbv[2], pbv[3]);
#pragma unroll
    for (int dt = 0; dt < 4; ++dt) {
      const bf16_t* vp = P.vt_ctx + ((size_t)(b * 4 + h) * 64 + dt * 16 + n) * 256 + k * 32 + quad * 4;
      uint2 lo = *(const uint2*)vp, hi = *(const uint2*)(vp + 16);
      O[dt] = mfma16(as_bf8(make_uint4(lo.x, lo.y, hi.x, hi.y)), as_bf8(pb), O[dt]);
    }
  }
  sum += __shfl_xor(sum, 16); sum += __shfl_xor(sum, 32);
  const float inv = 1.f / sum;
  bf16_t* yo = P.Ybuf + (size_t)qtok * 1024 + 256 + h * 64 + quad * 4;
#pragma unroll
  for (int dt = 0; dt < 4; ++dt) {
    uint2 v; v.x = pack2(O[dt][0] * inv, O[dt][1] * inv); v.y = pack2(O[dt][2] * inv, O[dt][3] * inv);
    *(uint2*)(yo + dt * 16) = v;
  }
}

template <bool PASS3>
__device__ __forceinline__ void ssd_task(const Params& P, int l, int b, int g, int ch, unsigned char* smem) {
  _Float16* xs = (_Float16*)smem;
  _Float16* Bs = xs + 64 * 128;
  _Float16* Cs = Bs + 64 * 64;
  float* dts = (float*)(Cs + 64 * 64);
  float* decs = dts + 256;
  float* as_ = decs + 256;
  _Float16* yt = (_Float16*)(as_ + 256);
  const int tid = tidx();
  const bool lat = ch >= 4;
  const int len = lat ? 2048 : 256;
  const int pos0 = lat ? (ch - 4) * 64 : ch * 64;
  const int tok0 = lat ? b * 2048 + pos0 : NLAT + b * 256 + pos0;
  __syncthreads();
  {
    const int col = (tid < 128) ? g * 128 + tid : (tid < 192 ? 256 + g * 64 + (tid - 128) : 384 + g * 64 + (tid - 192));
    const float w0 = P.ssd_conv_w[(l * 3 + 0) * 512 + col], w1 = P.ssd_conv_w[(l * 3 + 1) * 512 + col], w2 = P.ssd_conv_w[(l * 3 + 2) * 512 + col];
    const float bs = P.ssd_conv_b[l * 512 + col];
    const bf16_t* pp = P.Pbuf + (size_t)tok0 * PST + 2304 + col;
    float pv = (pos0 > 0) ? bf2f(pp[-(ptrdiff_t)PST]) : 0.f;
    float cu = bf2f(pp[0]);
    _Float16* dst = (tid < 128) ? xs + tid : (tid < 192 ? Bs + (tid - 128) : Cs + (tid - 192));
    const int dstride = (tid < 128) ? 128 : 64;
    for (int t = 0; t < 64; ++t) {
      float nx = (pos0 + t + 1 < len) ? bf2f(pp[(size_t)(t + 1) * PST]) : 0.f;
      float v = siluf_(w0 * pv + w1 * cu + w2 * nx + bs);
      dst[t * dstride] = (_Float16)v;
      pv = cu; cu = nx;
    }
    {
      const int t = tid >> 2, k = tid & 3, dir = k >> 1, hh = k & 1, head = g * 2 + hh;
      float raw = P.dtbuf[(size_t)(tok0 + t) * 8 + dir * 4 + head] + P.ssd_dt_bias[(l * 2 + dir) * 4 + head];
      float dtv = (raw > 20.f) ? raw : log1pf(expf(raw));
      float a = -dtv * expf(P.ssd_a_log[(l * 2 + dir) * 4 + head]);
      dts[tid] = dtv; as_[tid] = a; decs[tid] = expf(a);
    }
    if (PASS3) for (int i = tid; i < 64 * 128; i += NTHREADS) yt[i] = (_Float16)0.f;
  }
  __syncthreads();
  const int hh = tid >> 7, p = (tid >> 1) & 63, nh = tid & 1;
  const int head = g * 2 + hh;
  float stf[32], stb[32];
  float* sf = P.sst + ((((size_t)b * 2 + 0) * 4 + head) * NCH + ch) * 4096 + p * 64 + nh * 32;
  float* sb = P.sst + ((((size_t)b * 2 + 1) * 4 + head) * NCH + ch) * 4096 + p * 64 + nh * 32;
  if (PASS3) {
#pragma unroll
    for (int i = 0; i < 8; ++i) {
      float4 a = *(const float4*)(sf + i * 4); stf[i * 4] = a.x; stf[i * 4 + 1] = a.y; stf[i * 4 + 2] = a.z; stf[i * 4 + 3] = a.w;
      float4 c = *(const float4*)(sb + i * 4); stb[i * 4] = c.x; stb[i * 4 + 1] = c.y; stb[i * 4 + 2] = c.z; stb[i * 4 + 3] = c.w;
    }
  } else {
#pragma unroll
    for (int i = 0; i < 32; ++i) { stf[i] = 0.f; stb[i] = 0.f; }
  }
  for (int k = 0; k < 64; ++k) {
    {
      const float dtv = dts[k * 4 + hh], dec = decs[k * 4 + hh];
      const float xd = (float)xs[k * 128 + hh * 64 + p] * dtv;
      const _Float16* br = Bs + k * 64 + nh * 32;
#pragma unroll
      for (int i = 0; i < 32; ++i) stf[i] = stf[i] * dec + xd * (float)br[i];
      if (PASS3) {
        const _Float16* cr = Cs + k * 64 + nh * 32;
        float y0 = 0.f, y1 = 0.f, y2 = 0.f, y3 = 0.f;
#pragma unroll
        for (int i = 0; i < 32; i += 4) { y0 += stf[i] * (float)cr[i]; y1 += stf[i + 1] * (float)cr[i + 1]; y2 += stf[i + 2] * (float)cr[i + 2]; y3 += stf[i + 3] * (float)cr[i + 3]; }
        float y = (y0 + y1) + (y2 + y3);
        y += __shfl_xor(y, 1);
        if (nh == 0) { _Float16* yp = yt + k * 128 + hh * 64 + p; *yp = (_Float16)((float)*yp + y); }
      }
    }
    {
      const int kk = 63 - k;
      const float dtv = dts[kk * 4 + 2 + hh], dec = decs[kk * 4 + 2 + hh];
      const float xd = (float)xs[kk * 128 + hh * 64 + p] * dtv;
      const _Float16* br = Bs + kk * 64 + nh * 32;
#pragma unroll
      for (int i = 0; i < 32; ++i) stb[i] = stb[i] * dec + xd * (float)br[i];
      if (PASS3) {
        const _Float16* cr = Cs + kk * 64 + nh * 32;
        float y0 = 0.f, y1 = 0.f, y2 = 0.f, y3 = 0.f;
#pragma unroll
        for (int i = 0; i < 32; i += 4) { y0 += stb[i] * (float)cr[i]; y1 += stb[i + 1] * (float)cr[i + 1]; y2 += stb[i + 2] * (float)cr[i + 2]; y3 += stb[i + 3] * (float)cr[i + 3]; }
        float y = (y0 + y1) + (y2 + y3);
        y += __shfl_xor(y, 1);
        if (nh == 0) { _Float16* yp = yt + kk * 128 + hh * 64 + p; *yp = (_Float16)((float)*yp + y); }
      }
    }
  }
  if (!PASS3) {
#pragma unroll
    for (int i = 0; i < 8; ++i) {
      *(float4*)(sf + i * 4) = make_float4(stf[i * 4], stf[i * 4 + 1], stf[i * 4 + 2], stf[i * 4 + 3]);
      *(float4*)(sb + i * 4) = make_float4(stb[i * 4], stb[i * 4 + 1], stb[i * 4 + 2], stb[i * 4 + 3]);
    }
    if (tid < 4) {
      const int dir = tid >> 1, h2 = tid & 1;
      float a = 0.f;
      for (int t = 0; t < 64; ++t) a += as_[t * 4 + tid];
      P.ssumA[(((size_t)b * 2 + dir) * 4 + g * 2 + h2) * NCH + ch] = a;
    }
  } else {
    __syncthreads();
    const int t = tid >> 2, part = tid & 3;
    const int hd = g * 2 + (part >> 1);
    const float dsk = P.ssd_d[l * 4 + hd];
    float val[32];
    float sq = 0.f;
    const bf16_t* zr = P.Pbuf + (size_t)(tok0 + t) * PST + 2048 + g * 128 + part * 32;
#pragma unroll
    for (int i = 0; i < 32; ++i) {
      int cc = part * 32 + i;
      float y = (float)yt[t * 128 + cc] + (float)xs[t * 128 + cc] * dsk;
      float z = bf2f(zr[i]);
      y *= siluf_(z);
      val[i] = y; sq += y * y;
    }
    sq += __shfl_xor(sq, 1); sq += __shfl_xor(sq, 2);
    const float rinv = rsqrtf(sq * (1.f / 128.f) + LN_EPS);
    bf16_t* yo = P.Ybuf + (size_t)(tok0 + t) * 1024 + 768 + g * 128 + part * 32;
    const float* ngp = P.ssd_norm_g + l * 256 + g * 128 + part * 32;
#pragma unroll
    for (int i8 = 0; i8 < 4; ++i8) {
      float f[8];
#pragma unroll
      for (int j = 0; j < 8; ++j) f[j] = val[i8 * 8 + j] * rinv * ngp[i8 * 8 + j];
      *(uint4*)(yo + i8 * 8) = pack8(f);
    }
  }
}

__device__ __forceinline__ void ssd_prefix_task(const Params& P, int bdh, int part) {
  const int dir = (bdh >> 2) & 1;
  float* base = P.sst + (size_t)bdh * NCH * 4096 + part * 256 + tidx();
  const float* sa = P.ssumA + (size_t)bdh * NCH;
  float carry = 0.f;
  for (int i = 0; i < NCH; ++i) {
    int ch = dir ? (i < 4 ? 3 - i : 39 - i) : i;
    float loc = base[(size_t)ch * 4096];
    base[(size_t)ch * 4096] = carry;
    carry = expf(sa[ch]) * carry + loc;
  }
}

__device__ __forceinline__ int f2key(float f) { int b = __float_as_int(f); return b ^ ((b >> 31) & 0x7FFFFFFF); }
__device__ __forceinline__ float key2f(int k) { return __int_as_float(k ^ ((k >> 31) & 0x7FFFFFFF)); }
#define CE_DESC(a, b) { int _x = max(a, b); int _y = min(a, b); a = _x; b = _y; }
#define CE_ASC(a, b) { int _x = min(a, b); int _y = max(a, b); a = _x; b = _y; }
__device__ __forceinline__ void sort16_desc(int* a) {
#pragma unroll
  for (int k = 2; k <= 16; k <<= 1)
#pragma unroll
    for (int j = k >> 1; j > 0; j >>= 1)
#pragma unroll
      for (int i = 0; i < 16; ++i) {
        int lq = i ^ j;
        if (lq > i) { if ((i & k) == 0) CE_DESC(a[i], a[lq]) else CE_ASC(a[i], a[lq]) }
      }
}
__device__ __forceinline__ void merge16_desc(int* a, const int* b) {
#pragma unroll
  for (int i = 0; i < 16; ++i) a[i] = max(a[i], b[15 - i]);
#pragma unroll
  for (int j = 8; j > 0; j >>= 1)
#pragma unroll
    for (int i = 0; i < 16; ++i) {
      int lq = i ^ j;
      if (lq > i) CE_DESC(a[i], a[lq])
    }
}

__device__ __forceinline__ void gemm_acc32(const bf16_t* __restrict__ A, int lda, const bf16_t* __restrict__ Bt, int ldb,
                                           int K, int m0, int n0, unsigned char* smem, f32x4 (&acc)[4][4]) {
  bf16_t* As = (bf16_t*)smem;
  bf16_t* Bs = As + 2 * 128 * 40;
  const int tid = tidx(), lane = tid & 63, wave = tid >> 6;
  const int wm = wave >> 1, wn = wave & 1;
  const int lr = tid >> 1, lh = tid & 1;
  const bf16_t* ag = A + (size_t)(m0 + lr) * lda + lh * 16;
  const bf16_t* bg = Bt + (size_t)(n0 + lr) * ldb + lh * 16;
#pragma unroll
  for (int i = 0; i < 4; ++i)
#pragma unroll
    for (int j = 0; j < 4; ++j) acc[i][j] = (f32x4){0.f, 0.f, 0.f, 0.f};
  uint4 ra0 = *(const uint4*)ag, ra1 = *(const uint4*)(ag + 8);
  uint4 rb0 = *(const uint4*)bg, rb1 = *(const uint4*)(bg + 8);
  __syncthreads();
  {
    bf16_t* pa = As + lr * 40 + lh * 16; bf16_t* pb = Bs + lr * 40 + lh * 16;
    *(uint4*)pa = ra0; *(uint4*)(pa + 8) = ra1; *(uint4*)pb = rb0; *(uint4*)(pb + 8) = rb1;
  }
  __syncthreads();
  const int nk = K >> 5;
  for (int kt = 0; kt < nk; ++kt) {
    const int cur = kt & 1;
    if (kt + 1 < nk) {
      const bf16_t* a2 = ag + (kt + 1) * 32; const bf16_t* b2 = bg + (kt + 1) * 32;
      ra0 = *(const uint4*)a2; ra1 = *(const uint4*)(a2 + 8); rb0 = *(const uint4*)b2; rb1 = *(const uint4*)(b2 + 8);
    }
    const bf16_t* as = As + cur * 5120 + (wm * 64 + (lane & 15)) * 40 + (lane >> 4) * 8;
    const bf16_t* bs = Bs + cur * 5120 + (wn * 64 + (lane & 15)) * 40 + (lane >> 4) * 8;
    bf16x8 afr[4];
#pragma unroll
    for (int j = 0; j < 4; ++j) afr[j] = *(const bf16x8*)(bs + j * 16 * 40);
#pragma unroll
    for (int i = 0; i < 4; ++i) {
      const bf16x8 bfr = *(const bf16x8*)(as + i * 16 * 40);
#pragma unroll
      for (int j = 0; j < 4; ++j) acc[i][j] = mfma16(afr[j], bfr, acc[i][j]);
    }
    if (kt + 1 < nk) {
      bf16_t* pa = As + (cur ^ 1) * 5120 + lr * 40 + lh * 16; bf16_t* pb = Bs + (cur ^ 1) * 5120 + lr * 40 + lh * 16;
      *(uint4*)pa = ra0; *(uint4*)(pa + 8) = ra1; *(uint4*)pb = rb0; *(uint4*)(pb + 8) = rb1;
    }
    __syncthreads();
  }
}

__device__ __forceinline__ void peer_topk_task(const Params& P, int l, int tm, int h, unsigned char* smem) {
  float* sc = (float*)smem;
  int* fin = (int*)(smem + 33280);
  const int tid = tidx(), lane = tid & 63, wave = tid >> 6;
  const int wm = wave >> 1, wn = wave & 1;
  const int row64 = tid & 63, quarter = tid >> 6;
  int* K1 = (int*)(smem + 40960);
  int* K2a = (int*)(smem + 49152);
#pragma unroll
  for (int pp = 0; pp < 2; ++pp) {
    const bf16_t* A = P.qbuf + (h * 2 + pp) * 128;
    const bf16_t* Bt = P.keysb + ((size_t)(l * 8 + h) * 2 + pp) * 128 * 128;
#pragma unroll 1
    for (int half = 0; half < 2; ++half) {
      {
        f32x4 acc[4][4];
        gemm_acc32(A, 2048, Bt, 128, 128, tm * 128, 0, smem, acc);
        if (wm == half) {
#pragma unroll
          for (int i = 0; i < 4; ++i)
#pragma unroll
            for (int j = 0; j < 4; ++j) {
              float* d = sc + (i * 16 + (lane & 15)) * 129 + wn * 64 + j * 16 + (lane >> 4) * 4;
              d[0] = acc[i][j][0]; d[1] = acc[i][j][1]; d[2] = acc[i][j][2]; d[3] = acc[i][j][3];
            }
        }
      }
      __syncthreads();
      int run[16];
#pragma unroll
      for (int i = 0; i < 16; ++i) run[i] = (int)0x80000000;
#pragma unroll 1
      for (int grp = 0; grp < 2; ++grp) {
        int cur[16];
#pragma unroll
        for (int i = 0; i < 16; ++i) {
          int col = quarter * 32 + grp * 16 + i;
          cur[i] = (f2key(sc[row64 * 129 + col]) & ~127) | col;
        }
        sort16_desc(cur);
        merge16_desc(run, cur);
      }
      if (quarter != 0) {
#pragma unroll
        for (int i = 0; i < 16; ++i) sc[row64 * 129 + quarter * 32 + i] = __int_as_float(run[i]);
      }
      __syncthreads();
      if (quarter == 0) {
#pragma unroll 1
        for (int q = 1; q < 4; ++q) {
          int oth[16];
#pragma unroll
          for (int i = 0; i < 16; ++i) oth[i] = __float_as_int(sc[row64 * 129 + q * 32 + i]);
          merge16_desc(run, oth);
        }
        if (half == 0) {
#pragma unroll
          for (int i = 0; i < 16; ++i) { if (pp == 0) K1[row64 * 16 + i] = run[i]; else K2a[row64 * 16 + i] = run[i]; }
        } else {
#pragma unroll
          for (int i = 0; i < 16; ++i) fin[row64 * 16 + i] = run[i];
        }
      }
      __syncthreads();
    }
    if (pp == 0 && tid >= 64 && tid < 128) {
#pragma unroll
      for (int i = 0; i < 16; ++i) K1[tid * 16 + i] = fin[(tid - 64) * 16 + i];
    }
    __syncthreads();
  }
  const int row = tid & 127, half = tid >> 7;
  int* lists = (int*)smem;
  if (half == 0) {
#pragma unroll
    for (int i = 0; i < 16; ++i) { lists[row * 33 + i] = K1[row * 16 + i]; lists[row * 33 + 16 + i] = (row < 64) ? K2a[row * 16 + i] : fin[(row - 64) * 16 + i]; }
  }
  if (half == 0) {
    float v2[16];
#pragma unroll
    for (int i = 0; i < 16; ++i) v2[i] = key2f(lists[row * 33 + 16 + i] & ~127);
    int run[16];
    {
      const float v0 = key2f(lists[row * 33] & ~127);
#pragma unroll
      for (int j = 0; j < 16; ++j) run[j] = (f2key(v0 + v2[j]) & ~255) | (15 - j);
    }
#pragma unroll 1
    for (int i = 1; i < 8; ++i) {
      int cur[16];
      const float vi = key2f(lists[row * 33 + i] & ~127);
#pragma unroll
      for (int j = 0; j < 16; ++j) cur[j] = (f2key(vi + v2[j]) & ~255) | (i * 16 + 15 - j);
      merge16_desc(run, cur);
    }
    {
      int cur[16];
#pragma unroll
      for (int k = 0; k < 8; ++k) cur[k] = (f2key(key2f(lists[row * 33 + 8 + k] & ~127) + v2[0]) & ~255) | ((8 + k) * 16 + 15);
#pragma unroll
      for (int k = 8; k < 16; ++k) cur[k] = (int)0x80000000;
      merge16_desc(run, cur);
    }
    const float c0 = key2f(run[0] & ~255);
    float sum = 0.f;
#pragma unroll
    for (int k = 0; k < 16; ++k) sum += __expf(key2f(run[k] & ~255) - c0);
    const float inv = 1.f / sum;
    const int T = tm * 128 + row;
    int* eo = P.eidx + (size_t)T * 128 + h * 16;
    float* go = P.egate + (size_t)T * 128 + h * 16;
#pragma unroll
    for (int k = 0; k < 16; ++k) {
      int ci = run[k] & 255;
      int i = ci >> 4, j = 15 - (ci & 15);
      int i1 = lists[row * 33 + i] & 127, i2 = lists[row * 33 + 16 + j] & 127;
      eo[k] = i1 * 128 + i2;
      go[k] = __expf(key2f(run[k] & ~255) - c0) * inv;
    }
  }
}

#define XB_TMO      128
#define XB_XCNT(j)  (256  + 64 * (j))
#define XB_XSUB(j)  (1280 + 64 * (j))
#define XB_XGEN(j)  (2304 + 64 * (j))
#define XB_TOP      3328
#define XB_TOPGEN   3392
#define XCD_BAR_WORDS 3456
#define XB_SPIN_CAP (1u << 18)
#define LAS __attribute__((address_space(3)))

__device__ __forceinline__ unsigned xb_ld(unsigned* p)              { return __hip_atomic_load(p, __ATOMIC_RELAXED, __HIP_MEMORY_SCOPE_AGENT); }
__device__ __forceinline__ unsigned xb_add(unsigned* p, unsigned v) { return __hip_atomic_fetch_add(p, v, __ATOMIC_RELAXED, __HIP_MEMORY_SCOPE_AGENT); }
__device__ __forceinline__ unsigned xb_xcc_id() { return (unsigned)__builtin_amdgcn_s_getreg((3 << 11) | 20) & 0xFu; }
#define XB_SPIN(cond, bar) do { unsigned _sp = 0; while (cond) { __builtin_amdgcn_s_sleep(1); \
    if ((++_sp & 255u) == 0u) { if (xb_ld(&(bar)[XB_TMO])) break; if (_sp > XB_SPIN_CAP) { atomicAdd(&(bar)[XB_TMO], 1u); break; } } } } while (0)

struct XcdBarrier {
    unsigned* bar; unsigned x;
    volatile LAS unsigned* st;
};

__device__ __forceinline__ XcdBarrier xcd_barrier_post(unsigned* bar, volatile LAS unsigned* st) {
    XcdBarrier b; b.bar = bar; b.x = xb_xcc_id(); b.st = st;
    if (threadIdx.x == 0) (void)xb_add(&bar[XB_XCNT(b.x)], 1u);
    return b;
}
__device__ __forceinline__ void xcd_barrier_complete(unsigned* bar, unsigned x, unsigned& nloc, unsigned& nx) {
    const unsigned G = gridDim.x * gridDim.y * gridDim.z;
    unsigned sum, cnt, mine, sp = 0u;
    for (;;) {
        sum = 0u; cnt = 0u; mine = 0u;
#pragma unroll
        for (unsigned j = 0; j < 16; ++j) { const unsigned c = xb_ld(&bar[XB_XCNT(j)]); sum += c; cnt += (c > 0u) ? 1u : 0u; mine = (j == x) ? c : mine; }
        if (sum == G) break;
        __builtin_amdgcn_s_sleep(1);
        if ((++sp & 255u) == 0u) { if (xb_ld(&bar[XB_TMO])) break; if (sp > XB_SPIN_CAP) { atomicAdd(&bar[XB_TMO], 1u); break; } }
    }
    nloc = mine > 0u ? mine : 1u; nx = cnt > 0u ? cnt : 1u;
}

__device__ __forceinline__ void xcd_barrier(const XcdBarrier& b) {
    asm volatile("s_waitcnt vmcnt(0)" ::: "memory");
    __syncthreads();
    if (threadIdx.x == 0) {
        unsigned* bar = b.bar;
        __builtin_amdgcn_s_waitcnt(0);
        unsigned nloc = b.st[0], nx = b.st[1];
        if (nloc == 0u) { xcd_barrier_complete(bar, b.x, nloc, nx); b.st[0] = nloc; b.st[1] = nx; }
        const unsigned old = xb_add(&bar[XB_XSUB(b.x)], 1u);
        const unsigned gen = old / nloc;
        if (old + 1u == (gen + 1u) * nloc) {
            __builtin_amdgcn_fence(__ATOMIC_RELEASE, "agent");
            asm volatile("s_waitcnt vmcnt(0)" ::: "memory");
            const unsigned og = xb_add(&bar[XB_TOP], 1u);
            const unsigned tg = og / nx;
            if (og + 1u == (tg + 1u) * nx) xb_add(&bar[XB_TOPGEN], 1u);
            else XB_SPIN(xb_ld(&bar[XB_TOPGEN]) == tg, bar);
            __builtin_amdgcn_fence(__ATOMIC_ACQUIRE, "agent");
            xb_add(&bar[XB_XGEN(b.x)], 1u);
            asm volatile("s_waitcnt vmcnt(0)" ::: "memory");
        } else {
            XB_SPIN(xb_ld(&bar[XB_XGEN(b.x)]) == gen, bar);
            __builtin_amdgcn_fence(__ATOMIC_ACQUIRE, "agent");
            asm volatile("s_waitcnt vmcnt(0)" ::: "memory");
        }
    }
    __syncthreads();
}


__device__ __forceinline__ int next_task(unsigned* cnt, int* slot) {
  __syncthreads();
  if (tidx() == 0) *slot = (int)__hip_atomic_fetch_add(cnt, 1u, __ATOMIC_RELAXED, __HIP_MEMORY_SCOPE_AGENT);
  __syncthreads();
  return *slot;
}
enum { PH_PRE0 = 0, PH_PRE1, PH_PRE2, PH_L1, PH_L2, PH_L3, PH_L4, PH_L5, PH_L6, PH_L7, PH_L8, PH_L9, PH_L9W, PH_L9B, PH_L9C, PH_COUNT };
struct XInfo { int slot, nx, rank, nloc; };
#define QCNT(i) (XCD_BAR_WORDS + 16 * 64 + 64 * (i))

template <int ph>
__device__ __forceinline__ void run_phase(const Params& P, const XInfo& X, int l, unsigned char* smem, const bool rep = false) {
  const int nb = gridDim.x, bid = blockIdx.x, tid = tidx(), lane = tid & 63, wave = tid >> 6;
  const int rbid = nb - 1 - bid;
  __shared__ int sQ;
  const int ntok = (l == 0) ? NTOK : NLAT;
  const int mt_out = ntok / 128;
  switch (ph) {
    case PH_PRE0: {
      for (int u = bid; u < 768; u += nb) modpart_task(P, u / 384, (u / 24) % 16, u % 24, smem);
      for (int u = rbid; u < 2 * 46 * 16; u += nb) { int ll = u / 736, r = u % 736; transpose_task(P.w_in + (size_t)ll * 1024 * 2824, P.wt_in + (size_t)ll * 2944 * 1024, 1024, 2824, (r % 16) * 64, (r / 16) * 64, smem); }
      for (int u = bid; u < 2 * 16 * 16; u += nb) { int ll = u / 256, r = u % 256; transpose_task(P.w_out + (size_t)ll * 1024 * 1024, P.wt_out + (size_t)ll * 1024 * 1024, 1024, 1024, (r % 16) * 64, (r / 16) * 64, smem); }
      for (int u = rbid; u < 2 * 32 * 16; u += nb) { int ll = u / 512, r = u % 512; transpose_task(P.peer_wq + (size_t)ll * 1024 * 2048, P.wt_q + (size_t)ll * 2048 * 1024, 1024, 2048, (r % 16) * 64, (r / 16) * 64, smem); }
      for (int u = bid; u < 256; u += nb) {
        size_t o = ((size_t)u * 256 + tid) * 8; float f[8];
#pragma unroll
        for (int j = 0; j < 8; ++j) f[j] = P.peer_keys[o + j];
        *(uint4*)(P.keysb + o) = pack8(f);
      }
      for (int u = rbid; u < 2 * 576; u += nb) { int ll = u / 576, r = u % 576; if (r < 512) hm2_task(P, ll, 0, r, smem); else hm2_task(P, ll, 1, r - 512, smem); }
      if (bid == nb - 1) {
        for (int i = tid; i < 1024; i += NTHREADS) {
          int pos = i >> 4, f = i & 15;
          float inv = powf(10000.f, -(float)f / 16.f);
          float ang = (float)pos * inv;
          P.ropetab[i] = cosf(ang); P.ropetab[1024 + i] = sinf(ang);
        }
      }
    } break;
    case PH_PRE1: {
      for (int t = bid; t < 816; t += nb) {
        int i = t * 256 + tid;
        int ll = i / (17 * 6144), rem = i % (17 * 6144), col = rem % 6144;
        float a = P.b_ada[ll * 6144 + col];
#pragma unroll
        for (int ks = 0; ks < 16; ++ks) a += P.modp[((size_t)ll * 16 + ks) * 17 * 6144 + rem];
        P.mod[i] = a;
      }
      for (int u = rbid; u < 2048; u += nb) filt_task(P, u >> 10, (u >> 9) & 1, u & 511, smem);
    } break;
    case PH_PRE2: {
      for (int T = bid * 4 + wave; T < NTOK; T += nb * 4) hmod0_token(P, T, lane);
    } break;
    case PH_L1: {
      const int ntile = (NTOK / 128) * 23;
      bf16_t* Pb = P.Pbuf; float* dtb = P.dtbuf;
      const bf16_t* Ain = P.Ybuf; const bf16_t* Win = P.wt_in + (size_t)l * 2944 * 1024;
      for (int t = bid; t < ntile; t += nb) {
        int tm = t / 23, tn = t % 23;
        gemm_tile32(Ain, 1024, Win, 1024, 1024, tm * 128, tn * 128, smem, [&](int m, int n, f32x4 v) {
          if (n < 2816) { uint2 o; o.x = pack2(v[0], v[1]); o.y = pack2(v[2], v[3]); *(uint2*)(Pb + (size_t)m * PST + n) = o; }
          else if (n < 2824) { *(float4*)(dtb + (size_t)m * 8 + (n - 2816)) = make_float4(v[0], v[1], v[2], v[3]); }
        });
      }
    } break;
    case PH_L2: {
      const int nS = NB * 2 * NCH, nCf = 512 + (l == 0 ? 64 : 0), nPr = 576;
      unsigned* cnt = P.bar + QCNT(l * 3 + 0);
      for (;;) {
        int u = next_task(cnt, &sQ);
        if (u >= nS + nCf + nPr) break;
        if (u < nS) { ssd_task<false>(P, l, u / (2 * NCH), (u / NCH) & 1, u % NCH, smem); continue; }
        u -= nS;
        if (u < nCf) { if (u < 512) conf_task(P, l, (u >> 5) * 2048, 2048, (u & 31) * 64, smem); else { int v = u - 512; conf_task(P, l, NLAT + (v >> 2) * 256, 256, (v & 3) * 64, smem); } continue; }
        u -= nCf;
        if (u < 512) prep_task(P, l, true, u >> 5, (u & 31) * 64); else { int v = u - 512; prep_task(P, l, false, v >> 2, (v & 3) * 64); }
      }
    } break;
    case PH_L3: {
      const int nH = 2048 + (l == 0 ? 256 : 0), nA = 2048, nAc = (l == 0 ? 256 : 0), nPf = rep ? 0 : 2048;
      unsigned* cnt = P.bar + QCNT(l * 3 + 1);
      for (;;) {
        int u = next_task(cnt, &sQ);
        if (u >= nH + nA + nAc + nPf) break;
        if (u < nH) { if (u < 2048) hyconv_task(P, l, true, u >> 3, (u & 7) * 256, smem); else hyconv_task(P, l, false, u - 2048, 0, smem); continue; }
        u -= nH;
        if (u < nA) { int b = u >> 7, r = (u >> 2) & 31, c0 = (u & 3) * 16; attn_task<true>(P, l, b, r, c0, wave, lane); continue; }
        u -= nA;
        if (u < nAc) { attn_task<false>(P, l, u >> 4, 0, (u & 15) * 16, wave, lane); continue; }
        u -= nAc;
        ssd_prefix_task(P, u >> 4, u & 15);
      }
    } break;
    case PH_L4: {
      const int nS = (l == 0) ? NB * 2 * NCH : NB * 2 * 32, nHf = 512 + (l == 0 ? 64 : 0);
      unsigned* cnt = P.bar + QCNT(l * 3 + 2);
      for (;;) {
        int u = next_task(cnt, &sQ);
        if (u >= nS + nHf) break;
        if (u < nS) {
          if (l == 0) ssd_task<true>(P, l, u / (2 * NCH), (u / NCH) & 1, u % NCH, smem);
          else ssd_task<true>(P, l, u / 64, (u / 32) & 1, 4 + (u % 32), smem);
          continue;
        }
        u -= nS;
        if (u < 512) hyfin_task(P, l, true, u >> 5, (u & 31) * 64); else { int v = u - 512; hyfin_task(P, l, false, v >> 2, (v & 3) * 64); }
      }
    } break;
    case PH_L5: {
      const int ng = mt_out * 8;
      bf16_t* Yo = P.Pbuf;
      const bf16_t* Ain = P.Ybuf; const bf16_t* Wt = P.wt_out + (size_t)l * 1024 * 1024;
      for (int t = bid; t < ng; t += nb) {
        int tm = t >> 3, tn = t & 7;
        gemm_tile32(Ain, 1024, Wt, 1024, 1024, tm * 128, tn * 128, smem, [&](int m, int n, f32x4 v) {
          uint2 o; o.x = pack2(v[0], v[1]); o.y = pack2(v[2], v[3]); *(uint2*)(Yo + (size_t)m * 1024 + n) = o;
        });
      }
      for (int u = rbid; u < 4096; u += nb) {
        const bool isv = u >= 2048;
        const int e0 = (u & 2047) * 8;
        const float* src = (isv ? P.peer_v : P.peer_u) + (size_t)l * 16384 * 1024 + (size_t)e0 * 1024;
        unsigned char* dstb = (unsigned char*)(isv ? P.tabv : P.tabu);
#pragma unroll
        for (int i = 0; i < 2; ++i) {
          int o = (i * 256 + tid) * 16;
          float4 a = *(const float4*)(src + o), bq = *(const float4*)(src + o + 4), c = *(const float4*)(src + o + 8), d = *(const float4*)(src + o + 12);
          uint4 r;
          r.x = pack4_fp8(a.x * 256.f, a.y * 256.f, a.z * 256.f, a.w * 256.f);
          r.y = pack4_fp8(bq.x * 256.f, bq.y * 256.f, bq.z * 256.f, bq.w * 256.f);
          r.z = pack4_fp8(c.x * 256.f, c.y * 256.f, c.z * 256.f, c.w * 256.f);
          r.w = pack4_fp8(d.x * 256.f, d.y * 256.f, d.z * 256.f, d.w * 256.f);
          *(uint4*)(dstb + (size_t)e0 * 1024 + o) = r;
        }
      }
    } break;
    case PH_L6: {
      for (int T = bid * 4 + wave; T < ntok; T += nb * 4) r1_token(P, l, T, lane, rep);
    } break;
    case PH_L7: {
      const int ng = mt_out * 16;
      bf16_t* Q = P.qbuf;
      for (int t = bid; t < ng; t += nb) {
        int tm = t >> 4, tn = t & 15;
        gemm_tile32(P.Ybuf, 1024, P.wt_q + (size_t)l * 2048 * 1024, 1024, 1024, tm * 128, tn * 128, smem, [&](int m, int n, f32x4 v) {
          uint2 o; o.x = pack2(v[0], v[1]); o.y = pack2(v[2], v[3]); *(uint2*)(Q + (size_t)m * 2048 + n) = o;
        });
      }
    } break;
    case PH_L8: {
      const int ng = mt_out * 8;
      for (int t = bid; t < ng; t += nb) peer_topk_task(P, l, t >> 3, t & 7, smem);
    } break;
    case PH_L9: {
      float* wl = (float*)smem + wave * 128;
      __syncthreads();
      for (int T0 = bid * 4 + wave; T0 < ntok; T0 += nb * 4) { const int T = __builtin_amdgcn_readfirstlane(T0); peer_token(P, l, T, lane, wl, false); }
    } break;
    case PH_L9W: {
      const size_t n = (size_t)ntok * 128;
      for (size_t i = (size_t)bid * 256 + tid; i < n; i += (size_t)nb * 256) {
        float a = 0.f;
#pragma unroll
        for (int x = 0; x < 8; ++x) a += P.pact[(size_t)x * NTOK * 128 + i];
        P.egate[i] = P.egate[i] * gelu_tanh(a * (1.f / 256.f));
      }
    } break;
    case PH_L9B: {
      int* li = (int*)smem + wave * 1024;
      __syncthreads();
      for (int sl = X.slot; sl < 8; sl += X.nx)
        { const int pw = (ntok + X.nloc * 4 - 1) / (X.nloc * 4); const int tf = __builtin_amdgcn_readfirstlane((X.rank * 4 + wave) * pw); peer_v_phase(P, sl, tf, 1, min(ntok, tf + pw), lane, li); }
    } break;
    case PH_L9C: {
      for (int T0 = bid * 4 + wave; T0 < ntok; T0 += nb * 4) { const int T = __builtin_amdgcn_readfirstlane(T0); ln2_token(P, l, T, lane); }
    } break;
  }
}

#if MULTI_LAUNCH
__global__ void __launch_bounds__(NTHREADS) phase_kernel(Params P, int ph, int l) {
  extern __shared__ __attribute__((aligned(16))) unsigned char smem[];
  __shared__ Params sP;
  if (threadIdx.x == 0) sP = P;
  __syncthreads();
  switch (ph) {
    case 0: run_phase<0>(sP, sX, l, smem); break; case 1: run_phase<1>(sP, sX, l, smem); break; case 2: run_phase<2>(sP, sX, l, smem); break;
    case 3: run_phase<3>(sP, sX, l, smem); break; case 4: run_phase<4>(sP, sX, l, smem); break; case 5: run_phase<5>(sP, sX, l, smem); break;
    case 6: run_phase<6>(sP, sX, l, smem); break; case 7: run_phase<7>(sP, sX, l, smem); break; case 8: run_phase<8>(sP, sX, l, smem); break;
    case 9: run_phase<9>(sP, sX, l, smem); break; case 10: run_phase<10>(sP, sX, l, smem); break; case 11: run_phase<11>(sP, sX, l, smem); break;
  }
}
#else
__global__ void __launch_bounds__(NTHREADS, 3) mega_kernel(Params P) {
  extern __shared__ __attribute__((aligned(16))) unsigned char smem[];
  cg::grid_group grid = cg::this_grid();
  __shared__ uint4 xb_words;
  if (threadIdx.x == 0) xb_words = make_uint4(0u, 0u, 0u, 0u);
  __syncthreads();
  XcdBarrier xb = xcd_barrier_post(P.bar, (volatile LAS unsigned*)&xb_words);
  __shared__ XInfo sX;
  if (threadIdx.x == 0) sX.rank = (int)xb_add(&P.bar[XCD_BAR_WORDS + 64 * xb.x], 1u);
  run_phase<PH_PRE0>(P, sX, 0, smem);
  if (P.bar == nullptr) grid.sync();
  xcd_barrier(xb);
  if (threadIdx.x == 0) {
    int slot = 0, nx = 0, nloc = 1;
    for (unsigned j = 0; j < 16; ++j) {
      const int c = (int)xb_ld(&P.bar[XCD_BAR_WORDS + 64 * j]);
      if (c > 0) { if (j < xb.x) ++slot; ++nx; }
      if (j == xb.x) nloc = c > 0 ? c : 1;
    }
    sX.slot = slot; sX.nx = nx > 0 ? nx : 1; sX.nloc = nloc;
  }
  __syncthreads();
  run_phase<PH_PRE1>(P, sX, 0, smem); xcd_barrier(xb);
  run_phase<PH_PRE2>(P, sX, 0, smem); xcd_barrier(xb);
  {
    constexpr int l = 0;
    run_phase<PH_L1>(P, sX, l, smem); xcd_barrier(xb);
#if defined(REPEAT_PH)
    if (REPEAT_PH == PH_L1) { run_phase<PH_L1>(P, sX, l, smem, true); xcd_barrier(xb); }
#endif
    run_phase<PH_L2>(P, sX, l, smem); xcd_barrier(xb);
#if defined(REPEAT_PH)
    if (REPEAT_PH == PH_L2) { run_phase<PH_L2>(P, sX, l, smem, true); xcd_barrier(xb); }
#endif
    run_phase<PH_L3>(P, sX, l, smem); xcd_barrier(xb);
#if defined(REPEAT_PH)
    if (REPEAT_PH == PH_L3) { run_phase<PH_L3>(P, sX, l, smem, true); xcd_barrier(xb); }
#endif
    run_phase<PH_L4>(P, sX, l, smem); xcd_barrier(xb);
#if defined(REPEAT_PH)
    if (REPEAT_PH == PH_L4) { run_phase<PH_L4>(P, sX, l, smem, true); xcd_barrier(xb); }
#endif
    run_phase<PH_L5>(P, sX, l, smem); xcd_barrier(xb);
#if defined(REPEAT_PH)
    if (REPEAT_PH == PH_L5) { run_phase<PH_L5>(P, sX, l, smem, true); xcd_barrier(xb); }
#endif
    run_phase<PH_L6>(P, sX, l, smem); xcd_barrier(xb);
#if defined(REPEAT_PH)
    if (REPEAT_PH == PH_L6) { run_phase<PH_L6>(P, sX, l, smem, true); xcd_barrier(xb); }
#endif
    run_phase<PH_L7>(P, sX, l, smem); xcd_barrier(xb);
#if defined(REPEAT_PH)
    if (REPEAT_PH == PH_L7) { run_phase<PH_L7>(P, sX, l, smem, true); xcd_barrier(xb); }
#endif
    run_phase<PH_L8>(P, sX, l, smem); xcd_barrier(xb);
#if defined(REPEAT_PH)
    if (REPEAT_PH == PH_L8) { run_phase<PH_L8>(P, sX, l, smem, true); xcd_barrier(xb); }
#endif
    run_phase<PH_L9>(P, sX, l, smem); xcd_barrier(xb);
#if defined(REPEAT_PH)
    if (REPEAT_PH == PH_L9) { run_phase<PH_L9>(P, sX, l, smem, true); xcd_barrier(xb); }
#endif
  }
  {
    constexpr int l = 1;
    run_phase<PH_L1>(P, sX, l, smem); xcd_barrier(xb);
#if defined(REPEAT_PH)
    if (REPEAT_PH == PH_L1) { run_phase<PH_L1>(P, sX, l, smem, true); xcd_barrier(xb); }
#endif
    run_phase<PH_L2>(P, sX, l, smem); xcd_barrier(xb);
#if defined(REPEAT_PH)
    if (REPEAT_PH == PH_L2) { run_phase<PH_L2>(P, sX, l, smem, true); xcd_barrier(xb); }
#endif
    run_phase<PH_L3>(P, sX, l, smem); xcd_barrier(xb);
#if defined(REPEAT_PH)
    if (REPEAT_PH == PH_L3) { run_phase<PH_L3>(P, sX, l, smem, true); xcd_barrier(xb); }
#endif
    run_phase<PH_L4>(P, sX, l, smem); xcd_barrier(xb);
#if defined(REPEAT_PH)
    if (REPEAT_PH == PH_L4) { run_phase<PH_L4>(P, sX, l, smem, true); xcd_barrier(xb); }
#endif
    run_phase<PH_L5>(P, sX, l, smem); xcd_barrier(xb);
#if defined(REPEAT_PH)
    if (REPEAT_PH == PH_L5) { run_phase<PH_L5>(P, sX, l, smem, true); xcd_barrier(xb); }
#endif
    run_phase<PH_L6>(P, sX, l, smem); xcd_barrier(xb);
#if defined(REPEAT_PH)
    if (REPEAT_PH == PH_L6) { run_phase<PH_L6>(P, sX, l, smem, true); xcd_barrier(xb); }
#endif
    run_phase<PH_L7>(P, sX, l, smem); xcd_barrier(xb);
#if defined(REPEAT_PH)
    if (REPEAT_PH == PH_L7) { run_phase<PH_L7>(P, sX, l, smem, true); xcd_barrier(xb); }
#endif
    run_phase<PH_L8>(P, sX, l, smem); xcd_barrier(xb);
#if defined(REPEAT_PH)
    if (REPEAT_PH == PH_L8) { run_phase<PH_L8>(P, sX, l, smem, true); xcd_barrier(xb); }
#endif
    run_phase<PH_L9>(P, sX, l, smem); xcd_barrier(xb);
#if defined(REPEAT_PH)
    if (REPEAT_PH == PH_L9) { run_phase<PH_L9>(P, sX, l, smem, true); xcd_barrier(xb); }
#endif
  }
}
#endif

extern "C" void kernel_launch(void* const* d_in, const int* in_sizes, int n_in, void* d_out, int out_size, void* d_ws, size_t ws_size, hipStream_t stream) {
  Params P{};
  const float** pf = (const float**)&P;
  for (int i = 0; i < 36; ++i) pf[i] = (const float*)d_in[i];
  P.out = (float*)d_out;
  unsigned char* w = (unsigned char*)d_ws;
  size_t off = 0;
  auto take = [&](size_t bytes) { unsigned char* p = w + off; off += (bytes + 255) & ~(size_t)255; return p; };
  P.Pbuf = (bf16_t*)take((size_t)NTOK * PST * 2);
  P.Ybuf = (bf16_t*)take((size_t)NTOK * 1024 * 2);
  P.xc = (float*)take((size_t)4096 * 1024 * 4);
  P.dtbuf = (float*)take((size_t)NTOK * 8 * 4);
  P.wt_in = (bf16_t*)take((size_t)2 * 2944 * 1024 * 2);
  P.wt_out = (bf16_t*)take((size_t)2 * 1024 * 1024 * 2);
  P.wt_q = (bf16_t*)take((size_t)2 * 2048 * 1024 * 2);
  P.keysb = (bf16_t*)take((size_t)2 * 8 * 2 * 128 * 128 * 2);
  P.modp = (float*)take((size_t)2 * 16 * 17 * 6144 * 4);
  P.mod = (float*)take((size_t)3 * 17 * 6144 * 4);
  P.hm2 = (float*)take((size_t)2 * 2 * 2048 * 64 * 4);
  P.gtab = (bf16_t*)take((size_t)2 * (256 * 2 * 4096 + 256 * 2 * 512) * 2);
  P.ropetab = (float*)take(2048 * 4);
  P.bar = (unsigned*)take((XCD_BAR_WORDS + 16 * 64 + 8 * 64) * 4);
  unsigned char* treg = w + off;
  P.krot = (bf16_t*)take((size_t)NLAT * 256 * 2);
  P.vt_lat = (bf16_t*)take((size_t)16 * 256 * 2048 * 2);
  P.vt_ctx = (bf16_t*)take((size_t)16 * 256 * 256 * 2);
  P.sst = (float*)take((size_t)16 * 2 * 4 * NCH * 4096 * 4);
  P.ssumA = (float*)take((size_t)16 * 2 * 4 * NCH * 4);
  const size_t hysz = (size_t)16 * 256 * (2048 + 256) * 2;
  P.uT = (bf16_t*)take(hysz);
  P.x0T = (bf16_t*)take(hysz);
  P.yT = (bf16_t*)take(hysz);
  P.tabu = (bf16_t*)treg;
  P.tabv = (bf16_t*)(treg + (size_t)16384 * 1024);
  P.pout = (bf16_t*)(treg + (size_t)40 * 1024 * 1024);
  P.pact = (float*)P.Pbuf;
  P.qbuf = P.Pbuf;
  P.eidx = (int*)((unsigned char*)P.Pbuf + (size_t)NTOK * 2048 * 2);
  P.egate = (float*)((unsigned char*)P.eidx + (size_t)NTOK * 128 * 4);
  if (off > ws_size || n_in != 36) { fprintf(stderr, "kernel_launch: workspace too small (%zu > %zu) or n_in %d != 36\n", off, ws_size, n_in); return; }

  static int grid = 0;
#if MULTI_LAUNCH
  if (!grid) {
    hipFuncSetAttribute((const void*)phase_kernel, hipFuncAttributeMaxDynamicSharedMemorySize, LDS_BYTES);
    grid = 512;
  }
  hipLaunchKernelGGL(phase_kernel, dim3(grid), dim3(NTHREADS), LDS_BYTES, stream, P, PH_PRE0, 0);
  hipLaunchKernelGGL(phase_kernel, dim3(grid), dim3(NTHREADS), LDS_BYTES, stream, P, PH_PRE1, 0);
  hipLaunchKernelGGL(phase_kernel, dim3(grid), dim3(NTHREADS), LDS_BYTES, stream, P, PH_PRE2, 0);
  for (int l = 0; l < 2; ++l)
    for (int ph = PH_L1; ph <= PH_L9; ++ph) hipLaunchKernelGGL(phase_kernel, dim3(grid), dim3(NTHREADS), LDS_BYTES, stream, P, ph, l);
#else
  if (!grid) {
    int dev = 0, cus = 0, per_cu = 0;
    hipGetDevice(&dev);
    hipDeviceGetAttribute(&cus, hipDeviceAttributeMultiprocessorCount, dev);
    hipFuncSetAttribute((const void*)mega_kernel, hipFuncAttributeMaxDynamicSharedMemorySize, LDS_BYTES);
    hipOccupancyMaxActiveBlocksPerMultiprocessor(&per_cu, (const void*)mega_kernel, NTHREADS, LDS_BYTES);
    if (per_cu < 1) { fprintf(stderr, "kernel_launch: occupancy query returned %d\n", per_cu); per_cu = 1; }
    if (per_cu > 3) per_cu = 3;
    grid = cus * per_cu;
  }
  if (hipMemsetAsync(P.bar, 0, (XCD_BAR_WORDS + 16 * 64 + 8 * 64) * 4, stream) != hipSuccess) { fprintf(stderr, "kernel_launch: memset of barrier words failed\n"); return; }
  void* args[] = {&P};
  hipError_t e = hipLaunchCooperativeKernel((const void*)mega_kernel, dim3(grid), dim3(NTHREADS), args, LDS_BYTES, stream);
  if (e != hipSuccess) fprintf(stderr, "cooperative launch failed: %s (grid %d)\n", hipGetErrorString(e), grid);
#endif
}
```

```cpp
#include <hip/hip_runtime.h>
#include <hip/hip_cooperative_groups.h>
#include <cstdio>
#include <cstdint>
namespace cg = cooperative_groups;

#ifndef MULTI_LAUNCH
#define MULTI_LAUNCH 0
#endif

typedef unsigned short bf16_t;
typedef __attribute__((ext_vector_type(8))) short bf16x8;
typedef __attribute__((ext_vector_type(4))) float f32x4;

#define D_MODEL 1024
#define NB 16
#define SEQ 2048
#define CTXL 256
#define NLAT 32768
#define NTOK 36864
#define PST 2816
#define NCH 36
#define LDS_BYTES 53248
#define NTHREADS 256
#define ALPHA 1.41421356237f
#define LN_EPS 1e-5f

struct Params {
  const float *x, *c, *ctx, *c_ctx, *w_ada, *b_ada, *w_in, *w_out, *ln1_g, *ln1_b, *ln2_g, *ln2_b;
  const float *conf_dw_w, *conf_dw_b, *conf_norm_g, *conf_norm_b, *na_rpb, *hy_short_w, *hy_short_b;
  const float *hy_w1, *hy_b1, *hy_w2, *hy_b2, *hy_w3, *hy_decay, *hy_bias;
  const float *ssd_conv_w, *ssd_conv_b, *ssd_a_log, *ssd_dt_bias, *ssd_d, *ssd_norm_g;
  const float *peer_wq, *peer_keys, *peer_u, *peer_v;
  float* out;
  bf16_t* Pbuf;
  bf16_t* Ybuf;
  float*  xc;
  float*  dtbuf;
  bf16_t* wt_in;
  bf16_t* wt_out;
  bf16_t* wt_q;
  bf16_t* keysb;
  float*  modp;
  float*  mod;
  float*  hm2;
  bf16_t* gtab;
  float*  ropetab;
  bf16_t* krot;
  bf16_t* vt_lat;
  bf16_t* vt_ctx;
  float*  sst;
  float*  ssumA;
  bf16_t* uT;
  bf16_t* x0T;
  bf16_t* yT;
  bf16_t* tabu;
  bf16_t* tabv;
  int*    eidx;
  float*  egate;
  bf16_t* qbuf;
  unsigned* bar;
  float* pact;
  bf16_t* pout;
};

__device__ __forceinline__ bf16_t f2bf(float f) { unsigned u = __float_as_uint(f); u += 0x7FFFu + ((u >> 16) & 1u); return (bf16_t)(u >> 16); }
__device__ __forceinline__ float bf2f(bf16_t h) { return __uint_as_float(((unsigned)h) << 16); }
__device__ __forceinline__ unsigned pack2(float a, float b) { return (unsigned)f2bf(a) | ((unsigned)f2bf(b) << 16); }
__device__ __forceinline__ float lo2f(unsigned u) { return __uint_as_float(u << 16); }
__device__ __forceinline__ float hi2f(unsigned u) { return __uint_as_float(u & 0xFFFF0000u); }
__device__ __forceinline__ float sigmoidf_(float x) { return 1.f / (1.f + __expf(-x)); }
__device__ __forceinline__ float siluf_(float x) { return x / (1.f + __expf(-x)); }
__device__ __forceinline__ float wave_sum(float v) {
#pragma unroll
  for (int o = 32; o >= 1; o >>= 1) v += __shfl_xor(v, o);
  return v;
}
__device__ __forceinline__ void unpack8(uint4 v, float* f) {
  f[0] = lo2f(v.x); f[1] = hi2f(v.x); f[2] = lo2f(v.y); f[3] = hi2f(v.y);
  f[4] = lo2f(v.z); f[5] = hi2f(v.z); f[6] = lo2f(v.w); f[7] = hi2f(v.w);
}
__device__ __forceinline__ uint4 pack8(const float* f) {
  uint4 v; v.x = pack2(f[0], f[1]); v.y = pack2(f[2], f[3]); v.z = pack2(f[4], f[5]); v.w = pack2(f[6], f[7]); return v;
}
__device__ __forceinline__ bf16x8 as_bf8(uint4 v) { union { uint4 u; bf16x8 b; } x; x.u = v; return x.b; }
__device__ __forceinline__ f32x4 mfma16(bf16x8 a, bf16x8 b, f32x4 c) { return __builtin_amdgcn_mfma_f32_16x16x32_bf16(a, b, c, 0, 0, 0); }

__device__ __forceinline__ int tidx() { int t = threadIdx.x; asm volatile("" : "+v"(t)); return t; }
template <class Epi>
__device__ __forceinline__ void gemm_tile(const bf16_t* __restrict__ A, int lda, const bf16_t* __restrict__ Bt, int ldb,
                                          int K, int m0, int n0, unsigned char* smem, Epi epi) {
  bf16_t* As = (bf16_t*)smem;
  bf16_t* Bs = As + 3 * 128 * 40;
  const int tid = tidx(), lane = tid & 63, wave = tid >> 6;
  const int wm = wave >> 1, wn = wave & 1;
  const int lr = tid >> 1, lh = tid & 1;
  const bf16_t* ag = A + (size_t)(m0 + lr) * lda + lh * 16;
  const bf16_t* bg = Bt + (size_t)(n0 + lr) * ldb + lh * 16;
  f32x4 acc[4][4];
#pragma unroll
  for (int i = 0; i < 4; ++i)
#pragma unroll
    for (int j = 0; j < 4; ++j) acc[i][j] = (f32x4){0.f, 0.f, 0.f, 0.f};
  const int nk = K >> 5;
  uint4 pa0 = *(const uint4*)ag, pa1 = *(const uint4*)(ag + 8), pb0 = *(const uint4*)bg, pb1 = *(const uint4*)(bg + 8);
  uint4 qa0 = *(const uint4*)(ag + 32), qa1 = *(const uint4*)(ag + 40), qb0 = *(const uint4*)(bg + 32), qb1 = *(const uint4*)(bg + 40);
  __syncthreads();
  {
    bf16_t* wa = As + lr * 40 + lh * 16; bf16_t* wb = Bs + lr * 40 + lh * 16;
    *(uint4*)wa = pa0; *(uint4*)(wa + 8) = pa1; *(uint4*)wb = pb0; *(uint4*)(wb + 8) = pb1;
  }
  __syncthreads();
  int st = 0;
  auto compute = [&](int stage) {
    const bf16_t* as = As + stage * 5120 + (wm * 64 + (lane & 15)) * 40 + (lane >> 4) * 8;
    const bf16_t* bs = Bs + stage * 5120 + (wn * 64 + (lane & 15)) * 40 + (lane >> 4) * 8;
    bf16x8 afr[4];
#pragma unroll
    for (int j = 0; j < 4; ++j) afr[j] = *(const bf16x8*)(bs + j * 16 * 40);
#pragma unroll
    for (int i = 0; i < 4; ++i) {
      const bf16x8 bfr = *(const bf16x8*)(as + i * 16 * 40);
#pragma unroll
      for (int j = 0; j < 4; ++j) acc[i][j] = mfma16(afr[j], bfr, acc[i][j]);
    }
  };
  for (int kt = 0; kt < nk; kt += 2) {
    if (kt + 2 < nk) { const bf16_t* a2 = ag + (kt + 2) * 32; const bf16_t* b2 = bg + (kt + 2) * 32; pa0 = *(const uint4*)a2; pa1 = *(const uint4*)(a2 + 8); pb0 = *(const uint4*)b2; pb1 = *(const uint4*)(b2 + 8); }
    compute(st);
    {
      const int s1 = (st == 2) ? 0 : st + 1;
      bf16_t* wa = As + s1 * 5120 + lr * 40 + lh * 16; bf16_t* wb = Bs + s1 * 5120 + lr * 40 + lh * 16;
      *(uint4*)wa = qa0; *(uint4*)(wa + 8) = qa1; *(uint4*)wb = qb0; *(uint4*)(wb + 8) = qb1;
      st = s1;
    }
    __syncthreads();
    if (kt + 3 < nk) { const bf16_t* a2 = ag + (kt + 3) * 32; const bf16_t* b2 = bg + (kt + 3) * 32; qa0 = *(const uint4*)a2; qa1 = *(const uint4*)(a2 + 8); qb0 = *(const uint4*)b2; qb1 = *(const uint4*)(b2 + 8); }
    compute(st);
    if (kt + 2 < nk) {
      const int s1 = (st == 2) ? 0 : st + 1;
      bf16_t* wa = As + s1 * 5120 + lr * 40 + lh * 16; bf16_t* wb = Bs + s1 * 5120 + lr * 40 + lh * 16;
      *(uint4*)wa = pa0; *(uint4*)(wa + 8) = pa1; *(uint4*)wb = pb0; *(uint4*)(wb + 8) = pb1;
      st = s1;
    }
    __syncthreads();
  }
#pragma unroll
  for (int i = 0; i < 4; ++i)
#pragma unroll
    for (int j = 0; j < 4; ++j) {
      int m = m0 + wm * 64 + i * 16 + (lane & 15);
      int n = n0 + wn * 64 + j * 16 + (lane >> 4) * 4;
      epi(m, n, acc[i][j]);
    }
}

template <class Epi>
__device__ __forceinline__ void gemm_tile32(const bf16_t* __restrict__ A, int lda, const bf16_t* __restrict__ Bt, int ldb,
                                          int K, int m0, int n0, unsigned char* smem, Epi epi) {
  bf16_t* As = (bf16_t*)smem;
  bf16_t* Bs = As + 2 * 128 * 40;
  const int tid = tidx(), lane = tid & 63, wave = tid >> 6;
  const int wm = wave >> 1, wn = wave & 1;
  const int lr = tid >> 1, lh = tid & 1;
  const bf16_t* ag = A + (size_t)(m0 + lr) * lda + lh * 16;
  const bf16_t* bg = Bt + (size_t)(n0 + lr) * ldb + lh * 16;
  f32x4 acc[4][4];
#pragma unroll
  for (int i = 0; i < 4; ++i)
#pragma unroll
    for (int j = 0; j < 4; ++j) acc[i][j] = (f32x4){0.f, 0.f, 0.f, 0.f};
  uint4 ra0 = *(const uint4*)ag, ra1 = *(const uint4*)(ag + 8);
  uint4 rb0 = *(const uint4*)bg, rb1 = *(const uint4*)(bg + 8);
  __syncthreads();
  {
    bf16_t* pa = As + lr * 40 + lh * 16; bf16_t* pb = Bs + lr * 40 + lh * 16;
    *(uint4*)pa = ra0; *(uint4*)(pa + 8) = ra1; *(uint4*)pb = rb0; *(uint4*)(pb + 8) = rb1;
  }
  __syncthreads();
  const int nk = K >> 5;
  for (int kt = 0; kt < nk; ++kt) {
    const int cur = kt & 1;
    if (kt + 1 < nk) {
      const bf16_t* a2 = ag + (kt + 1) * 32; const bf16_t* b2 = bg + (kt + 1) * 32;
      ra0 = *(const uint4*)a2; ra1 = *(const uint4*)(a2 + 8); rb0 = *(const uint4*)b2; rb1 = *(const uint4*)(b2 + 8);
    }
    const bf16_t* as = As + cur * 5120 + (wm * 64 + (lane & 15)) * 40 + (lane >> 4) * 8;
    const bf16_t* bs = Bs + cur * 5120 + (wn * 64 + (lane & 15)) * 40 + (lane >> 4) * 8;
    bf16x8 afr[4];
#pragma unroll
    for (int j = 0; j < 4; ++j) afr[j] = *(const bf16x8*)(bs + j * 16 * 40);
#pragma unroll
    for (int i = 0; i < 4; ++i) {
      const bf16x8 bfr = *(const bf16x8*)(as + i * 16 * 40);
#pragma unroll
      for (int j = 0; j < 4; ++j) acc[i][j] = mfma16(afr[j], bfr, acc[i][j]);
    }
    if (kt + 1 < nk) {
      bf16_t* pa = As + (cur ^ 1) * 5120 + lr * 40 + lh * 16; bf16_t* pb = Bs + (cur ^ 1) * 5120 + lr * 40 + lh * 16;
      *(uint4*)pa = ra0; *(uint4*)(pa + 8) = ra1; *(uint4*)pb = rb0; *(uint4*)(pb + 8) = rb1;
    }
    __syncthreads();
  }
#pragma unroll
  for (int i = 0; i < 4; ++i)
#pragma unroll
    for (int j = 0; j < 4; ++j) {
      int m = m0 + wm * 64 + i * 16 + (lane & 15);
      int n = n0 + wn * 64 + j * 16 + (lane >> 4) * 4;
      epi(m, n, acc[i][j]);
    }
}

__device__ __forceinline__ void transpose_task(const float* __restrict__ src, bf16_t* __restrict__ dst, int K, int N, int k0, int n0, unsigned char* smem) {
  float* tile = (float*)smem;
  const int tid = tidx();
  __syncthreads();
  {
    int r = tid >> 4, c4 = tid & 15;
#pragma unroll
    for (int rr = 0; rr < 4; ++rr) {
      int row = rr * 16 + r;
      float4 v = make_float4(0.f, 0.f, 0.f, 0.f);
      if (n0 + c4 * 4 < N) v = *(const float4*)(src + (size_t)(k0 + row) * N + n0 + c4 * 4);
      float* t = tile + row * 65 + c4 * 4;
      t[0] = v.x; t[1] = v.y; t[2] = v.z; t[3] = v.w;
    }
  }
  __syncthreads();
  {
    int n = tid >> 2, kq = tid & 3;
    float f[16];
#pragma unroll
    for (int i = 0; i < 16; ++i) f[i] = tile[(kq * 16 + i) * 65 + n];
    bf16_t* d = dst + (size_t)(n0 + n) * K + k0 + kq * 16;
    *(uint4*)d = pack8(f); *(uint4*)(d + 8) = pack8(f + 8);
  }
}

__device__ __forceinline__ void modpart_task(const Params& P, int l, int ks, int cb, unsigned char* smem) {
  float* s = (float*)smem;
  const int tid = tidx();
  __syncthreads();
  for (int i = tid; i < 17 * 64; i += NTHREADS) {
    int r = i >> 6, k = i & 63;
    float v = (r < 16) ? P.c[r * 1024 + ks * 64 + k] : P.c_ctx[ks * 64 + k];
    s[i] = siluf_(v);
  }
  __syncthreads();
  float acc[17];
#pragma unroll
  for (int r = 0; r < 17; ++r) acc[r] = 0.f;
  const int col = cb * 256 + tid;
  const float* w = P.w_ada + ((size_t)l * 1024 + ks * 64) * 6144 + col;
#pragma unroll 8
  for (int k = 0; k < 64; ++k) {
    float wv = w[(size_t)k * 6144];
#pragma unroll
    for (int r = 0; r < 17; ++r) acc[r] += s[r * 64 + k] * wv;
  }
#pragma unroll
  for (int r = 0; r < 17; ++r) P.modp[(((size_t)l * 16 + ks) * 17 + r) * 6144 + col] = acc[r];
}

__device__ __forceinline__ void hm2_task(const Params& P, int l, int lsel, int t4, unsigned char* smem) {
  float* z = (float*)smem;
  float* h1 = z + 4 * 36;
  const int tid = tidx(), tt = tid >> 6, j = tid & 63;
  const int L = lsel ? 256 : 2048;
  const int t = t4 * 4 + tt;
  const float tn = (float)t / (float)L;
  __syncthreads();
  if (j < 33) {
    float v;
    if (j == 0) v = tn;
    else if (j <= 16) v = sinf((6.2831855f * (float)j) * tn);
    else v = cosf((6.2831855f * (float)(j - 16)) * tn);
    z[tt * 36 + j] = v;
  }
  __syncthreads();
  float a = P.hy_b1[l * 64 + j];
  for (int i = 0; i < 33; ++i) a += z[tt * 36 + i] * P.hy_w1[(l * 33 + i) * 64 + j];
  h1[tt * 64 + j] = sinf(a);
  __syncthreads();
  float b = P.hy_b2[l * 64 + j];
  for (int i = 0; i < 64; ++i) b += h1[tt * 64 + i] * P.hy_w2[(l * 64 + i) * 64 + j];
  P.hm2[(((size_t)l * 2 + lsel) * 2048 + t) * 64 + j] = sinf(b);
}

__device__ __forceinline__ bf16_t* gtab_ptr(const Params& P, int l, int lsel, int c) {
  bf16_t* base = P.gtab + (size_t)l * (256 * 2 * 4096 + 256 * 2 * 512);
  return lsel ? base + 256 * 2 * 4096 + (size_t)c * 1024 : base + (size_t)c * 8192;
}

__device__ __forceinline__ void filt_task(const Params& P, int l, int lsel, int col, unsigned char* smem) {
  float* kv = (float*)smem;
  float* red = kv + 2048;
  float* w3s = red + 8;
  const int tid = tidx();
  const int L = lsel ? 256 : 2048;
  __syncthreads();
  if (tid < 64) w3s[tid] = P.hy_w3[(l * 64 + tid) * 512 + col];
  __syncthreads();
  const float dec = P.hy_decay[l * 512 + col];
  float asum = 0.f;
  for (int t = tid; t < L; t += NTHREADS) {
    const float* h = P.hm2 + (((size_t)l * 2 + lsel) * 2048 + t) * 64;
    float a = 0.f;
#pragma unroll 8
    for (int i = 0; i < 64; ++i) a += h[i] * w3s[i];
    float tn = (float)t / (float)L;
    a *= expf(-tn * dec);
    kv[t] = a; asum += fabsf(a);
  }
  asum = wave_sum(asum);
  if ((tid & 63) == 0) red[tid >> 6] = asum;
  __syncthreads();
  const float inv = 1.f / (red[0] + red[1] + red[2] + red[3] + 1e-6f);
  const int c = col & 255;
  const bool bwd = col >= 256;
  bf16_t* g0 = gtab_ptr(P, l, lsel, c);
  bf16_t* g1 = g0 + 2 * L;
  for (int d = tid; d < L; d += NTHREADS) {
    if (bwd && d == 0) continue;
    int i = bwd ? (L - 1 + d) : (L - 1 - d);
    bf16_t v = f2bf(kv[d] * inv);
    g0[i] = v;
    if (i >= 1) g1[i - 1] = v;
  }
}

__device__ __forceinline__ int mod_row(int T) { return T < NLAT ? (T >> 11) : 16; }

__device__ __forceinline__ void hmod0_token(const Params& P, int T, int lane) {
  const float* xr = (T < NLAT) ? P.x + (size_t)T * 1024 : P.ctx + (size_t)(T - NLAT) * 1024;
  const float* m = P.mod + (size_t)mod_row(T) * 6144;
#pragma unroll
  for (int i = 0; i < 2; ++i) {
    int d = i * 512 + lane * 8;
    float f[8];
#pragma unroll
    for (int j = 0; j < 8; ++j) f[j] = xr[d + j] * (1.f + m[1024 + d + j]) + m[d + j];
    *(uint4*)(P.Ybuf + (size_t)T * 1024 + d) = pack8(f);
  }
}

__device__ __forceinline__ void r1_token(const Params& P, int l, int T, int lane, const bool dry) {
  const float* xr;
  float* xw;
  if (T < NLAT) { xr = (l == 0) ? P.x + (size_t)T * 1024 : P.out + (size_t)T * 1024; xw = P.out + (size_t)T * 1024; }
  else { xr = (l == 0) ? P.ctx + (size_t)(T - NLAT) * 1024 : P.xc + (size_t)(T - NLAT) * 1024; xw = P.xc + (size_t)(T - NLAT) * 1024; }
  bf16_t* hw = P.Ybuf + (size_t)T * 1024;
  if (dry) { xw = (float*)P.uT + (size_t)(T & 2047) * 1024; hw = P.x0T + (size_t)(T & 2047) * 1024; }
  const float* m = P.mod + ((size_t)l * 17 + mod_row(T)) * 6144;
  const bf16_t* yo = P.Pbuf + (size_t)T * 1024;
  float v[16];
  float s = 0.f;
#pragma unroll
  for (int i = 0; i < 2; ++i) {
    int d = i * 512 + lane * 8;
    float y[8]; unpack8(*(const uint4*)(yo + d), y);
#pragma unroll
    for (int j = 0; j < 8; ++j) { v[i * 8 + j] = ALPHA * xr[d + j] + m[2048 + d + j] * y[j]; s += v[i * 8 + j]; }
  }
  float mean = wave_sum(s) * (1.f / 1024.f);
  float q = 0.f;
#pragma unroll
  for (int i = 0; i < 16; ++i) { v[i] -= mean; q += v[i] * v[i]; }
  float rstd = rsqrtf(wave_sum(q) * (1.f / 1024.f) + LN_EPS);
#pragma unroll
  for (int i = 0; i < 2; ++i) {
    int d = i * 512 + lane * 8;
    float h[8];
#pragma unroll
    for (int j = 0; j < 8; ++j) {
      float x1 = v[i * 8 + j] * rstd * P.ln1_g[l * 1024 + d + j] + P.ln1_b[l * 1024 + d + j];
      xw[d + j] = x1;
      h[j] = x1 * (1.f + m[4096 + d + j]) + m[3072 + d + j];
    }
    *(uint4*)(hw + d) = pack8(h);
  }
}

__device__ __forceinline__ float gelu_tanh(float x) {
  float u = 0.7978845608f * (x + 0.044715f * x * x * x);
  float t = 1.f - 2.f / (1.f + __expf(2.f * u));
  return 0.5f * x * (1.f + t);
}

typedef float f32x2 __attribute__((ext_vector_type(2)));
__device__ __forceinline__ unsigned pack4_fp8(float a, float b, float c, float d) {
  int v = 0;
  v = __builtin_amdgcn_cvt_pk_fp8_f32(a, b, v, false);
  v = __builtin_amdgcn_cvt_pk_fp8_f32(c, d, v, true);
  return (unsigned)v;
}
__device__ __forceinline__ float dot16_fp8(uint4 v, const float* h) {
  f32x2 acc = (f32x2){0.f, 0.f};
  unsigned w[4] = {v.x, v.y, v.z, v.w};
#pragma unroll
  for (int q = 0; q < 4; ++q) {
    acc += __builtin_amdgcn_cvt_pk_f32_fp8((int)w[q], false) * (f32x2){h[q * 4], h[q * 4 + 1]};
    acc += __builtin_amdgcn_cvt_pk_f32_fp8((int)w[q], true) * (f32x2){h[q * 4 + 2], h[q * 4 + 3]};
  }
  return acc[0] + acc[1];
}
typedef float f32x4_t __attribute__((ext_vector_type(4)));
__device__ __forceinline__ void peer_u_phase(const Params& P, int sl, int Tfirst, int Tstride, int ntok, int lane, int* li) {
  const int m = lane & 15, quad = lane >> 4;
  const unsigned char* tu = (const unsigned char*)P.tabu + (size_t)sl * 16384 * 128 + quad * 32;
  const int wpos = (lane & 15) * 8 + (lane >> 4);
  for (int T0 = Tfirst; T0 < ntok; T0 += 4 * Tstride) {
    int Tk[4];
    {
      int ir[4][2];
#pragma unroll
      for (int k = 0; k < 4; ++k) {
        Tk[k] = min(T0 + k * Tstride, ntok - 1);
        const int* er = P.eidx + (size_t)Tk[k] * 128;
        ir[k][0] = er[lane]; ir[k][1] = er[64 + lane];
      }
#pragma unroll
      for (int k = 0; k < 4; ++k) { li[k * 128 + wpos] = ir[k][0]; li[k * 128 + wpos + 4] = ir[k][1]; }
    }
#pragma unroll 1
    for (int k = 0; k < 4; ++k) {
      const int Tc = min(T0 + k * Tstride, ntok - 1);
      uint4 hr[4];
      const bf16_t* hp = P.Ybuf + (size_t)Tc * 1024 + sl * 128 + quad * 32;
#pragma unroll
      for (int q = 0; q < 4; ++q) hr[q] = *(const uint4*)(hp + q * 8);
      uint4 rv[16];
      {
        int idx[8];
#pragma unroll
        for (int q = 0; q < 2; ++q) { int4 v = *(const int4*)(li + k * 128 + m * 8 + q * 4); idx[q * 4] = v.x; idx[q * 4 + 1] = v.y; idx[q * 4 + 2] = v.z; idx[q * 4 + 3] = v.w; }
#pragma unroll
        for (int t = 0; t < 8; ++t) { const unsigned char* rp = tu + (size_t)idx[t] * 128; rv[2 * t] = *(const uint4*)rp; rv[2 * t + 1] = *(const uint4*)(rp + 16); }
      }
      long hb[4];
#pragma unroll
      for (int q = 0; q < 4; ++q) {
        float f[8]; unpack8(hr[q], f);
        unsigned lo = pack4_fp8(f[0], f[1], f[2], f[3]), hi = pack4_fp8(f[4], f[5], f[6], f[7]);
        hb[q] = (long)(((unsigned long long)hi << 32) | (unsigned long long)lo);
      }
      const bool live = (T0 + k * Tstride) < ntok;
      float* po = P.pact + ((size_t)sl * NTOK + Tc) * 128 + quad * 4;
#pragma unroll
      for (int t = 0; t < 8; ++t) {
        f32x4_t acc = (f32x4_t){0.f, 0.f, 0.f, 0.f};
        const uint4 r0 = rv[2 * t], r1 = rv[2 * t + 1];
        acc = __builtin_amdgcn_mfma_f32_16x16x32_fp8_fp8((long)(((unsigned long long)r0.y << 32) | r0.x), hb[0], acc, 0, 0, 0);
        acc = __builtin_amdgcn_mfma_f32_16x16x32_fp8_fp8((long)(((unsigned long long)r0.w << 32) | r0.z), hb[1], acc, 0, 0, 0);
        acc = __builtin_amdgcn_mfma_f32_16x16x32_fp8_fp8((long)(((unsigned long long)r1.y << 32) | r1.x), hb[2], acc, 0, 0, 0);
        acc = __builtin_amdgcn_mfma_f32_16x16x32_fp8_fp8((long)(((unsigned long long)r1.w << 32) | r1.z), hb[3], acc, 0, 0, 0);
        if (m == 0 && live) *(float4*)(po + t * 16) = make_float4(acc[0], acc[1], acc[2], acc[3]);
      }
    }
  }
}
__device__ __forceinline__ void peer_v_phase(const Params& P, int sl, int Tfirst, int Tstride, int ntok, int lane, int* li) {
  const int grp = lane >> 3, j8 = lane & 7;
  const unsigned char* tv = (const unsigned char*)P.tabv + (size_t)sl * 16384 * 128 + j8 * 16;
  float* lw = (float*)(li + 512);
  const int wpos = (lane & 7) * 16 + (lane >> 3);
  for (int T0 = Tfirst; T0 < ntok; T0 += 4 * Tstride) {
    int Tk[4];
    {
      int ir[4][2]; float wr[4][2];
#pragma unroll
      for (int k = 0; k < 4; ++k) {
        Tk[k] = min(T0 + k * Tstride, ntok - 1);
        const int* er = P.eidx + (size_t)Tk[k] * 128; const float* gr = P.egate + (size_t)Tk[k] * 128;
        ir[k][0] = er[lane]; ir[k][1] = er[64 + lane]; wr[k][0] = gr[lane]; wr[k][1] = gr[64 + lane];
      }
#pragma unroll
      for (int k = 0; k < 4; ++k) { li[k * 128 + wpos] = ir[k][0]; li[k * 128 + wpos + 8] = ir[k][1]; lw[k * 128 + wpos] = wr[k][0]; lw[k * 128 + wpos + 8] = wr[k][1]; }
    }
    uint4 rv[1][16];
#pragma unroll
    for (int k = 0; k < 4; ++k) {
      {
        int idx[16];
#pragma unroll
        for (int q = 0; q < 4; ++q) { int4 v = *(const int4*)(li + k * 128 + grp * 16 + q * 4); idx[q * 4] = v.x; idx[q * 4 + 1] = v.y; idx[q * 4 + 2] = v.z; idx[q * 4 + 3] = v.w; }
#pragma unroll
        for (int t = 0; t < 16; ++t) rv[0][t] = *(const uint4*)(tv + (size_t)idx[t] * 128);
      }
      {
        const int kk = k;
        float w[16];
#pragma unroll
        for (int q = 0; q < 4; ++q) { float4 f = *(const float4*)(lw + kk * 128 + grp * 16 + q * 4); w[q * 4] = f.x; w[q * 4 + 1] = f.y; w[q * 4 + 2] = f.z; w[q * 4 + 3] = f.w; }
        f32x2 o[8];
#pragma unroll
        for (int i = 0; i < 8; ++i) o[i] = (f32x2){0.f, 0.f};
#pragma unroll
        for (int t = 0; t < 16; ++t) {
          const f32x2 w2 = (f32x2){w[t], w[t]};
          const uint4 r = rv[0][t];
          unsigned ww[4] = {r.x, r.y, r.z, r.w};
#pragma unroll
          for (int q = 0; q < 4; ++q) {
            o[q * 2] += w2 * __builtin_amdgcn_cvt_pk_f32_fp8((int)ww[q], false);
            o[q * 2 + 1] += w2 * __builtin_amdgcn_cvt_pk_f32_fp8((int)ww[q], true);
          }
        }
        float of[16];
#pragma unroll
        for (int i = 0; i < 8; ++i) { of[2 * i] = o[i][0]; of[2 * i + 1] = o[i][1]; }
#pragma unroll
        for (int i = 0; i < 16; ++i) { of[i] += __shfl_xor(of[i], 8); of[i] += __shfl_xor(of[i], 16); of[i] += __shfl_xor(of[i], 32); }
        if (grp == 0 && (T0 + kk * Tstride) < ntok) {
#pragma unroll
          for (int i = 0; i < 16; ++i) of[i] *= (1.f / 256.f);
          bf16_t* d = P.pout + (size_t)Tk[kk] * 1024 + sl * 128 + j8 * 16;
          *(uint4*)d = pack8(of); *(uint4*)(d + 8) = pack8(of + 8);
        }
      }
    }
  }
}
__device__ __forceinline__ void ln2_token(const Params& P, int l, int T, int lane) {
  float* xw = (T < NLAT) ? P.out + (size_t)T * 1024 : P.xc + (size_t)(T - NLAT) * 1024;
  bf16_t* hw = P.Ybuf + (size_t)T * 1024;
  const float* m = P.mod + ((size_t)l * 17 + mod_row(T)) * 6144;
  const int d0 = lane * 16;
  float o[16];
  unpack8(*(const uint4*)(P.pout + (size_t)T * 1024 + d0), o); unpack8(*(const uint4*)(P.pout + (size_t)T * 1024 + d0 + 8), o + 8);
  float s = 0.f;
#pragma unroll
  for (int i = 0; i < 16; ++i) { o[i] = ALPHA * xw[d0 + i] + m[5120 + d0 + i] * o[i]; s += o[i]; }
  float mean = wave_sum(s) * (1.f / 1024.f);
  float q = 0.f;
#pragma unroll
  for (int i = 0; i < 16; ++i) { o[i] -= mean; q += o[i] * o[i]; }
  float rstd = rsqrtf(wave_sum(q) * (1.f / 1024.f) + LN_EPS);
  const float* mn = P.mod + ((size_t)(l + 1) * 17 + mod_row(T)) * 6144;
  float hh[16];
#pragma unroll
  for (int i = 0; i < 16; ++i) {
    float x2 = o[i] * rstd * P.ln2_g[l * 1024 + d0 + i] + P.ln2_b[l * 1024 + d0 + i];
    o[i] = x2;
    if (l == 0) hh[i] = x2 * (1.f + mn[1024 + d0 + i]) + mn[d0 + i];
  }
#pragma unroll
  for (int i = 0; i < 4; ++i) *(float4*)(xw + d0 + i * 4) = make_float4(o[i * 4], o[i * 4 + 1], o[i * 4 + 2], o[i * 4 + 3]);
  if (l == 0) { *(uint4*)(hw + d0) = pack8(hh); *(uint4*)(hw + d0 + 8) = pack8(hh + 8); }
}

__device__ __forceinline__ void peer_token(const Params& P, int l, int T, int lane, float* wl, const bool dry) {
  const int sub = lane >> 4, j16 = lane & 15;
  float h[64];
  {
    const bf16_t* hr = P.Ybuf + (size_t)T * 1024 + j16 * 16;
#pragma unroll
    for (int i = 0; i < 4; ++i) { unpack8(*(const uint4*)(hr + i * 256), h + i * 16); unpack8(*(const uint4*)(hr + i * 256 + 8), h + i * 16 + 8); }
  }
  const int* er = P.eidx + (size_t)T * 128;
  const float* gr = P.egate + (size_t)T * 128;
  const unsigned char* tu = (const unsigned char*)P.tabu;
  const unsigned char* tv = (const unsigned char*)P.tabv;
  for (int it = 0; it < 32; it += 2) {
    uint4 rv[2][4];
#pragma unroll
    for (int u2 = 0; u2 < 2; ++u2) {
      int e = er[(it + u2) * 4 + sub];
      const unsigned char* row = tu + (size_t)e * 1024 + j16 * 16;
#pragma unroll
      for (int i = 0; i < 4; ++i) rv[u2][i] = *(const uint4*)(row + i * 256);
    }
#pragma unroll
    for (int u2 = 0; u2 < 2; ++u2) {
      float acc = 0.f;
#pragma unroll
      for (int i = 0; i < 4; ++i) acc += dot16_fp8(rv[u2][i], h + i * 16);
      acc += __shfl_xor(acc, 1); acc += __shfl_xor(acc, 2); acc += __shfl_xor(acc, 4); acc += __shfl_xor(acc, 8);
      if (j16 == 0) wl[(it + u2) * 4 + sub] = gr[(it + u2) * 4 + sub] * gelu_tanh(acc * (1.f / 256.f));
    }
  }
  float o[16];
#pragma unroll
  for (int i = 0; i < 16; ++i) o[i] = 0.f;
  for (int e8 = 0; e8 < 128; e8 += 8) {
    uint4 rv[8];
    float w[8];
#pragma unroll
    for (int k = 0; k < 8; ++k) {
      int e = er[e8 + k];
      rv[k] = *(const uint4*)(tv + (size_t)e * 1024 + lane * 16);
      w[k] = wl[e8 + k];
    }
#pragma unroll
    for (int k = 0; k < 8; ++k) {
      unsigned ww[4] = {rv[k].x, rv[k].y, rv[k].z, rv[k].w};
#pragma unroll
      for (int q = 0; q < 4; ++q) {
        f32x2 lo = __builtin_amdgcn_cvt_pk_f32_fp8((int)ww[q], false);
        f32x2 hi = __builtin_amdgcn_cvt_pk_f32_fp8((int)ww[q], true);
        o[q * 4] += w[k] * lo[0]; o[q * 4 + 1] += w[k] * lo[1]; o[q * 4 + 2] += w[k] * hi[0]; o[q * 4 + 3] += w[k] * hi[1];
      }
    }
  }
  float* xw = (T < NLAT) ? P.out + (size_t)T * 1024 : P.xc + (size_t)(T - NLAT) * 1024;
  const float* xrd = xw;
  bf16_t* hw = P.Ybuf + (size_t)T * 1024;
  if (dry) { xw = (float*)P.uT + (size_t)(T & 2047) * 1024; hw = P.x0T + (size_t)(T & 2047) * 1024; }
  const float* m = P.mod + ((size_t)l * 17 + mod_row(T)) * 6144;
  const int d0 = lane * 16;
  float s = 0.f;
#pragma unroll
  for (int i = 0; i < 16; ++i) { o[i] = ALPHA * xrd[d0 + i] + m[5120 + d0 + i] * (o[i] * (1.f / 256.f)); s += o[i]; }
  float mean = wave_sum(s) * (1.f / 1024.f);
  float q = 0.f;
#pragma unroll
  for (int i = 0; i < 16; ++i) { o[i] -= mean; q += o[i] * o[i]; }
  float rstd = rsqrtf(wave_sum(q) * (1.f / 1024.f) + LN_EPS);
  const float* mn = P.mod + ((size_t)(l + 1) * 17 + mod_row(T)) * 6144;
  float hh[16];
#pragma unroll
  for (int i = 0; i < 16; ++i) {
    float x2 = o[i] * rstd * P.ln2_g[l * 1024 + d0 + i] + P.ln2_b[l * 1024 + d0 + i];
    o[i] = x2;
    if (l == 0) hh[i] = x2 * (1.f + mn[1024 + d0 + i]) + mn[d0 + i];
  }
#pragma unroll
  for (int i = 0; i < 4; ++i) *(float4*)(xw + d0 + i * 4) = make_float4(o[i * 4], o[i * 4 + 1], o[i * 4 + 2], o[i * 4 + 3]);
  if (l == 0) { *(uint4*)(hw + d0) = pack8(hh); *(uint4*)(hw + d0 + 8) = pack8(hh + 8); }
}

__device__ __forceinline__ void conf_task(const Params& P, int l, int tok_base, int len, int pos0, unsigned char* smem) {
  _Float16* u = (_Float16*)smem;
  const int c = tidx();
  __syncthreads();
  for (int i = 0; i < 94; ++i) {
    int pos = pos0 - 15 + i;
    float v = 0.f;
    if (pos >= 0 && pos < len) {
      const bf16_t* pr = P.Pbuf + (size_t)(tok_base + pos) * PST;
      v = bf2f(pr[c]) * sigmoidf_(bf2f(pr[256 + c]));
    }
    u[i * 256 + c] = (_Float16)v;
  }
  __syncthreads();
  float w[31];
#pragma unroll
  for (int j = 0; j < 31; ++j) w[j] = P.conf_dw_w[(l * 31 + j) * 256 + c];
  const float bias = P.conf_dw_b[l * 256 + c], ng = P.conf_norm_g[l * 256 + c], nb = P.conf_norm_b[l * 256 + c];
  for (int t = 0; t < 64; ++t) {
    float acc = bias;
#pragma unroll
    for (int j = 0; j < 31; ++j) acc += w[j] * (float)u[(t + j) * 256 + c];
    float mean = wave_sum(acc) * (1.f / 64.f);
    float d = acc - mean;
    float var = wave_sum(d * d) * (1.f / 64.f);
    float un = d * rsqrtf(var + LN_EPS) * ng + nb;
    P.Ybuf[(size_t)(tok_base + pos0 + t) * 1024 + c] = f2bf(siluf_(un));
  }
}

__device__ __forceinline__ void prep_task(const Params& P, int l, bool lat, int b, int pos0) {
  const int c = tidx();
  const int len = lat ? 2048 : 256;
  const int tok0 = lat ? b * 2048 + pos0 : NLAT + b * 256 + pos0;
  {
    bf16_t* dst = (lat ? P.vt_lat : P.vt_ctx) + ((size_t)b * 256 + c) * len + pos0;
    for (int t8 = 0; t8 < 8; ++t8) {
      unsigned wv[4];
#pragma unroll
      for (int k = 0; k < 4; ++k) {
        unsigned a = P.Pbuf[(size_t)(tok0 + t8 * 8 + k * 2) * PST + 1024 + c];
        unsigned bb = P.Pbuf[(size_t)(tok0 + t8 * 8 + k * 2 + 1) * PST + 1024 + c];
        wv[k] = a | (bb << 16);
      }
      *(uint4*)(dst + t8 * 8) = make_uint4(wv[0], wv[1], wv[2], wv[3]);
    }
  }
  if (lat) {
    const int hd = c & 63, i = hd & 31, hbase = c & ~63;
    const bool hi = hd >= 32;
    const int row = pos0 >> 6;
    const float* tc = P.ropetab; const float* ts = P.ropetab + 1024;
    for (int t = 0; t < 64; ++t) {
      const bf16_t* kr = P.Pbuf + (size_t)(tok0 + t) * PST + 768 + hbase;
      float x1 = bf2f(kr[i]), x2 = bf2f(kr[32 + i]);
      int pos = (i < 16) ? row : t;
      float cs = tc[pos * 16 + (i & 15)], sn = ts[pos * 16 + (i & 15)];
      float o = hi ? (x1 * sn + x2 * cs) : (x1 * cs - x2 * sn);
      P.krot[(size_t)(tok0 + t) * 256 + c] = f2bf(o);
    }
  }
  {
    float w[3][3], bsv[3];
#pragma unroll
    for (int q = 0; q < 3; ++q) {
      bsv[q] = P.hy_short_b[l * 768 + q * 256 + c];
#pragma unroll
      for (int k = 0; k < 3; ++k) w[q][k] = P.hy_short_w[(l * 3 + k) * 768 + q * 256 + c];
    }
    const size_t seqoff = lat ? ((size_t)b * 256 + c) * 2048 : (size_t)16 * 256 * 2048 + ((size_t)b * 256 + c) * 256;
    float pv[3], cu[3], nx[3];
#pragma unroll
    for (int q = 0; q < 3; ++q) {
      pv[q] = (pos0 > 0) ? bf2f(P.Pbuf[(size_t)(tok0 - 1) * PST + 1280 + q * 256 + c]) : 0.f;
      cu[q] = bf2f(P.Pbuf[(size_t)tok0 * PST + 1280 + q * 256 + c]);
    }
    for (int t8 = 0; t8 < 8; ++t8) {
      float uo[8], xo[8];
#pragma unroll
      for (int k = 0; k < 8; ++k) {
        int t = t8 * 8 + k;
        float r[3];
#pragma unroll
        for (int q = 0; q < 3; ++q) {
          nx[q] = (pos0 + t + 1 < len) ? bf2f(P.Pbuf[(size_t)(tok0 + t + 1) * PST + 1280 + q * 256 + c]) : 0.f;
          r[q] = w[q][0] * pv[q] + w[q][1] * cu[q] + w[q][2] * nx[q] + bsv[q];
          pv[q] = cu[q]; cu[q] = nx[q];
        }
        xo[k] = r[0]; uo[k] = r[2] * r[1];
      }
      *(uint4*)(P.uT + seqoff + pos0 + t8 * 8) = pack8(uo);
      *(uint4*)(P.x0T + seqoff + pos0 + t8 * 8) = pack8(xo);
    }
  }
}

__device__ __forceinline__ void hyfin_task(const Params& P, int l, bool lat, int b, int pos0) {
  const int c = tidx();
  const int tok0 = lat ? b * 2048 + pos0 : NLAT + b * 256 + pos0;
  const size_t seqoff = lat ? ((size_t)b * 256 + c) * 2048 : (size_t)16 * 256 * 2048 + ((size_t)b * 256 + c) * 256;
  const float skip = P.hy_bias[l * 256 + c];
  for (int t8 = 0; t8 < 8; ++t8) {
    float y[8], u[8], x0[8];
    unpack8(*(const uint4*)(P.yT + seqoff + pos0 + t8 * 8), y);
    unpack8(*(const uint4*)(P.uT + seqoff + pos0 + t8 * 8), u);
    unpack8(*(const uint4*)(P.x0T + seqoff + pos0 + t8 * 8), x0);
#pragma unroll
    for (int k = 0; k < 8; ++k)
      P.Ybuf[(size_t)(tok0 + t8 * 8 + k) * 1024 + 512 + c] = f2bf((y[k] + u[k] * skip) * x0[k]);
  }
}

__device__ __forceinline__ void hyconv_task(const Params& P, int l, bool lat, int c, int tb, unsigned char* smem) {
  const int L = lat ? 2048 : 256;
  unsigned* g = (unsigned*)smem;
  const int tid = tidx(), lane = tid & 63, wave = tid >> 6;
  __syncthreads();
  {
    const uint4* src = (const uint4*)gtab_ptr(P, l, lat ? 0 : 1, c);
    const int n16 = (4 * L * 2) / 16;
    for (int i = tid; i < n16; i += NTHREADS) ((uint4*)g)[i] = src[i];
  }
  __syncthreads();
  const int m = lane & 15, quad = lane >> 4;
  const size_t seqbase = lat ? 0 : (size_t)16 * 256 * 2048;
  const bf16_t* ub = P.uT + seqbase + ((size_t)m * 256 + c) * L + quad * 8;
  const int t0 = tb + wave * 64;
  f32x4 acc[4];
#pragma unroll
  for (int i = 0; i < 4; ++i) acc[i] = (f32x4){0.f, 0.f, 0.f, 0.f};
  for (int s0 = 0; s0 < L; s0 += 256) {
    bf16x8 ufr[8];
#pragma unroll
    for (int q = 0; q < 8; ++q) ufr[q] = *(const bf16x8*)(ub + s0 + q * 32);
#pragma unroll
    for (int q = 0; q < 8; ++q) {
#pragma unroll
      for (int i = 0; i < 4; ++i) {
        int o = (L - 1) + s0 + q * 32 - (t0 + i * 16) + quad * 8 - m;
        const unsigned* gp = g + (o & 1) * L + (o >> 1);
        uint4 tv = make_uint4(gp[0], gp[1], gp[2], gp[3]);
        acc[i] = mfma16(as_bf8(tv), ufr[q], acc[i]);
      }
    }
  }
  bf16_t* yb = P.yT + seqbase + ((size_t)m * 256 + c) * L;
#pragma unroll
  for (int i = 0; i < 4; ++i) {
    uint2 v; v.x = pack2(acc[i][0], acc[i][1]); v.y = pack2(acc[i][2], acc[i][3]);
    *(uint2*)(yb + t0 + i * 16 + quad * 4) = v;
  }
}

template <bool LOCAL>
__device__ __forceinline__ void attn_task(const Params& P, int l, int b, int r, int c0, int h, int lane) {
  const int n = lane & 15, quad = lane >> 4;
  const int qtok = LOCAL ? (b * 2048 + r * 64 + c0 + n) : (NLAT + b * 256 + c0 + n);
  const bf16_t* pq = P.Pbuf + (size_t)qtok * PST + 512 + h * 64 + quad * 8;
  const uint4 q0 = *(const uint4*)pq, q1 = *(const uint4*)(pq + 32);
  const bf16x8 qp0 = as_bf8(q0), qp1 = as_bf8(q1);
  bf16x8 qr0 = qp0, qr1 = qp1;
  const int rs = min(max(r - 4, 0), 24), kc0 = min(max(c0 - 8, 0), 32);
  const int cq = c0 + n, cs_ = min(max(cq - 8, 0), 48);
  const float* rpb = P.na_rpb + ((size_t)l * 4 + h) * 15 * 31;
  if (LOCAL) {
    float x1[8], x2[8], a[8], bq[8];
    unpack8(q0, x1); unpack8(q1, x2);
    const int pos = (quad < 2) ? r : (c0 + n);
    const float* tc = P.ropetab + pos * 16 + (quad & 1) * 8;
    const float* ts = tc + 1024;
#pragma unroll
    for (int j = 0; j < 8; ++j) { float cs = tc[j], sn = ts[j]; a[j] = x1[j] * cs - x2[j] * sn; bq[j] = x1[j] * sn + x2[j] * cs; }
    qr0 = as_bf8(pack8(a)); qr1 = as_bf8(pack8(bq));
  }
  auto local_scores = [&](int g) -> f32x4 {
    const int i = g >> 1, half = g & 1;
    const int ktok = b * 2048 + (rs + i) * 64 + kc0 + half * 16 + n;
    const bf16_t* kp = P.krot + (size_t)ktok * 256 + h * 64 + quad * 8;
    f32x4 acc = (f32x4){0.f, 0.f, 0.f, 0.f};
    acc = mfma16(*(const bf16x8*)kp, qr0, acc);
    acc = mfma16(*(const bf16x8*)(kp + 32), qr1, acc);
    const float* rb = rpb + (rs + i - r + 7) * 31;
    f32x4 o;
#pragma unroll
    for (int rr = 0; rr < 4; ++rr) {
      int kcol = kc0 + half * 16 + quad * 4 + rr;
      bool valid = (kcol >= cs_) && (kcol < cs_ + 16);
      int bi = min(max(kcol - cq + 15, 0), 30);
      o[rr] = valid ? (acc[rr] * 0.125f + rb[bi]) : -1e30f;
    }
    return o;
  };
  auto ctx_scores = [&](int g) -> f32x4 {
    const int ktok = NLAT + b * 256 + g * 16 + n;
    const bf16_t* kp = P.Pbuf + (size_t)ktok * PST + 768 + h * 64 + quad * 8;
    f32x4 acc = (f32x4){0.f, 0.f, 0.f, 0.f};
    acc = mfma16(*(const bf16x8*)kp, qp0, acc);
    acc = mfma16(*(const bf16x8*)(kp + 32), qp1, acc);
    return acc * 0.125f;
  };
  float mx = -1e30f, sum = 0.f;
  f32x4 O[4];
#pragma unroll
  for (int i = 0; i < 4; ++i) O[i] = (f32x4){0.f, 0.f, 0.f, 0.f};
  auto block = [&](const bool loc, const int sb) {
    f32x4 sc[8];
#pragma unroll
    for (int q = 0; q < 8; ++q) sc[q] = loc ? local_scores(sb * 8 + q) : ctx_scores(sb * 8 + q);
    float bm = -1e30f;
#pragma unroll
    for (int q = 0; q < 8; ++q) bm = fmaxf(bm, fmaxf(fmaxf(sc[q][0], sc[q][1]), fmaxf(sc[q][2], sc[q][3])));
    bm = fmaxf(bm, __shfl_xor(bm, 16)); bm = fmaxf(bm, __shfl_xor(bm, 32));
    const float mnew = fmaxf(mx, bm);
    const float scale = __expf(mx - mnew);
    mx = mnew; sum *= scale;
#pragma unroll
    for (int dt = 0; dt < 4; ++dt) O[dt] *= scale;
#pragma unroll
    for (int pr = 0; pr < 4; ++pr) {
      const int ip = sb * 4 + pr;
      float pa[4], pbv[4];
#pragma unroll
      for (int rr = 0; rr < 4; ++rr) { pa[rr] = __expf(sc[2 * pr][rr] - mx); pbv[rr] = __expf(sc[2 * pr + 1][rr] - mx); sum += pa[rr] + pbv[rr]; }
      uint4 pb; pb.x = pack2(pa[0], pa[1]); pb.y = pack2(pa[2], pa[3]); pb.z = pack2(pbv[0], pbv[1]); pb.w = pack2(pbv[2], pbv[3]);
#pragma unroll
      for (int dt = 0; dt < 4; ++dt) {
        const bf16_t* vp = loc ? P.vt_lat + ((size_t)(b * 4 + h) * 64 + dt * 16 + n) * 2048 + (rs + ip) * 64 + kc0 + quad * 4
                               : P.vt_ctx + ((size_t)(b * 4 + h) * 64 + dt * 16 + n) * 256 + ip * 32 + quad * 4;
        uint2 lo = *(const uint2*)vp, hi = *(const uint2*)(vp + 16);
        O[dt] = mfma16(as_bf8(make_uint4(lo.x, lo.y, hi.x, hi.y)), as_bf8(pb), O[dt]);
      }
    }
  };
  if (LOCAL) { block(true, 0); block(true, 1); }
  block(false, 0); block(false, 1);
  sum += __shfl_xor(sum, 16); sum += __shfl_xor(sum, 32);
  const float inv = 1.f / sum;
  bf16_t* yo = P.Ybuf + (size_t)qtok * 1024 + 256 + h * 64 + quad * 4;
#pragma unroll
  for (int dt = 0; dt < 4; ++dt) {
    uint2 v; v.x = pack2(O[dt][0] * inv, O[dt][1] * inv); v.y = pack2(O[dt][2] * inv, O[dt][3] * inv);
    *(uint2*)(yo + dt * 16) = v;
  }
}

template <bool PASS3>
__device__ __forceinline__ void ssd_task(const Params& P, int l, int b, int g, int ch, unsigned char* smem) {
  _Float16* xs = (_Float16*)smem;
  _Float16* Bs = xs + 64 * 128;
  _Float16* Cs = Bs + 64 * 64;
  float* dts = (float*)(Cs + 64 * 64);
  float* decs = dts + 256;
  float* as_ = decs + 256;
  _Float16* yt = (_Float16*)(as_ + 256);
  const int tid = tidx();
  const bool lat = ch >= 4;
  const int len = lat ? 2048 : 256;
  const int pos0 = lat ? (ch - 4) * 64 : ch * 64;
  const int tok0 = lat ? b * 2048 + pos0 : NLAT + b * 256 + pos0;
  __syncthreads();
  {
    const int col = (tid < 128) ? g * 128 + tid : (tid < 192 ? 256 + g * 64 + (tid - 128) : 384 + g * 64 + (tid - 192));
    const float w0 = P.ssd_conv_w[(l * 3 + 0) * 512 + col], w1 = P.ssd_conv_w[(l * 3 + 1) * 512 + col], w2 = P.ssd_conv_w[(l * 3 + 2) * 512 + col];
    const float bs = P.ssd_conv_b[l * 512 + col];
    const bf16_t* pp = P.Pbuf + (size_t)tok0 * PST + 2304 + col;
    float pv = (pos0 > 0) ? bf2f(pp[-(ptrdiff_t)PST]) : 0.f;
    float cu = bf2f(pp[0]);
    _Float16* dst = (tid < 128) ? xs + tid : (tid < 192 ? Bs + (tid - 128) : Cs + (tid - 192));
    const int dstride = (tid < 128) ? 128 : 64;
    for (int t = 0; t < 64; ++t) {
      float nx = (pos0 + t + 1 < len) ? bf2f(pp[(size_t)(t + 1) * PST]) : 0.f;
      float v = siluf_(w0 * pv + w1 * cu + w2 * nx + bs);
      dst[t * dstride] = (_Float16)v;
      pv = cu; cu = nx;
    }
    {
      const int t = tid >> 2, k = tid & 3, dir = k >> 1, hh = k & 1, head = g * 2 + hh;
      float raw = P.dtbuf[(size_t)(tok0 + t) * 8 + dir * 4 + head] + P.ssd_dt_bias[(l * 2 + dir) * 4 + head];
      float dtv = (raw > 20.f) ? raw : log1pf(expf(raw));
      float a = -dtv * expf(P.ssd_a_log[(l * 2 + dir) * 4 + head]);
      dts[tid] = dtv; as_[tid] = a; decs[tid] = expf(a);
    }
    if (PASS3) for (int i = tid; i < 64 * 128; i += NTHREADS) yt[i] = (_Float16)0.f;
  }
  __syncthreads();
  const int hh = tid >> 7, p = (tid >> 1) & 63, nh = tid & 1;
  const int head = g * 2 + hh;
  float stf[32], stb[32];
  float* sf = P.sst + ((((size_t)b * 2 + 0) * 4 + head) * NCH + ch) * 4096 + p * 64 + nh * 32;
  float* sb = P.sst + ((((size_t)b * 2 + 1) * 4 + head) * NCH + ch) * 4096 + p * 64 + nh * 32;
  if (PASS3) {
#pragma unroll
    for (int i = 0; i < 8; ++i) {
      float4 a = *(const float4*)(sf + i * 4); stf[i * 4] = a.x; stf[i * 4 + 1] = a.y; stf[i * 4 + 2] = a.z; stf[i * 4 + 3] = a.w;
      float4 c = *(const float4*)(sb + i * 4); stb[i * 4] = c.x; stb[i * 4 + 1] = c.y; stb[i * 4 + 2] = c.z; stb[i * 4 + 3] = c.w;
    }
  } else {
#pragma unroll
    for (int i = 0; i < 32; ++i) { stf[i] = 0.f; stb[i] = 0.f; }
  }
  for (int k = 0; k < 64; ++k) {
    {
      const float dtv = dts[k * 4 + hh], dec = decs[k * 4 + hh];
      const float xd = (float)xs[k * 128 + hh * 64 + p] * dtv;
      const _Float16* br = Bs + k * 64 + nh * 32;
#pragma unroll
      for (int i = 0; i < 32; ++i) stf[i] = stf[i] * dec + xd * (float)br[i];
      if (PASS3) {
        const _Float16* cr = Cs + k * 64 + nh * 32;
        float y0 = 0.f, y1 = 0.f, y2 = 0.f, y3 = 0.f;
#pragma unroll
        for (int i = 0; i < 32; i += 4) { y0 += stf[i] * (float)cr[i]; y1 += stf[i + 1] * (float)cr[i + 1]; y2 += stf[i + 2] * (float)cr[i + 2]; y3 += stf[i + 3] * (float)cr[i + 3]; }
        float y = (y0 + y1) + (y2 + y3);
        y += __shfl_xor(y, 1);
        if (nh == 0) { _Float16* yp = yt + k * 128 + hh * 64 + p; *yp = (_Float16)((float)*yp + y); }
      }
    }
    {
      const int kk = 63 - k;
      const float dtv = dts[kk * 4 + 2 + hh], dec = decs[kk * 4 + 2 + hh];
      const float xd = (float)xs[kk * 128 + hh * 64 + p] * dtv;
      const _Float16* br = Bs + kk * 64 + nh * 32;
#pragma unroll
      for (int i = 0; i < 32; ++i) stb[i] = stb[i] * dec + xd * (float)br[i];
      if (PASS3) {
        const _Float16* cr = Cs + kk * 64 + nh * 32;
        float y0 = 0.f, y1 = 0.f, y2 = 0.f, y3 = 0.f;
#pragma unroll
        for (int i = 0; i < 32; i += 4) { y0 += stb[i] * (float)cr[i]; y1 += stb[i + 1] * (float)cr[i + 1]; y2 += stb[i + 2] * (float)cr[i + 2]; y3 += stb[i + 3] * (float)cr[i + 3]; }
        float y = (y0 + y1) + (y2 + y3);
        y += __shfl_xor(y, 1);
        if (nh == 0) { _Float16* yp = yt + kk * 128 + hh * 64 + p; *yp = (_Float16)((float)*yp + y); }
      }
    }
  }
  if (!PASS3) {
#pragma unroll
    for (int i = 0; i < 8; ++i) {
      *(float4*)(sf + i * 4) = make_float4(stf[i * 4], stf[i * 4 + 1], stf[i * 4 + 2], stf[i * 4 + 3]);
      *(float4*)(sb + i * 4) = make_float4(stb[i * 4], stb[i * 4 + 1], stb[i * 4 + 2], stb[i * 4 + 3]);
    }
    if (tid < 4) {
      const int dir = tid >> 1, h2 = tid & 1;
      float a = 0.f;
      for (int t = 0; t < 64; ++t) a += as_[t * 4 + tid];
      P.ssumA[(((size_t)b * 2 + dir) * 4 + g * 2 + h2) * NCH + ch] = a;
    }
  } else {
    __syncthreads();
    const int t = tid >> 2, part = tid & 3;
    const int hd = g * 2 + (part >> 1);
    const float dsk = P.ssd_d[l * 4 + hd];
    float val[32];
    float sq = 0.f;
    const bf16_t* zr = P.Pbuf + (size_t)(tok0 + t) * PST + 2048 + g * 128 + part * 32;
#pragma unroll
    for (int i = 0; i < 32; ++i) {
      int cc = part * 32 + i;
      float y = (float)yt[t * 128 + cc] + (float)xs[t * 128 + cc] * dsk;
      float z = bf2f(zr[i]);
      y *= siluf_(z);
      val[i] = y; sq += y * y;
    }
    sq += __shfl_xor(sq, 1); sq += __shfl_xor(sq, 2);
    const float rinv = rsqrtf(sq * (1.f / 128.f) + LN_EPS);
    bf16_t* yo = P.Ybuf + (size_t)(tok0 + t) * 1024 + 768 + g * 128 + part * 32;
    const float* ngp = P.ssd_norm_g + l * 256 + g * 128 + part * 32;
#pragma unroll
    for (int i8 = 0; i8 < 4; ++i8) {
      float f[8];
#pragma unroll
      for (int j = 0; j < 8; ++j) f[j] = val[i8 * 8 + j] * rinv * ngp[i8 * 8 + j];
      *(uint4*)(yo + i8 * 8) = pack8(f);
    }
  }
}

__device__ __forceinline__ void ssd_prefix_task(const Params& P, int bdh, int part) {
  const int dir = (bdh >> 2) & 1;
  float* base = P.sst + (size_t)bdh * NCH * 4096 + part * 256 + tidx();
  const float* sa = P.ssumA + (size_t)bdh * NCH;
  float carry = 0.f;
  for (int i = 0; i < NCH; ++i) {
    int ch = dir ? (i < 4 ? 3 - i : 39 - i) : i;
    float loc = base[(size_t)ch * 4096];
    base[(size_t)ch * 4096] = carry;
    carry = expf(sa[ch]) * carry + loc;
  }
}

__device__ __forceinline__ int f2key(float f) { int b = __float_as_int(f); return b ^ ((b >> 31) & 0x7FFFFFFF); }
__device__ __forceinline__ float key2f(int k) { return __int_as_float(k ^ ((k >> 31) & 0x7FFFFFFF)); }
#define CE_DESC(a, b) { int _x = max(a, b); int _y = min(a, b); a = _x; b = _y; }
#define CE_ASC(a, b) { int _x = min(a, b); int _y = max(a, b); a = _x; b = _y; }
__device__ __forceinline__ void sort16_desc(int* a) {
#pragma unroll
  for (int k = 2; k <= 16; k <<= 1)
#pragma unroll
    for (int j = k >> 1; j > 0; j >>= 1)
#pragma unroll
      for (int i = 0; i < 16; ++i) {
        int lq = i ^ j;
        if (lq > i) { if ((i & k) == 0) CE_DESC(a[i], a[lq]) else CE_ASC(a[i], a[lq]) }
      }
}
__device__ __forceinline__ void merge16_desc(int* a, const int* b) {
#pragma unroll
  for (int i = 0; i < 16; ++i) a[i] = max(a[i], b[15 - i]);
#pragma unroll
  for (int j = 8; j > 0; j >>= 1)
#pragma unroll
    for (int i = 0; i < 16; ++i) {
      int lq = i ^ j;
      if (lq > i) CE_DESC(a[i], a[lq])
    }
}

__device__ __forceinline__ void gemm_acc32(const bf16_t* __restrict__ A, int lda, const bf16_t* __restrict__ Bt, int ldb,
                                           int K, int m0, int n0, unsigned char* smem, f32x4 (&acc)[4][4]) {
  bf16_t* As = (bf16_t*)smem;
  bf16_t* Bs = As + 2 * 128 * 40;
  const int tid = tidx(), lane = tid & 63, wave = tid >> 6;
  const int wm = wave >> 1, wn = wave & 1;
  const int lr = tid >> 1, lh = tid & 1;
  const bf16_t* ag = A + (size_t)(m0 + lr) * lda + lh * 16;
  const bf16_t* bg = Bt + (size_t)(n0 + lr) * ldb + lh * 16;
#pragma unroll
  for (int i = 0; i < 4; ++i)
#pragma unroll
    for (int j = 0; j < 4; ++j) acc[i][j] = (f32x4){0.f, 0.f, 0.f, 0.f};
  uint4 ra0 = *(const uint4*)ag, ra1 = *(const uint4*)(ag + 8);
  uint4 rb0 = *(const uint4*)bg, rb1 = *(const uint4*)(bg + 8);
  __syncthreads();
  {
    bf16_t* pa = As + lr * 40 + lh * 16; bf16_t* pb = Bs + lr * 40 + lh * 16;
    *(uint4*)pa = ra0; *(uint4*)(pa + 8) = ra1; *(uint4*)pb = rb0; *(uint4*)(pb + 8) = rb1;
  }
  __syncthreads();
  const int nk = K >> 5;
  for (int kt = 0; kt < nk; ++kt) {
    const int cur = kt & 1;
    if (kt + 1 < nk) {
      const bf16_t* a2 = ag + (kt + 1) * 32; const bf16_t* b2 = bg + (kt + 1) * 32;
      ra0 = *(const uint4*)a2; ra1 = *(const uint4*)(a2 + 8); rb0 = *(const uint4*)b2; rb1 = *(const uint4*)(b2 + 8);
    }
    const bf16_t* as = As + cur * 5120 + (wm * 64 + (lane & 15)) * 40 + (lane >> 4) * 8;
    const bf16_t* bs = Bs + cur * 5120 + (wn * 64 + (lane & 15)) * 40 + (lane >> 4) * 8;
    bf16x8 afr[4];
#pragma unroll
    for (int j = 0; j < 4; ++j) afr[j] = *(const bf16x8*)(bs + j * 16 * 40);
#pragma unroll
    for (int i = 0; i < 4; ++i) {
      const bf16x8 bfr = *(const bf16x8*)(as + i * 16 * 40);
#pragma unroll
      for (int j = 0; j < 4; ++j) acc[i][j] = mfma16(afr[j], bfr, acc[i][j]);
    }
    if (kt + 1 < nk) {
      bf16_t* pa = As + (cur ^ 1) * 5120 + lr * 40 + lh * 16; bf16_t* pb = Bs + (cur ^ 1) * 5120 + lr * 40 + lh * 16;
      *(uint4*)pa = ra0; *(uint4*)(pa + 8) = ra1; *(uint4*)pb = rb0; *(uint4*)(pb + 8) = rb1;
    }
    __syncthreads();
  }
}

__device__ __forceinline__ void peer_topk_task(const Params& P, int l, int tm, int h, unsigned char* smem) {
  float* sc = (float*)smem;
  int* fin = (int*)(smem + 33280);
  const int tid = tidx(), lane = tid & 63, wave = tid >> 6;
  const int wm = wave >> 1, wn = wave & 1;
  const int row64 = tid & 63, quarter = tid >> 6;
  int* K1 = (int*)(smem + 40960);
  int* K2a = (int*)(smem + 49152);
#pragma unroll
  for (int pp = 0; pp < 2; ++pp) {
    const bf16_t* A = P.qbuf + (h * 2 + pp) * 128;
    const bf16_t* Bt = P.keysb + ((size_t)(l * 8 + h) * 2 + pp) * 128 * 128;
#pragma unroll 1
    for (int half = 0; half < 2; ++half) {
      {
        f32x4 acc[4][4];
        gemm_acc32(A, 2048, Bt, 128, 128, tm * 128, 0, smem, acc);
        if (wm == half) {
#pragma unroll
          for (int i = 0; i < 4; ++i)
#pragma unroll
            for (int j = 0; j < 4; ++j) {
              float* d = sc + (i * 16 + (lane & 15)) * 129 + wn * 64 + j * 16 + (lane >> 4) * 4;
              d[0] = acc[i][j][0]; d[1] = acc[i][j][1]; d[2] = acc[i][j][2]; d[3] = acc[i][j][3];
            }
        }
      }
      __syncthreads();
      int run[16];
#pragma unroll
      for (int i = 0; i < 16; ++i) run[i] = (int)0x80000000;
#pragma unroll 1
      for (int grp = 0; grp < 2; ++grp) {
        int cur[16];
#pragma unroll
        for (int i = 0; i < 16; ++i) {
          int col = quarter * 32 + grp * 16 + i;
          cur[i] = (f2key(sc[row64 * 129 + col]) & ~127) | col;
        }
        sort16_desc(cur);
        merge16_desc(run, cur);
      }
      if (quarter != 0) {
#pragma unroll
        for (int i = 0; i < 16; ++i) sc[row64 * 129 + quarter * 32 + i] = __int_as_float(run[i]);
      }
      __syncthreads();
      if (quarter == 0) {
#pragma unroll 1
        for (int q = 1; q < 4; ++q) {
          int oth[16];
#pragma unroll
          for (int i = 0; i < 16; ++i) oth[i] = __float_as_int(sc[row64 * 129 + q * 32 + i]);
          merge16_desc(run, oth);
        }
        if (half == 0) {
#pragma unroll
          for (int i = 0; i < 16; ++i) { if (pp == 0) K1[row64 * 16 + i] = run[i]; else K2a[row64 * 16 + i] = run[i]; }
        } else {
#pragma unroll
          for (int i = 0; i < 16; ++i) fin[row64 * 16 + i] = run[i];
        }
      }
      __syncthreads();
    }
    if (pp == 0 && tid >= 64 && tid < 128) {
#pragma unroll
      for (int i = 0; i < 16; ++i) K1[tid * 16 + i] = fin[(tid - 64) * 16 + i];
    }
    __syncthreads();
  }
  const int row = tid & 127, half = tid >> 7;
  int* lists = (int*)smem;
  if (half == 0) {
#pragma unroll
    for (int i = 0; i < 16; ++i) { lists[row * 33 + i] = K1[row * 16 + i]; lists[row * 33 + 16 + i] = (row < 64) ? K2a[row * 16 + i] : fin[(row - 64) * 16 + i]; }
  }
  if (half == 0) {
    float v2[16];
#pragma unroll
    for (int i = 0; i < 16; ++i) v2[i] = key2f(lists[row * 33 + 16 + i] & ~127);
    int run[16];
    {
      const float v0 = key2f(lists[row * 33] & ~127);
#pragma unroll
      for (int j = 0; j < 16; ++j) run[j] = (f2key(v0 + v2[j]) & ~255) | (15 - j);
    }
#pragma unroll 1
    for (int i = 1; i < 16; ++i) {
      int cur[16];
      const float vi = key2f(lists[row * 33 + i] & ~127);
#pragma unroll
      for (int j = 0; j < 16; ++j) cur[j] = (f2key(vi + v2[j]) & ~255) | (i * 16 + 15 - j);
      merge16_desc(run, cur);
    }
    const float c0 = key2f(run[0] & ~255);
    float sum = 0.f;
#pragma unroll
    for (int k = 0; k < 16; ++k) sum += __expf(key2f(run[k] & ~255) - c0);
    const float inv = 1.f / sum;
    const int T = tm * 128 + row;
    int* eo = P.eidx + (size_t)T * 128 + h * 16;
    float* go = P.egate + (size_t)T * 128 + h * 16;
#pragma unroll
    for (int k = 0; k < 16; ++k) {
      int ci = run[k] & 255;
      int i = ci >> 4, j = 15 - (ci & 15);
      int i1 = lists[row * 33 + i] & 127, i2 = lists[row * 33 + 16 + j] & 127;
      eo[k] = i1 * 128 + i2;
      go[k] = __expf(key2f(run[k] & ~255) - c0) * inv;
    }
  }
}

#define XB_TMO      128
#define XB_XCNT(j)  (256  + 64 * (j))
#define XB_XSUB(j)  (1280 + 64 * (j))
#define XB_XGEN(j)  (2304 + 64 * (j))
#define XB_TOP      3328
#define XB_TOPGEN   3392
#define XCD_BAR_WORDS 3456
#define XB_SPIN_CAP (1u << 18)
#define LAS __attribute__((address_space(3)))

__device__ __forceinline__ unsigned xb_ld(unsigned* p)              { return __hip_atomic_load(p, __ATOMIC_RELAXED, __HIP_MEMORY_SCOPE_AGENT); }
__device__ __forceinline__ unsigned xb_add(unsigned* p, unsigned v) { return __hip_atomic_fetch_add(p, v, __ATOMIC_RELAXED, __HIP_MEMORY_SCOPE_AGENT); }
__device__ __forceinline__ unsigned xb_xcc_id() { return (unsigned)__builtin_amdgcn_s_getreg((3 << 11) | 20) & 0xFu; }
#define XB_SPIN(cond, bar) do { unsigned _sp = 0; while (cond) { __builtin_amdgcn_s_sleep(1); \
    if ((++_sp & 255u) == 0u) { if (xb_ld(&(bar)[XB_TMO])) break; if (_sp > XB_SPIN_CAP) { atomicAdd(&(bar)[XB_TMO], 1u); break; } } } } while (0)

struct XcdBarrier {
    unsigned* bar; unsigned x;
    volatile LAS unsigned* st;
};

__device__ __forceinline__ XcdBarrier xcd_barrier_post(unsigned* bar, volatile LAS unsigned* st) {
    XcdBarrier b; b.bar = bar; b.x = xb_xcc_id(); b.st = st;
    if (threadIdx.x == 0) (void)xb_add(&bar[XB_XCNT(b.x)], 1u);
    return b;
}
__device__ __forceinline__ void xcd_barrier_complete(unsigned* bar, unsigned x, unsigned& nloc, unsigned& nx) {
    const unsigned G = gridDim.x * gridDim.y * gridDim.z;
    unsigned sum, cnt, mine, sp = 0u;
    for (;;) {
        sum = 0u; cnt = 0u; mine = 0u;
#pragma unroll
        for (unsigned j = 0; j < 16; ++j) { const unsigned c = xb_ld(&bar[XB_XCNT(j)]); sum += c; cnt += (c > 0u) ? 1u : 0u; mine = (j == x) ? c : mine; }
        if (sum == G) break;
        __builtin_amdgcn_s_sleep(1);
        if ((++sp & 255u) == 0u) { if (xb_ld(&bar[XB_TMO])) break; if (sp > XB_SPIN_CAP) { atomicAdd(&bar[XB_TMO], 1u); break; } }
    }
    nloc = mine > 0u ? mine : 1u; nx = cnt > 0u ? cnt : 1u;
}

__device__ __forceinline__ void xcd_barrier(const XcdBarrier& b) {
    asm volatile("s_waitcnt vmcnt(0)" ::: "memory");
    __syncthreads();
    if (threadIdx.x == 0) {
        unsigned* bar = b.bar;
        __builtin_amdgcn_s_waitcnt(0);
        unsigned nloc = b.st[0], nx = b.st[1];
        if (nloc == 0u) { xcd_barrier_complete(bar, b.x, nloc, nx); b.st[0] = nloc; b.st[1] = nx; }
        const unsigned old = xb_add(&bar[XB_XSUB(b.x)], 1u);
        const unsigned gen = old / nloc;
        if (old + 1u == (gen + 1u) * nloc) {
            __builtin_amdgcn_fence(__ATOMIC_RELEASE, "agent");
            asm volatile("s_waitcnt vmcnt(0)" ::: "memory");
            const unsigned og = xb_add(&bar[XB_TOP], 1u);
            const unsigned tg = og / nx;
            if (og + 1u == (tg + 1u) * nx) xb_add(&bar[XB_TOPGEN], 1u);
            else XB_SPIN(xb_ld(&bar[XB_TOPGEN]) == tg, bar);
            __builtin_amdgcn_fence(__ATOMIC_ACQUIRE, "agent");
            xb_add(&bar[XB_XGEN(b.x)], 1u);
            asm volatile("s_waitcnt vmcnt(0)" ::: "memory");
        } else {
            XB_SPIN(xb_ld(&bar[XB_XGEN(b.x)]) == gen, bar);
            __builtin_amdgcn_fence(__ATOMIC_ACQUIRE, "agent");
            asm volatile("s_waitcnt vmcnt(0)" ::: "memory");
        }
    }
    __syncthreads();
}


__device__ __forceinline__ int next_task(unsigned* cnt, int* slot) {
  __syncthreads();
  if (tidx() == 0) *slot = (int)__hip_atomic_fetch_add(cnt, 1u, __ATOMIC_RELAXED, __HIP_MEMORY_SCOPE_AGENT);
  __syncthreads();
  return *slot;
}
enum { PH_PRE0 = 0, PH_PRE1, PH_PRE2, PH_L1, PH_L2, PH_L3, PH_L4, PH_L5, PH_L6, PH_L7, PH_L8, PH_L9, PH_L9W, PH_L9B, PH_L9C, PH_COUNT };
struct XInfo { int slot, nx, rank, nloc; };
#define QCNT(i) (XCD_BAR_WORDS + 16 * 64 + 64 * (i))

template <int ph>
__device__ __forceinline__ void run_phase(const Params& P, const XInfo& X, int l, unsigned char* smem, const bool rep = false) {
  const int nb = gridDim.x, bid = blockIdx.x, tid = tidx(), lane = tid & 63, wave = tid >> 6;
  const int rbid = nb - 1 - bid;
  __shared__ int sQ;
  const int ntok = (l == 0) ? NTOK : NLAT;
  const int mt_out = ntok / 128;
  switch (ph) {
    case PH_PRE0: {
      for (int u = bid; u < 768; u += nb) modpart_task(P, u / 384, (u / 24) % 16, u % 24, smem);
      for (int u = rbid; u < 2 * 46 * 16; u += nb) { int ll = u / 736, r = u % 736; transpose_task(P.w_in + (size_t)ll * 1024 * 2824, P.wt_in + (size_t)ll * 2944 * 1024, 1024, 2824, (r % 16) * 64, (r / 16) * 64, smem); }
      for (int u = bid; u < 2 * 16 * 16; u += nb) { int ll = u / 256, r = u % 256; transpose_task(P.w_out + (size_t)ll * 1024 * 1024, P.wt_out + (size_t)ll * 1024 * 1024, 1024, 1024, (r % 16) * 64, (r / 16) * 64, smem); }
      for (int u = rbid; u < 2 * 32 * 16; u += nb) { int ll = u / 512, r = u % 512; transpose_task(P.peer_wq + (size_t)ll * 1024 * 2048, P.wt_q + (size_t)ll * 2048 * 1024, 1024, 2048, (r % 16) * 64, (r / 16) * 64, smem); }
      for (int u = bid; u < 256; u += nb) {
        size_t o = ((size_t)u * 256 + tid) * 8; float f[8];
#pragma unroll
        for (int j = 0; j < 8; ++j) f[j] = P.peer_keys[o + j];
        *(uint4*)(P.keysb + o) = pack8(f);
      }
      for (int u = rbid; u < 2 * 576; u += nb) { int ll = u / 576, r = u % 576; if (r < 512) hm2_task(P, ll, 0, r, smem); else hm2_task(P, ll, 1, r - 512, smem); }
      if (bid == nb - 1) {
        for (int i = tid; i < 1024; i += NTHREADS) {
          int pos = i >> 4, f = i & 15;
          float inv = powf(10000.f, -(float)f / 16.f);
          float ang = (float)pos * inv;
          P.ropetab[i] = cosf(ang); P.ropetab[1024 + i] = sinf(ang);
        }
      }
    } break;
    case PH_PRE1: {
      for (int t = bid; t < 816; t += nb) {
        int i = t * 256 + tid;
        int ll = i / (17 * 6144), rem = i % (17 * 6144), col = rem % 6144;
        float a = P.b_ada[ll * 6144 + col];
#pragma unroll
        for (int ks = 0; ks < 16; ++ks) a += P.modp[((size_t)ll * 16 + ks) * 17 * 6144 + rem];
        P.mod[i] = a;
      }
      for (int u = rbid; u < 2048; u += nb) filt_task(P, u >> 10, (u >> 9) & 1, u & 511, smem);
    } break;
    case PH_PRE2: {
      for (int T = bid * 4 + wave; T < NTOK; T += nb * 4) hmod0_token(P, T, lane);
    } break;
    case PH_L1: {
      const int ntile = (NTOK / 128) * 23;
      bf16_t* Pb = P.Pbuf; float* dtb = P.dtbuf;
      const bf16_t* Ain = P.Ybuf; const bf16_t* Win = P.wt_in + (size_t)l * 2944 * 1024;
      for (int t = bid; t < ntile; t += nb) {
        int tm = t / 23, tn = t % 23;
        gemm_tile32(Ain, 1024, Win, 1024, 1024, tm * 128, tn * 128, smem, [&](int m, int n, f32x4 v) {
          if (n < 2816) { uint2 o; o.x = pack2(v[0], v[1]); o.y = pack2(v[2], v[3]); *(uint2*)(Pb + (size_t)m * PST + n) = o; }
          else if (n < 2824) { *(float4*)(dtb + (size_t)m * 8 + (n - 2816)) = make_float4(v[0], v[1], v[2], v[3]); }
        });
      }
    } break;
    case PH_L2: {
      const int nS = NB * 2 * NCH, nCf = 512 + (l == 0 ? 64 : 0), nPr = 576;
      unsigned* cnt = P.bar + QCNT(l * 3 + 0);
      for (;;) {
        int u = next_task(cnt, &sQ);
        if (u >= nS + nCf + nPr) break;
        if (u < nS) { ssd_task<false>(P, l, u / (2 * NCH), (u / NCH) & 1, u % NCH, smem); continue; }
        u -= nS;
        if (u < nCf) { if (u < 512) conf_task(P, l, (u >> 5) * 2048, 2048, (u & 31) * 64, smem); else { int v = u - 512; conf_task(P, l, NLAT + (v >> 2) * 256, 256, (v & 3) * 64, smem); } continue; }
        u -= nCf;
        if (u < 512) prep_task(P, l, true, u >> 5, (u & 31) * 64); else { int v = u - 512; prep_task(P, l, false, v >> 2, (v & 3) * 64); }
      }
    } break;
    case PH_L3: {
      const int nH = 2048 + (l == 0 ? 256 : 0), nA = 2048, nAc = (l == 0 ? 256 : 0), nPf = rep ? 0 : 2048;
      unsigned* cnt = P.bar + QCNT(l * 3 + 1);
      for (;;) {
        int u = next_task(cnt, &sQ);
        if (u >= nH + nA + nAc + nPf) break;
        if (u < nH) { if (u < 2048) hyconv_task(P, l, true, u >> 3, (u & 7) * 256, smem); else hyconv_task(P, l, false, u - 2048, 0, smem); continue; }
        u -= nH;
        if (u < nA) { int b = u >> 7, r = (u >> 2) & 31, c0 = (u & 3) * 16; attn_task<true>(P, l, b, r, c0, wave, lane); continue; }
        u -= nA;
        if (u < nAc) { attn_task<false>(P, l, u >> 4, 0, (u & 15) * 16, wave, lane); continue; }
        u -= nAc;
        ssd_prefix_task(P, u >> 4, u & 15);
      }
    } break;
    case PH_L4: {
      const int nS = (l == 0) ? NB * 2 * NCH : NB * 2 * 32, nHf = 512 + (l == 0 ? 64 : 0);
      unsigned* cnt = P.bar + QCNT(l * 3 + 2);
      for (;;) {
        int u = next_task(cnt, &sQ);
        if (u >= nS + nHf) break;
        if (u < nS) {
          if (l == 0) ssd_task<true>(P, l, u / (2 * NCH), (u / NCH) & 1, u % NCH, smem);
          else ssd_task<true>(P, l, u / 64, (u / 32) & 1, 4 + (u % 32), smem);
          continue;
        }
        u -= nS;
        if (u < 512) hyfin_task(P, l, true, u >> 5, (u & 31) * 64); else { int v = u - 512; hyfin_task(P, l, false, v >> 2, (v & 3) * 64); }
      }
    } break;
    case PH_L5: {
      const int ng = mt_out * 8;
      bf16_t* Yo = P.Pbuf;
      const bf16_t* Ain = P.Ybuf; const bf16_t* Wt = P.wt_out + (size_t)l * 1024 * 1024;
      for (int t = bid; t < ng; t += nb) {
        int tm = t >> 3, tn = t & 7;
        gemm_tile32(Ain, 1024, Wt, 1024, 1024, tm * 128, tn * 128, smem, [&](int m, int n, f32x4 v) {
          uint2 o; o.x = pack2(v[0], v[1]); o.y = pack2(v[2], v[3]); *(uint2*)(Yo + (size_t)m * 1024 + n) = o;
        });
      }
      for (int u = rbid; u < 4096; u += nb) {
        const bool isv = u >= 2048;
        const int e0 = (u & 2047) * 8;
        const float* src = (isv ? P.peer_v : P.peer_u) + (size_t)l * 16384 * 1024 + (size_t)e0 * 1024;
        unsigned char* dstb = (unsigned char*)(isv ? P.tabv : P.tabu);
#pragma unroll
        for (int i = 0; i < 2; ++i) {
          int o = (i * 256 + tid) * 16;
          float4 a = *(const float4*)(src + o), bq = *(const float4*)(src + o + 4), c = *(const float4*)(src + o + 8), d = *(const float4*)(src + o + 12);
          uint4 r;
          r.x = pack4_fp8(a.x * 256.f, a.y * 256.f, a.z * 256.f, a.w * 256.f);
          r.y = pack4_fp8(bq.x * 256.f, bq.y * 256.f, bq.z * 256.f, bq.w * 256.f);
          r.z = pack4_fp8(c.x * 256.f, c.y * 256.f, c.z * 256.f, c.w * 256.f);
          r.w = pack4_fp8(d.x * 256.f, d.y * 256.f, d.z * 256.f, d.w * 256.f);
          *(uint4*)(dstb + (size_t)e0 * 1024 + o) = r;
        }
      }
    } break;
    case PH_L6: {
      for (int T = bid * 4 + wave; T < ntok; T += nb * 4) r1_token(P, l, T, lane, rep);
    } break;
    case PH_L7: {
      const int ng = mt_out * 16;
      bf16_t* Q = P.qbuf;
      for (int t = bid; t < ng; t += nb) {
        int tm = t >> 4, tn = t & 15;
        gemm_tile32(P.Ybuf, 1024, P.wt_q + (size_t)l * 2048 * 1024, 1024, 1024, tm * 128, tn * 128, smem, [&](int m, int n, f32x4 v) {
          uint2 o; o.x = pack2(v[0], v[1]); o.y = pack2(v[2], v[3]); *(uint2*)(Q + (size_t)m * 2048 + n) = o;
        });
      }
    } break;
    case PH_L8: {
      const int ng = mt_out * 8;
      for (int t = bid; t < ng; t += nb) peer_topk_task(P, l, t >> 3, t & 7, smem);
    } break;
    case PH_L9: {
      float* wl = (float*)smem + wave * 128;
      __syncthreads();
      for (int T0 = bid * 4 + wave; T0 < ntok; T0 += nb * 4) { const int T = __builtin_amdgcn_readfirstlane(T0); peer_token(P, l, T, lane, wl, false); }
    } break;
    case PH_L9W: {
      const size_t n = (size_t)ntok * 128;
      for (size_t i = (size_t)bid * 256 + tid; i < n; i += (size_t)nb * 256) {
        float a = 0.f;
#pragma unroll
        for (int x = 0; x < 8; ++x) a += P.pact[(size_t)x * NTOK * 128 + i];
        P.egate[i] = P.egate[i] * gelu_tanh(a * (1.f / 256.f));
      }
    } break;
    case PH_L9B: {
      int* li = (int*)smem + wave * 1024;
      __syncthreads();
      for (int sl = X.slot; sl < 8; sl += X.nx)
        { const int pw = (ntok + X.nloc * 4 - 1) / (X.nloc * 4); const int tf = __builtin_amdgcn_readfirstlane((X.rank * 4 + wave) * pw); peer_v_phase(P, sl, tf, 1, min(ntok, tf + pw), lane, li); }
    } break;
    case PH_L9C: {
      for (int T0 = bid * 4 + wave; T0 < ntok; T0 += nb * 4) { const int T = __builtin_amdgcn_readfirstlane(T0); ln2_token(P, l, T, lane); }
    } break;
  }
}

#if MULTI_LAUNCH
__global__ void __launch_bounds__(NTHREADS) phase_kernel(Params P, int ph, int l) {
  extern __shared__ __attribute__((aligned(16))) unsigned char smem[];
  __shared__ Params sP;
  if (threadIdx.x == 0) sP = P;
  __syncthreads();
  switch (ph) {
    case 0: run_phase<0>(sP, sX, l, smem); break; case 1: run_phase<1>(sP, sX, l, smem); break; case 2: run_phase<2>(sP, sX, l, smem); break;
    case 3: run_phase<3>(sP, sX, l, smem); break; case 4: run_phase<4>(sP, sX, l, smem); break; case 5: run_phase<5>(sP, sX, l, smem); break;
    case 6: run_phase<6>(sP, sX, l, smem); break; case 7: run_phase<7>(sP, sX, l, smem); break; case 8: run_phase<8>(sP, sX, l, smem); break;
    case 9: run_phase<9>(sP, sX, l, smem); break; case 10: run_phase<10>(sP, sX, l, smem); break; case 11: run_phase<11>(sP, sX, l, smem); break;
  }
}
#else
__global__ void __launch_bounds__(NTHREADS, 3) mega_kernel(Params P) {
  extern __shared__ __attribute__((aligned(16))) unsigned char smem[];
  cg::grid_group grid = cg::this_grid();
  __shared__ uint4 xb_words;
  if (threadIdx.x == 0) xb_words = make_uint4(0u, 0u, 0u, 0u);
  __syncthreads();
  XcdBarrier xb = xcd_barrier_post(P.bar, (volatile LAS unsigned*)&xb_words);
  __shared__ XInfo sX;
  if (threadIdx.x == 0) sX.rank = (int)xb_add(&P.bar[XCD_BAR_WORDS + 64 * xb.x], 1u);
  run_phase<PH_PRE0>(P, sX, 0, smem);
  if (P.bar == nullptr) grid.sync();
  xcd_barrier(xb);
  if (threadIdx.x == 0) {
    int slot = 0, nx = 0, nloc = 1;
    for (unsigned j = 0; j < 16; ++j) {
      const int c = (int)xb_ld(&P.bar[XCD_BAR_WORDS + 64 * j]);
      if (c > 0) { if (j < xb.x) ++slot; ++nx; }
      if (j == xb.x) nloc = c > 0 ? c : 1;
    }
    sX.slot = slot; sX.nx = nx > 0 ? nx : 1; sX.nloc = nloc;
  }
  __syncthreads();
  run_phase<PH_PRE1>(P, sX, 0, smem); xcd_barrier(xb);
  run_phase<PH_PRE2>(P, sX, 0, smem); xcd_barrier(xb);
  {
    constexpr int l = 0;
    run_phase<PH_L1>(P, sX, l, smem); xcd_barrier(xb);
#if defined(REPEAT_PH)
    if (REPEAT_PH == PH_L1) { run_phase<PH_L1>(P, sX, l, smem, true); xcd_barrier(xb); }
#endif
    run_phase<PH_L2>(P, sX, l, smem); xcd_barrier(xb);
#if defined(REPEAT_PH)
    if (REPEAT_PH == PH_L2) { run_phase<PH_L2>(P, sX, l, smem, true); xcd_barrier(xb); }
#endif
    run_phase<PH_L3>(P, sX, l, smem); xcd_barrier(xb);
#if defined(REPEAT_PH)
    if (REPEAT_PH == PH_L3) { run_phase<PH_L3>(P, sX, l, smem, true); xcd_barrier(xb); }
#endif
    run_phase<PH_L4>(P, sX, l, smem); xcd_barrier(xb);
#if defined(REPEAT_PH)
    if (REPEAT_PH == PH_L4) { run_phase<PH_L4>(P, sX, l, smem, true); xcd_barrier(xb); }
#endif
    run_phase<PH_L5>(P, sX, l, smem); xcd_barrier(xb);
#if defined(REPEAT_PH)
    if (REPEAT_PH == PH_L5) { run_phase<PH_L5>(P, sX, l, smem, true); xcd_barrier(xb); }
#endif
    run_phase<PH_L6>(P, sX, l, smem); xcd_barrier(xb);
#if defined(REPEAT_PH)
    if (REPEAT_PH == PH_L6) { run_phase<PH_L6>(P, sX, l, smem, true); xcd_barrier(xb); }
#endif
    run_phase<PH_L7>(P, sX, l, smem); xcd_barrier(xb);
#if defined(REPEAT_PH)
    if (REPEAT_PH == PH_L7) { run_phase<PH_L7>(P, sX, l, smem, true); xcd_barrier(xb); }
#endif
    run_phase<PH_L8>(P, sX, l, smem); xcd_barrier(xb);
#if defined(REPEAT_PH)
    if (REPEAT_PH == PH_L8) { run_phase<PH_L8>(P, sX, l, smem, true); xcd_barrier(xb); }
#endif
    run_phase<PH_L9>(P, sX, l, smem); xcd_barrier(xb);
#if defined(REPEAT_PH)
    if (REPEAT_PH == PH_L9) { run_phase<PH_L9>(P, sX, l, smem, true); xcd_barrier(xb); }
#endif
  }
  {
    constexpr int l = 1;
    run_phase<PH_L1>(P, sX, l, smem); xcd_barrier(xb);
#if defined(REPEAT_PH)
    if (REPEAT_PH == PH_L1) { run_phase<PH_L1>(P, sX, l, smem, true); xcd_barrier(xb); }
#endif
    run_phase<PH_L2>(P, sX, l, smem); xcd_barrier(xb);
#if defined(REPEAT_PH)
    if (REPEAT_PH == PH_L2) { run_phase<PH_L2>(P, sX, l, smem, true); xcd_barrier(xb); }
#endif
    run_phase<PH_L3>(P, sX, l, smem); xcd_barrier(xb);
#if defined(REPEAT_PH)
    if (REPEAT_PH == PH_L3) { run_phase<PH_L3>(P, sX, l, smem, true); xcd_barrier(xb); }
#endif
    run_phase<PH_L4>(P, sX, l, smem); xcd_barrier(xb);
#if defined(REPEAT_PH)
    if (REPEAT_PH == PH_L4) { run_phase<PH_L4>(P, sX, l, smem, true); xcd_barrier(xb); }
#endif
    run_phase<PH_L5>(P, sX, l, smem); xcd_barrier(xb);
#if defined(REPEAT_PH)
    if (REPEAT_PH == PH_L5) { run_phase<PH_L5>(P, sX, l, smem, true); xcd_barrier(xb); }
#endif
    run_phase<PH_L6>(P, sX, l, smem); xcd_barrier(xb);
#if defined(REPEAT_PH)
    if (REPEAT_PH == PH_L6) { run_phase<PH_L6>(P, sX, l, smem, true); xcd_barrier(xb); }
#endif
    run_phase<PH_L7>(P, sX, l, smem); xcd_barrier(xb);
#if defined(REPEAT_PH)
    if (REPEAT_PH == PH_L7) { run_phase<PH_L7>(P, sX, l, smem, true); xcd_barrier(xb); }
#endif
    run_phase<PH_L8>(P, sX, l, smem); xcd_barrier(xb);
#if defined(REPEAT_PH)
    if (REPEAT_PH == PH_L8) { run_phase<PH_L8>(P, sX, l, smem, true); xcd_barrier(xb); }
#endif
    run_phase<PH_L9>(P, sX, l, smem); xcd_barrier(xb);
#if defined(REPEAT_PH)
    if (REPEAT_PH == PH_L9) { run_phase<PH_L9>(P, sX, l, smem, true); xcd_barrier(xb); }
#endif
  }
}
#endif

extern "C" void kernel_launch(void* const* d_in, const int* in_sizes, int n_in, void* d_out, int out_size, void* d_ws, size_t ws_size, hipStream_t stream) {
  Params P{};
  const float** pf = (const float**)&P;
  for (int i = 0; i < 36; ++i) pf[i] = (const float*)d_in[i];
  P.out = (float*)d_out;
  unsigned char* w = (unsigned char*)d_ws;
  size_t off = 0;
  auto take = [&](size_t bytes) { unsigned char* p = w + off; off += (bytes + 255) & ~(size_t)255; return p; };
  P.Pbuf = (bf16_t*)take((size_t)NTOK * PST * 2);
  P.Ybuf = (bf16_t*)take((size_t)NTOK * 1024 * 2);
  P.xc = (float*)take((size_t)4096 * 1024 * 4);
  P.dtbuf = (float*)take((size_t)NTOK * 8 * 4);
  P.wt_in = (bf16_t*)take((size_t)2 * 2944 * 1024 * 2);
  P.wt_out = (bf16_t*)take((size_t)2 * 1024 * 1024 * 2);
  P.wt_q = (bf16_t*)take((size_t)2 * 2048 * 1024 * 2);
  P.keysb = (bf16_t*)take((size_t)2 * 8 * 2 * 128 * 128 * 2);
  P.modp = (float*)take((size_t)2 * 16 * 17 * 6144 * 4);
  P.mod = (float*)take((size_t)3 * 17 * 6144 * 4);
  P.hm2 = (float*)take((size_t)2 * 2 * 2048 * 64 * 4);
  P.gtab = (bf16_t*)take((size_t)2 * (256 * 2 * 4096 + 256 * 2 * 512) * 2);
  P.ropetab = (float*)take(2048 * 4);
  P.bar = (unsigned*)take((XCD_BAR_WORDS + 16 * 64 + 8 * 64) * 4);
  unsigned char* treg = w + off;
  P.krot = (bf16_t*)take((size_t)NLAT * 256 * 2);
  P.vt_lat = (bf16_t*)take((size_t)16 * 256 * 2048 * 2);
  P.vt_ctx = (bf16_t*)take((size_t)16 * 256 * 256 * 2);
  P.sst = (float*)take((size_t)16 * 2 * 4 * NCH * 4096 * 4);
  P.ssumA = (float*)take((size_t)16 * 2 * 4 * NCH * 4);
  const size_t hysz = (size_t)16 * 256 * (2048 + 256) * 2;
  P.uT = (bf16_t*)take(hysz);
  P.x0T = (bf16_t*)take(hysz);
  P.yT = (bf16_t*)take(hysz);
  P.tabu = (bf16_t*)treg;
  P.tabv = (bf16_t*)(treg + (size_t)16384 * 1024);
  P.pout = (bf16_t*)(treg + (size_t)40 * 1024 * 1024);
  P.pact = (float*)P.Pbuf;
  P.qbuf = P.Pbuf;
  P.eidx = (int*)((unsigned char*)P.Pbuf + (size_t)NTOK * 2048 * 2);
  P.egate = (float*)((unsigned char*)P.eidx + (size_t)NTOK * 128 * 4);
  if (off > ws_size || n_in != 36) { fprintf(stderr, "kernel_launch: workspace too small (%zu > %zu) or n_in %d != 36\n", off, ws_size, n_in); return; }

  static int grid = 0;
#if MULTI_LAUNCH
  if (!grid) {
    hipFuncSetAttribute((const void*)phase_kernel, hipFuncAttributeMaxDynamicSharedMemorySize, LDS_BYTES);
    grid = 512;
  }
  hipLaunchKernelGGL(phase_kernel, dim3(grid), dim3(NTHREADS), LDS_BYTES, stream, P, PH_PRE0, 0);
  hipLaunchKernelGGL(phase_kernel, dim3(grid), dim3(NTHREADS), LDS_BYTES, stream, P, PH_PRE1, 0);
  hipLaunchKernelGGL(phase_kernel, dim3(grid), dim3(NTHREADS), LDS_BYTES, stream, P, PH_PRE2, 0);
  for (int l = 0; l < 2; ++l)
    for (int ph = PH_L1; ph <= PH_L9; ++ph) hipLaunchKernelGGL(phase_kernel, dim3(grid), dim3(NTHREADS), LDS_BYTES, stream, P, ph, l);
#else
  if (!grid) {
    int dev = 0, cus = 0, per_cu = 0;
    hipGetDevice(&dev);
    hipDeviceGetAttribute(&cus, hipDeviceAttributeMultiprocessorCount, dev);
    hipFuncSetAttribute((const void*)mega_kernel, hipFuncAttributeMaxDynamicSharedMemorySize, LDS_BYTES);
    hipOccupancyMaxActiveBlocksPerMultiprocessor(&per_cu, (const void*)mega_kernel, NTHREADS, LDS_BYTES);
    if (per_cu < 1) { fprintf(stderr, "kernel_launch: occupancy query returned %d\n", per_cu); per_cu = 1; }
    if (per_cu > 3) per_cu = 3;
    grid = cus * per_cu;
  }
  if (hipMemsetAsync(P.bar, 0, (XCD_BAR_WORDS + 16 * 64 + 8 * 64) * 4, stream) != hipSuccess) { fprintf(stderr, "kernel_launch: memset of barrier words failed\n"); return; }
  void* args[] = {&P};
  hipError_t e = hipLaunchCooperativeKernel((const void*)mega_kernel, dim3(grid), dim3(NTHREADS), args, LDS_BYTES, stream);
  if (e != hipSuccess) fprintf(stderr, "cooperative launch failed: %s (grid %d)\n", hipGetErrorString(e), grid);
#endif
}
```

```cpp
#include <hip/hip_runtime.h>
#include <hip/hip_cooperative_groups.h>
#include <cstdio>
#include <cstdint>
namespace cg = cooperative_groups;

#ifndef MULTI_LAUNCH
#define MULTI_LAUNCH 0
#endif

typedef unsigned short bf16_t;
typedef __attribute__((ext_vector_type(8))) short bf16x8;
typedef __attribute__((ext_vector_type(4))) float f32x4;

#define D_MODEL 1024
#define NB 16
#define SEQ 2048
#define CTXL 256
#define NLAT 32768
#define NTOK 36864
#define PST 2816
#define NCH 36
#define LDS_BYTES 53248
#define NTHREADS 256
#define ALPHA 1.41421356237f
#define LN_EPS 1e-5f

struct Params {
  const float *x, *c, *ctx, *c_ctx, *w_ada, *b_ada, *w_in, *w_out, *ln1_g, *ln1_b, *ln2_g, *ln2_b;
  const float *conf_dw_w, *conf_dw_b, *conf_norm_g, *conf_norm_b, *na_rpb, *hy_short_w, *hy_short_b;
  const float *hy_w1, *hy_b1, *hy_w2, *hy_b2, *hy_w3, *hy_decay, *hy_bias;
  const float *ssd_conv_w, *ssd_conv_b, *ssd_a_log, *ssd_dt_bias, *ssd_d, *ssd_norm_g;
  const float *peer_wq, *peer_keys, *peer_u, *peer_v;
  float* out;
  bf16_t* Pbuf;
  bf16_t* Ybuf;
  float*  xc;
  float*  dtbuf;
  bf16_t* wt_in;
  bf16_t* wt_out;
  bf16_t* wt_q;
  bf16_t* keysb;
  float*  modp;
  float*  mod;
  float*  hm2;
  bf16_t* gtab;
  float*  ropetab;
  bf16_t* krot;
  bf16_t* vt_lat;
  bf16_t* vt_ctx;
  float*  sst;
  float*  ssumA;
  bf16_t* uT;
  bf16_t* x0T;
  bf16_t* yT;
  bf16_t* tabu;
  bf16_t* tabv;
  int*    eidx;
  float*  egate;
  bf16_t* qbuf;
  unsigned* bar;
  float* pact;
  bf16_t* pout;
};

__device__ __forceinline__ bf16_t f2bf(float f) { unsigned u = __float_as_uint(f); u += 0x7FFFu + ((u >> 16) & 1u); return (bf16_t)(u >> 16); }
__device__ __forceinline__ float bf2f(bf16_t h) { return __uint_as_float(((unsigned)h) << 16); }
__device__ __forceinline__ unsigned pack2(float a, float b) { return (unsigned)f2bf(a) | ((unsigned)f2bf(b) << 16); }
__device__ __forceinline__ float lo2f(unsigned u) { return __uint_as_float(u << 16); }
__device__ __forceinline__ float hi2f(unsigned u) { return __uint_as_float(u & 0xFFFF0000u); }
__device__ __forceinline__ float sigmoidf_(float x) { return 1.f / (1.f + __expf(-x)); }
__device__ __forceinline__ float siluf_(float x) { return x / (1.f + __expf(-x)); }
__device__ __forceinline__ float wave_sum(float v) {
#pragma unroll
  for (int o = 32; o >= 1; o >>= 1) v += __shfl_xor(v, o);
  return v;
}
__device__ __forceinline__ void unpack8(uint4 v, float* f) {
  f[0] = lo2f(v.x); f[1] = hi2f(v.x); f[2] = lo2f(v.y); f[3] = hi2f(v.y);
  f[4] = lo2f(v.z); f[5] = hi2f(v.z); f[6] = lo2f(v.w); f[7] = hi2f(v.w);
}
__device__ __forceinline__ uint4 pack8(const float* f) {
  uint4 v; v.x = pack2(f[0], f[1]); v.y = pack2(f[2], f[3]); v.z = pack2(f[4], f[5]); v.w = pack2(f[6], f[7]); return v;
}
__device__ __forceinline__ bf16x8 as_bf8(uint4 v) { union { uint4 u; bf16x8 b; } x; x.u = v; return x.b; }
__device__ __forceinline__ f32x4 mfma16(bf16x8 a, bf16x8 b, f32x4 c) { return __builtin_amdgcn_mfma_f32_16x16x32_bf16(a, b, c, 0, 0, 0); }

__device__ __forceinline__ int tidx() { int t = threadIdx.x; asm volatile("" : "+v"(t)); return t; }
template <class Epi>
__device__ __forceinline__ void gemm_tile(const bf16_t* __restrict__ A, int lda, const bf16_t* __restrict__ Bt, int ldb,
                                          int K, int m0, int n0, unsigned char* smem, Epi epi) {
  bf16_t* As = (bf16_t*)smem;
  bf16_t* Bs = As + 3 * 128 * 40;
  const int tid = tidx(), lane = tid & 63, wave = tid >> 6;
  const int wm = wave >> 1, wn = wave & 1;
  const int lr = tid >> 1, lh = tid & 1;
  const bf16_t* ag = A + (size_t)(m0 + lr) * lda + lh * 16;
  const bf16_t* bg = Bt + (size_t)(n0 + lr) * ldb + lh * 16;
  f32x4 acc[4][4];
#pragma unroll
  for (int i = 0; i < 4; ++i)
#pragma unroll
    for (int j = 0; j < 4; ++j) acc[i][j] = (f32x4){0.f, 0.f, 0.f, 0.f};
  const int nk = K >> 5;
  uint4 pa0 = *(const uint4*)ag, pa1 = *(const uint4*)(ag + 8), pb0 = *(const uint4*)bg, pb1 = *(const uint4*)(bg + 8);
  uint4 qa0 = *(const uint4*)(ag + 32), qa1 = *(const uint4*)(ag + 40), qb0 = *(const uint4*)(bg + 32), qb1 = *(const uint4*)(bg + 40);
  __syncthreads();
  {
    bf16_t* wa = As + lr * 40 + lh * 16; bf16_t* wb = Bs + lr * 40 + lh * 16;
    *(uint4*)wa = pa0; *(uint4*)(wa + 8) = pa1; *(uint4*)wb = pb0; *(uint4*)(wb + 8) = pb1;
  }
  __syncthreads();
  int st = 0;
  auto compute = [&](int stage) {
    const bf16_t* as = As + stage * 5120 + (wm * 64 + (lane & 15)) * 40 + (lane >> 4) * 8;
    const bf16_t* bs = Bs + stage * 5120 + (wn * 64 + (lane & 15)) * 40 + (lane >> 4) * 8;
    bf16x8 afr[4];
#pragma unroll
    for (int j = 0; j < 4; ++j) afr[j] = *(const bf16x8*)(bs + j * 16 * 40);
#pragma unroll
    for (int i = 0; i < 4; ++i) {
      const bf16x8 bfr = *(const bf16x8*)(as + i * 16 * 40);
#pragma unroll
      for (int j = 0; j < 4; ++j) acc[i][j] = mfma16(afr[j], bfr, acc[i][j]);
    }
  };
  for (int kt = 0; kt < nk; kt += 2) {
    if (kt + 2 < nk) { const bf16_t* a2 = ag + (kt + 2) * 32; const bf16_t* b2 = bg + (kt + 2) * 32; pa0 = *(const uint4*)a2; pa1 = *(const uint4*)(a2 + 8); pb0 = *(const uint4*)b2; pb1 = *(const uint4*)(b2 + 8); }
    compute(st);
    {
      const int s1 = (st == 2) ? 0 : st + 1;
      bf16_t* wa = As + s1 * 5120 + lr * 40 + lh * 16; bf16_t* wb = Bs + s1 * 5120 + lr * 40 + lh * 16;
      *(uint4*)wa = qa0; *(uint4*)(wa + 8) = qa1; *(uint4*)wb = qb0; *(uint4*)(wb + 8) = qb1;
      st = s1;
    }
    __syncthreads();
    if (kt + 3 < nk) { const bf16_t* a2 = ag + (kt + 3) * 32; const bf16_t* b2 = bg + (kt + 3) * 32; qa0 = *(const uint4*)a2; qa1 = *(const uint4*)(a2 + 8); qb0 = *(const uint4*)b2; qb1 = *(const uint4*)(b2 + 8); }
    compute(st);
    if (kt + 2 < nk) {
      const int s1 = (st == 2) ? 0 : st + 1;
      bf16_t* wa = As + s1 * 5120 + lr * 40 + lh * 16; bf16_t* wb = Bs + s1 * 5120 + lr * 40 + lh * 16;
      *(uint4*)wa = pa0; *(uint4*)(wa + 8) = pa1; *(uint4*)wb = pb0; *(uint4*)(wb + 8) = pb1;
      st = s1;
    }
    __syncthreads();
  }
#pragma unroll
  for (int i = 0; i < 4; ++i)
#pragma unroll
    for (int j = 0; j < 4; ++j) {
      int m = m0 + wm * 64 + i * 16 + (lane & 15);
      int n = n0 + wn * 64 + j * 16 + (lane >> 4) * 4;
      epi(m, n, acc[i][j]);
    }
}

template <class Epi>
__device__ __forceinline__ void gemm_tile32(const bf16_t* __restrict__ A, int lda, const bf16_t* __restrict__ Bt, int ldb,
                                          int K, int m0, int n0, unsigned char* smem, Epi epi) {
  bf16_t* As = (bf16_t*)smem;
  bf16_t* Bs = As + 2 * 128 * 40;
  const int tid = tidx(), lane = tid & 63, wave = tid >> 6;
  const int wm = wave >> 1, wn = wave & 1;
  const int lr = tid >> 1, lh = tid & 1;
  const bf16_t* ag = A + (size_t)(m0 + lr) * lda + lh * 16;
  const bf16_t* bg = Bt + (size_t)(n0 + lr) * ldb + lh * 16;
  f32x4 acc[4][4];
#pragma unroll
  for (int i = 0; i < 4; ++i)
#pragma unroll
    for (int j = 0; j < 4; ++j) acc[i][j] = (f32x4){0.f, 0.f, 0.f, 0.f};
  uint4 ra0 = *(const uint4*)ag, ra1 = *(const uint4*)(ag + 8);
  uint4 rb0 = *(const uint4*)bg, rb1 = *(const uint4*)(bg + 8);
  __syncthreads();
  {
    bf16_t* pa = As + lr * 40 + lh * 16; bf16_t* pb = Bs + lr * 40 + lh * 16;
    *(uint4*)pa = ra0; *(uint4*)(pa + 8) = ra1; *(uint4*)pb = rb0; *(uint4*)(pb + 8) = rb1;
  }
  __syncthreads();
  const int nk = K >> 5;
  for (int kt = 0; kt < nk; ++kt) {
    const int cur = kt & 1;
    if (kt + 1 < nk) {
      const bf16_t* a2 = ag + (kt + 1) * 32; const bf16_t* b2 = bg + (kt + 1) * 32;
      ra0 = *(const uint4*)a2; ra1 = *(const uint4*)(a2 + 8); rb0 = *(const uint4*)b2; rb1 = *(const uint4*)(b2 + 8);
    }
    const bf16_t* as = As + cur * 5120 + (wm * 64 + (lane & 15)) * 40 + (lane >> 4) * 8;
    const bf16_t* bs = Bs + cur * 5120 + (wn * 64 + (lane & 15)) * 40 + (lane >> 4) * 8;
    bf16x8 afr[4];
#pragma unroll
    for (int j = 0; j < 4; ++j) afr[j] = *(const bf16x8*)(bs + j * 16 * 40);
#pragma unroll
    for (int i = 0; i < 4; ++i) {
      const bf16x8 bfr = *(const bf16x8*)(as + i * 16 * 40);
#pragma unroll
      for (int j = 0; j < 4; ++j) acc[i][j] = mfma16(afr[j], bfr, acc[i][j]);
    }
    if (kt + 1 < nk) {
      bf16_t* pa = As + (cur ^ 1) * 5120 + lr * 40 + lh * 16; bf16_t* pb = Bs + (cur ^ 1) * 5120 + lr * 40 + lh * 16;
      *(uint4*)pa = ra0; *(uint4*)(pa + 8) = ra1; *(uint4*)pb = rb0; *(uint4*)(pb + 8) = rb1;
    }
    __syncthreads();
  }
#pragma unroll
  for (int i = 0; i < 4; ++i)
#pragma unroll
    for (int j = 0; j < 4; ++j) {
      int m = m0 + wm * 64 + i * 16 + (lane & 15);
      int n = n0 + wn * 64 + j * 16 + (lane >> 4) * 4;
      epi(m, n, acc[i][j]);
    }
}

__device__ __forceinline__ void transpose_task(const float* __restrict__ src, bf16_t* __restrict__ dst, int K, int N, int k0, int n0, unsigned char* smem) {
  float* tile = (float*)smem;
  const int tid = tidx();
  __syncthreads();
  {
    int r = tid >> 4, c4 = tid & 15;
#pragma unroll
    for (int rr = 0; rr < 4; ++rr) {
      int row = rr * 16 + r;
      float4 v = make_float4(0.f, 0.f, 0.f, 0.f);
      if (n0 + c4 * 4 < N) v = *(const float4*)(src + (size_t)(k0 + row) * N + n0 + c4 * 4);
      float* t = tile + row * 65 + c4 * 4;
      t[0] = v.x; t[1] = v.y; t[2] = v.z; t[3] = v.w;
    }
  }
  __syncthreads();
  {
    int n = tid >> 2, kq = tid & 3;
    float f[16];
#pragma unroll
    for (int i = 0; i < 16; ++i) f[i] = tile[(kq * 16 + i) * 65 + n];
    bf16_t* d = dst + (size_t)(n0 + n) * K + k0 + kq * 16;
    *(uint4*)d = pack8(f); *(uint4*)(d + 8) = pack8(f + 8);
  }
}

__device__ __forceinline__ void modpart_task(const Params& P, int l, int ks, int cb, unsigned char* smem) {
  float* s = (float*)smem;
  const int tid = tidx();
  __syncthreads();
  for (int i = tid; i < 17 * 64; i += NTHREADS) {
    int r = i >> 6, k = i & 63;
    float v = (r < 16) ? P.c[r * 1024 + ks * 64 + k] : P.c_ctx[ks * 64 + k];
    s[i] = siluf_(v);
  }
  __syncthreads();
  float acc[17];
#pragma unroll
  for (int r = 0; r < 17; ++r) acc[r] = 0.f;
  const int col = cb * 256 + tid;
  const float* w = P.w_ada + ((size_t)l * 1024 + ks * 64) * 6144 + col;
#pragma unroll 8
  for (int k = 0; k < 64; ++k) {
    float wv = w[(size_t)k * 6144];
#pragma unroll
    for (int r = 0; r < 17; ++r) acc[r] += s[r * 64 + k] * wv;
  }
#pragma unroll
  for (int r = 0; r < 17; ++r) P.modp[(((size_t)l * 16 + ks) * 17 + r) * 6144 + col] = acc[r];
}

__device__ __forceinline__ void hm2_task(const Params& P, int l, int lsel, int t4, unsigned char* smem) {
  float* z = (float*)smem;
  float* h1 = z + 4 * 36;
  const int tid = tidx(), tt = tid >> 6, j = tid & 63;
  const int L = lsel ? 256 : 2048;
  const int t = t4 * 4 + tt;
  const float tn = (float)t / (float)L;
  __syncthreads();
  if (j < 33) {
    float v;
    if (j == 0) v = tn;
    else if (j <= 16) v = sinf((6.2831855f * (float)j) * tn);
    else v = cosf((6.2831855f * (float)(j - 16)) * tn);
    z[tt * 36 + j] = v;
  }
  __syncthreads();
  float a = P.hy_b1[l * 64 + j];
  for (int i = 0; i < 33; ++i) a += z[tt * 36 + i] * P.hy_w1[(l * 33 + i) * 64 + j];
  h1[tt * 64 + j] = sinf(a);
  __syncthreads();
  float b = P.hy_b2[l * 64 + j];
  for (int i = 0; i < 64; ++i) b += h1[tt * 64 + i] * P.hy_w2[(l * 64 + i) * 64 + j];
  P.hm2[(((size_t)l * 2 + lsel) * 2048 + t) * 64 + j] = sinf(b);
}

__device__ __forceinline__ bf16_t* gtab_ptr(const Params& P, int l, int lsel, int c) {
  bf16_t* base = P.gtab + (size_t)l * (256 * 2 * 4096 + 256 * 2 * 512);
  return lsel ? base + 256 * 2 * 4096 + (size_t)c * 1024 : base + (size_t)c * 8192;
}

__device__ __forceinline__ void filt_task(const Params& P, int l, int lsel, int col, unsigned char* smem) {
  float* kv = (float*)smem;
  float* red = kv + 2048;
  float* w3s = red + 8;
  const int tid = tidx();
  const int L = lsel ? 256 : 2048;
  __syncthreads();
  if (tid < 64) w3s[tid] = P.hy_w3[(l * 64 + tid) * 512 + col];
  __syncthreads();
  const float dec = P.hy_decay[l * 512 + col];
  float asum = 0.f;
  for (int t = tid; t < L; t += NTHREADS) {
    const float* h = P.hm2 + (((size_t)l * 2 + lsel) * 2048 + t) * 64;
    float a = 0.f;
#pragma unroll 8
    for (int i = 0; i < 64; ++i) a += h[i] * w3s[i];
    float tn = (float)t / (float)L;
    a *= expf(-tn * dec);
    kv[t] = a; asum += fabsf(a);
  }
  asum = wave_sum(asum);
  if ((tid & 63) == 0) red[tid >> 6] = asum;
  __syncthreads();
  const float inv = 1.f / (red[0] + red[1] + red[2] + red[3] + 1e-6f);
  const int c = col & 255;
  const bool bwd = col >= 256;
  bf16_t* g0 = gtab_ptr(P, l, lsel, c);
  bf16_t* g1 = g0 + 2 * L;
  for (int d = tid; d < L; d += NTHREADS) {
    if (bwd && d == 0) continue;
    int i = bwd ? (L - 1 + d) : (L - 1 - d);
    bf16_t v = f2bf(kv[d] * inv);
    g0[i] = v;
    if (i >= 1) g1[i - 1] = v;
  }
}

__device__ __forceinline__ int mod_row(int T) { return T < NLAT ? (T >> 11) : 16; }

__device__ __forceinline__ void hmod0_token(const Params& P, int T, int lane) {
  const float* xr = (T < NLAT) ? P.x + (size_t)T * 1024 : P.ctx + (size_t)(T - NLAT) * 1024;
  const float* m = P.mod + (size_t)mod_row(T) * 6144;
#pragma unroll
  for (int i = 0; i < 2; ++i) {
    int d = i * 512 + lane * 8;
    float f[8];
#pragma unroll
    for (int j = 0; j < 8; ++j) f[j] = xr[d + j] * (1.f + m[1024 + d + j]) + m[d + j];
    *(uint4*)(P.Ybuf + (size_t)T * 1024 + d) = pack8(f);
  }
}

__device__ __forceinline__ void r1_token(const Params& P, int l, int T, int lane, const bool dry) {
  const float* xr;
  float* xw;
  if (T < NLAT) { xr = (l == 0) ? P.x + (size_t)T * 1024 : P.out + (size_t)T * 1024; xw = P.out + (size_t)T * 1024; }
  else { xr = (l == 0) ? P.ctx + (size_t)(T - NLAT) * 1024 : P.xc + (size_t)(T - NLAT) * 1024; xw = P.xc + (size_t)(T - NLAT) * 1024; }
  bf16_t* hw = P.Ybuf + (size_t)T * 1024;
  if (dry) { xw = (float*)P.uT + (size_t)(T & 2047) * 1024; hw = P.x0T + (size_t)(T & 2047) * 1024; }
  const float* m = P.mod + ((size_t)l * 17 + mod_row(T)) * 6144;
  const bf16_t* yo = P.Pbuf + (size_t)T * 1024;
  float v[16];
  float s = 0.f;
#pragma unroll
  for (int i = 0; i < 2; ++i) {
    int d = i * 512 + lane * 8;
    float y[8]; unpack8(*(const uint4*)(yo + d), y);
#pragma unroll
    for (int j = 0; j < 8; ++j) { v[i * 8 + j] = ALPHA * xr[d + j] + m[2048 + d + j] * y[j]; s += v[i * 8 + j]; }
  }
  float mean = wave_sum(s) * (1.f / 1024.f);
  float q = 0.f;
#pragma unroll
  for (int i = 0; i < 16; ++i) { v[i] -= mean; q += v[i] * v[i]; }
  float rstd = rsqrtf(wave_sum(q) * (1.f / 1024.f) + LN_EPS);
#pragma unroll
  for (int i = 0; i < 2; ++i) {
    int d = i * 512 + lane * 8;
    float h[8];
#pragma unroll
    for (int j = 0; j < 8; ++j) {
      float x1 = v[i * 8 + j] * rstd * P.ln1_g[l * 1024 + d + j] + P.ln1_b[l * 1024 + d + j];
      xw[d + j] = x1;
      h[j] = x1 * (1.f + m[4096 + d + j]) + m[3072 + d + j];
    }
    *(uint4*)(hw + d) = pack8(h);
  }
}

__device__ __forceinline__ float gelu_tanh(float x) {
  float u = 0.7978845608f * (x + 0.044715f * x * x * x);
  float t = 1.f - 2.f / (1.f + __expf(2.f * u));
  return 0.5f * x * (1.f + t);
}

typedef float f32x2 __attribute__((ext_vector_type(2)));
__device__ __forceinline__ unsigned pack4_fp8(float a, float b, float c, float d) {
  int v = 0;
  v = __builtin_amdgcn_cvt_pk_fp8_f32(a, b, v, false);
  v = __builtin_amdgcn_cvt_pk_fp8_f32(c, d, v, true);
  return (unsigned)v;
}
__device__ __forceinline__ float dot16_fp8(uint4 v, const float* h) {
  f32x2 acc = (f32x2){0.f, 0.f};
  unsigned w[4] = {v.x, v.y, v.z, v.w};
#pragma unroll
  for (int q = 0; q < 4; ++q) {
    acc += __builtin_amdgcn_cvt_pk_f32_fp8((int)w[q], false) * (f32x2){h[q * 4], h[q * 4 + 1]};
    acc += __builtin_amdgcn_cvt_pk_f32_fp8((int)w[q], true) * (f32x2){h[q * 4 + 2], h[q * 4 + 3]};
  }
  return acc[0] + acc[1];
}
typedef float f32x4_t __attribute__((ext_vector_type(4)));
__device__ __forceinline__ void peer_u_phase(const Params& P, int sl, int Tfirst, int Tstride, int ntok, int lane, int* li) {
  const int m = lane & 15, quad = lane >> 4;
  const unsigned char* tu = (const unsigned char*)P.tabu + (size_t)sl * 16384 * 128 + quad * 32;
  const int wpos = (lane & 15) * 8 + (lane >> 4);
  for (int T0 = Tfirst; T0 < ntok; T0 += 4 * Tstride) {
    int Tk[4];
    {
      int ir[4][2];
#pragma unroll
      for (int k = 0; k < 4; ++k) {
        Tk[k] = min(T0 + k * Tstride, ntok - 1);
        const int* er = P.eidx + (size_t)Tk[k] * 128;
        ir[k][0] = er[lane]; ir[k][1] = er[64 + lane];
      }
#pragma unroll
      for (int k = 0; k < 4; ++k) { li[k * 128 + wpos] = ir[k][0]; li[k * 128 + wpos + 4] = ir[k][1]; }
    }
#pragma unroll 1
    for (int k = 0; k < 4; ++k) {
      const int Tc = min(T0 + k * Tstride, ntok - 1);
      uint4 hr[4];
      const bf16_t* hp = P.Ybuf + (size_t)Tc * 1024 + sl * 128 + quad * 32;
#pragma unroll
      for (int q = 0; q < 4; ++q) hr[q] = *(const uint4*)(hp + q * 8);
      uint4 rv[16];
      {
        int idx[8];
#pragma unroll
        for (int q = 0; q < 2; ++q) { int4 v = *(const int4*)(li + k * 128 + m * 8 + q * 4); idx[q * 4] = v.x; idx[q * 4 + 1] = v.y; idx[q * 4 + 2] = v.z; idx[q * 4 + 3] = v.w; }
#pragma unroll
        for (int t = 0; t < 8; ++t) { const unsigned char* rp = tu + (size_t)idx[t] * 128; rv[2 * t] = *(const uint4*)rp; rv[2 * t + 1] = *(const uint4*)(rp + 16); }
      }
      long hb[4];
#pragma unroll
      for (int q = 0; q < 4; ++q) {
        float f[8]; unpack8(hr[q], f);
        unsigned lo = pack4_fp8(f[0], f[1], f[2], f[3]), hi = pack4_fp8(f[4], f[5], f[6], f[7]);
        hb[q] = (long)(((unsigned long long)hi << 32) | (unsigned long long)lo);
      }
      const bool live = (T0 + k * Tstride) < ntok;
      float* po = P.pact + ((size_t)sl * NTOK + Tc) * 128 + quad * 4;
#pragma unroll
      for (int t = 0; t < 8; ++t) {
        f32x4_t acc = (f32x4_t){0.f, 0.f, 0.f, 0.f};
        const uint4 r0 = rv[2 * t], r1 = rv[2 * t + 1];
        acc = __builtin_amdgcn_mfma_f32_16x16x32_fp8_fp8((long)(((unsigned long long)r0.y << 32) | r0.x), hb[0], acc, 0, 0, 0);
        acc = __builtin_amdgcn_mfma_f32_16x16x32_fp8_fp8((long)(((unsigned long long)r0.w << 32) | r0.z), hb[1], acc, 0, 0, 0);
        acc = __builtin_amdgcn_mfma_f32_16x16x32_fp8_fp8((long)(((unsigned long long)r1.y << 32) | r1.x), hb[2], acc, 0, 0, 0);
        acc = __builtin_amdgcn_mfma_f32_16x16x32_fp8_fp8((long)(((unsigned long long)r1.w << 32) | r1.z), hb[3], acc, 0, 0, 0);
        if (m == 0 && live) *(float4*)(po + t * 16) = make_float4(acc[0], acc[1], acc[2], acc[3]);
      }
    }
  }
}
__device__ __forceinline__ void peer_v_phase(const Params& P, int sl, int Tfirst, int Tstride, int ntok, int lane, int* li) {
  const int grp = lane >> 3, j8 = lane & 7;
  const unsigned char* tv = (const unsigned char*)P.tabv + (size_t)sl * 16384 * 128 + j8 * 16;
  float* lw = (float*)(li + 512);
  const int wpos = (lane & 7) * 16 + (lane >> 3);
  for (int T0 = Tfirst; T0 < ntok; T0 += 4 * Tstride) {
    int Tk[4];
    {
      int ir[4][2]; float wr[4][2];
#pragma unroll
      for (int k = 0; k < 4; ++k) {
        Tk[k] = min(T0 + k * Tstride, ntok - 1);
        const int* er = P.eidx + (size_t)Tk[k] * 128; const float* gr = P.egate + (size_t)Tk[k] * 128;
        ir[k][0] = er[lane]; ir[k][1] = er[64 + lane]; wr[k][0] = gr[lane]; wr[k][1] = gr[64 + lane];
      }
#pragma unroll
      for (int k = 0; k < 4; ++k) { li[k * 128 + wpos] = ir[k][0]; li[k * 128 + wpos + 8] = ir[k][1]; lw[k * 128 + wpos] = wr[k][0]; lw[k * 128 + wpos + 8] = wr[k][1]; }
    }
    uint4 rv[1][16];
#pragma unroll
    for (int k = 0; k < 4; ++k) {
      {
        int idx[16];
#pragma unroll
        for (int q = 0; q < 4; ++q) { int4 v = *(const int4*)(li + k * 128 + grp * 16 + q * 4); idx[q * 4] = v.x; idx[q * 4 + 1] = v.y; idx[q * 4 + 2] = v.z; idx[q * 4 + 3] = v.w; }
#pragma unroll
        for (int t = 0; t < 16; ++t) rv[0][t] = *(const uint4*)(tv + (size_t)idx[t] * 128);
      }
      {
        const int kk = k;
        float w[16];
#pragma unroll
        for (int q = 0; q < 4; ++q) { float4 f = *(const float4*)(lw + kk * 128 + grp * 16 + q * 4); w[q * 4] = f.x; w[q * 4 + 1] = f.y; w[q * 4 + 2] = f.z; w[q * 4 + 3] = f.w; }
        f32x2 o[8];
#pragma unroll
        for (int i = 0; i < 8; ++i) o[i] = (f32x2){0.f, 0.f};
#pragma unroll
        for (int t = 0; t < 16; ++t) {
          const f32x2 w2 = (f32x2){w[t], w[t]};
          const uint4 r = rv[0][t];
          unsigned ww[4] = {r.x, r.y, r.z, r.w};
#pragma unroll
          for (int q = 0; q < 4; ++q) {
            o[q * 2] += w2 * __builtin_amdgcn_cvt_pk_f32_fp8((int)ww[q], false);
            o[q * 2 + 1] += w2 * __builtin_amdgcn_cvt_pk_f32_fp8((int)ww[q], true);
          }
        }
        float of[16];
#pragma unroll
        for (int i = 0; i < 8; ++i) { of[2 * i] = o[i][0]; of[2 * i + 1] = o[i][1]; }
#pragma unroll
        for (int i = 0; i < 16; ++i) { of[i] += __shfl_xor(of[i], 8); of[i] += __shfl_xor(of[i], 16); of[i] += __shfl_xor(of[i], 32); }
        if (grp == 0 && (T0 + kk * Tstride) < ntok) {
#pragma unroll
          for (int i = 0; i < 16; ++i) of[i] *= (1.f / 256.f);
          bf16_t* d = P.pout + (size_t)Tk[kk] * 1024 + sl * 128 + j8 * 16;
          *(uint4*)d = pack8(of); *(uint4*)(d + 8) = pack8(of + 8);
        }
      }
    }
  }
}
__device__ __forceinline__ void ln2_token(const Params& P, int l, int T, int lane) {
  float* xw = (T < NLAT) ? P.out + (size_t)T * 1024 : P.xc + (size_t)(T - NLAT) * 1024;
  bf16_t* hw = P.Ybuf + (size_t)T * 1024;
  const float* m = P.mod + ((size_t)l * 17 + mod_row(T)) * 6144;
  const int d0 = lane * 16;
  float o[16];
  unpack8(*(const uint4*)(P.pout + (size_t)T * 1024 + d0), o); unpack8(*(const uint4*)(P.pout + (size_t)T * 1024 + d0 + 8), o + 8);
  float s = 0.f;
#pragma unroll
  for (int i = 0; i < 16; ++i) { o[i] = ALPHA * xw[d0 + i] + m[5120 + d0 + i] * o[i]; s += o[i]; }
  float mean = wave_sum(s) * (1.f / 1024.f);
  float q = 0.f;
#pragma unroll
  for (int i = 0; i < 16; ++i) { o[i] -= mean; q += o[i] * o[i]; }
  float rstd = rsqrtf(wave_sum(q) * (1.f / 1024.f) + LN_EPS);
  const float* mn = P.mod + ((size_t)(l + 1) * 17 + mod_row(T)) * 6144;
  float hh[16];
#pragma unroll
  for (int i = 0; i < 16; ++i) {
    float x2 = o[i] * rstd * P.ln2_g[l * 1024 + d0 + i] + P.ln2_b[l * 1024 + d0 + i];
    o[i] = x2;
    if (l == 0) hh[i] = x2 * (1.f + mn[1024 + d0 + i]) + mn[d0 + i];
  }
#pragma unroll
  for (int i = 0; i < 4; ++i) *(float4*)(xw + d0 + i * 4) = make_float4(o[i * 4], o[i * 4 + 1], o[i * 4 + 2], o[i * 4 + 3]);
  if (l == 0) { *(uint4*)(hw + d0) = pack8(hh); *(uint4*)(hw + d0 + 8) = pack8(hh + 8); }
}

__device__ __forceinline__ void peer_token(const Params& P, int l, int T, int lane, float* wl, const bool dry) {
  const int sub = lane >> 4, j16 = lane & 15;
  float h[64];
  {
    const bf16_t* hr = P.Ybuf + (size_t)T * 1024 + j16 * 16;
#pragma unroll
    for (int i = 0; i < 4; ++i) { unpack8(*(const uint4*)(hr + i * 256), h + i * 16); unpack8(*(const uint4*)(hr + i * 256 + 8), h + i * 16 + 8); }
  }
  const int* er = P.eidx + (size_t)T * 128;
  const float* gr = P.egate + (size_t)T * 128;
  const unsigned char* tu = (const unsigned char*)P.tabu;
  const unsigned char* tv = (const unsigned char*)P.tabv;
  for (int it = 0; it < 32; it += 2) {
    uint4 rv[2][4];
#pragma unroll
    for (int u2 = 0; u2 < 2; ++u2) {
      int e = er[(it + u2) * 4 + sub];
      const unsigned char* row = tu + (size_t)e * 1024 + j16 * 16;
#pragma unroll
      for (int i = 0; i < 4; ++i) rv[u2][i] = *(const uint4*)(row + i * 256);
    }
#pragma unroll
    for (int u2 = 0; u2 < 2; ++u2) {
      float acc = 0.f;
#pragma unroll
      for (int i = 0; i < 4; ++i) acc += dot16_fp8(rv[u2][i], h + i * 16);
      acc += __shfl_xor(acc, 1); acc += __shfl_xor(acc, 2); acc += __shfl_xor(acc, 4); acc += __shfl_xor(acc, 8);
      if (j16 == 0) wl[(it + u2) * 4 + sub] = gr[(it + u2) * 4 + sub] * gelu_tanh(acc * (1.f / 256.f));
    }
  }
  float o[16];
#pragma unroll
  for (int i = 0; i < 16; ++i) o[i] = 0.f;
  for (int e8 = 0; e8 < 128; e8 += 8) {
    uint4 rv[8];
    float w[8];
#pragma unroll
    for (int k = 0; k < 8; ++k) {
      int e = er[e8 + k];
      rv[k] = *(const uint4*)(tv + (size_t)e * 1024 + lane * 16);
      w[k] = wl[e8 + k];
    }
#pragma unroll
    for (int k = 0; k < 8; ++k) {
      unsigned ww[4] = {rv[k].x, rv[k].y, rv[k].z, rv[k].w};
#pragma unroll
      for (int q = 0; q < 4; ++q) {
        f32x2 lo = __builtin_amdgcn_cvt_pk_f32_fp8((int)ww[q], false);
        f32x2 hi = __builtin_amdgcn_cvt_pk_f32_fp8((int)ww[q], true);
        o[q * 4] += w[k] * lo[0]; o[q * 4 + 1] += w[k] * lo[1]; o[q * 4 + 2] += w[k] * hi[0]; o[q * 4 + 3] += w[k] * hi[1];
      }
    }
  }
  float* xw = (T < NLAT) ? P.out + (size_t)T * 1024 : P.xc + (size_t)(T - NLAT) * 1024;
  const float* xrd = xw;
  bf16_t* hw = P.Ybuf + (size_t)T * 1024;
  if (dry) { xw = (float*)P.uT + (size_t)(T & 2047) * 1024; hw = P.x0T + (size_t)(T & 2047) * 1024; }
  const float* m = P.mod + ((size_t)l * 17 + mod_row(T)) * 6144;
  const int d0 = lane * 16;
  float s = 0.f;
#pragma unroll
  for (int i = 0; i < 16; ++i) { o[i] = ALPHA * xrd[d0 + i] + m[5120 + d0 + i] * (o[i] * (1.f / 256.f)); s += o[i]; }
  float mean = wave_sum(s) * (1.f / 1024.f);
  float q = 0.f;
#pragma unroll
  for (int i = 0; i < 16; ++i) { o[i] -= mean; q += o[i] * o[i]; }
  float rstd = rsqrtf(wave_sum(q) * (1.f / 1024.f) + LN_EPS);
  const float* mn = P.mod + ((size_t)(l + 1) * 17 + mod_row(T)) * 6144;
  float hh[16];
#pragma unroll
  for (int i = 0; i < 16; ++i) {
    float x2 = o[i] * rstd * P.ln2_g[l * 1024 + d0 + i] + P.ln2_b[l * 1024 + d0 + i];
    o[i] = x2;
    if (l == 0) hh[i] = x2 * (1.f + mn[1024 + d0 + i]) + mn[d0 + i];
  }
#pragma unroll
  for (int i = 0; i < 4; ++i) *(float4*)(xw + d0 + i * 4) = make_float4(o[i * 4], o[i * 4 + 1], o[i * 4 + 2], o[i * 4 + 3]);
  if (l == 0) { *(uint4*)(hw + d0) = pack8(hh); *(uint4*)(hw + d0 + 8) = pack8(hh + 8); }
}

__device__ __forceinline__ void conf_task(const Params& P, int l, int tok_base, int len, int pos0, unsigned char* smem) {
  _Float16* u = (_Float16*)smem;
  const int c = tidx();
  __syncthreads();
  for (int i = 0; i < 94; ++i) {
    int pos = pos0 - 15 + i;
    float v = 0.f;
    if (pos >= 0 && pos < len) {
      const bf16_t* pr = P.Pbuf + (size_t)(tok_base + pos) * PST;
      v = bf2f(pr[c]) * sigmoidf_(bf2f(pr[256 + c]));
    }
    u[i * 256 + c] = (_Float16)v;
  }
  __syncthreads();
  float w[31];
#pragma unroll
  for (int j = 0; j < 31; ++j) w[j] = P.conf_dw_w[(l * 31 + j) * 256 + c];
  const float bias = P.conf_dw_b[l * 256 + c], ng = P.conf_norm_g[l * 256 + c], nb = P.conf_norm_b[l * 256 + c];
  for (int t = 0; t < 64; ++t) {
    float acc = bias;
#pragma unroll
    for (int j = 0; j < 31; ++j) acc += w[j] * (float)u[(t + j) * 256 + c];
    float mean = wave_sum(acc) * (1.f / 64.f);
    float d = acc - mean;
    float var = wave_sum(d * d) * (1.f / 64.f);
    float un = d * rsqrtf(var + LN_EPS) * ng + nb;
    P.Ybuf[(size_t)(tok_base + pos0 + t) * 1024 + c] = f2bf(siluf_(un));
  }
}

__device__ __forceinline__ void prep_task(const Params& P, int l, bool lat, int b, int pos0) {
  const int c = tidx();
  const int len = lat ? 2048 : 256;
  const int tok0 = lat ? b * 2048 + pos0 : NLAT + b * 256 + pos0;
  {
    bf16_t* dst = (lat ? P.vt_lat : P.vt_ctx) + ((size_t)b * 256 + c) * len + pos0;
    for (int t8 = 0; t8 < 8; ++t8) {
      unsigned wv[4];
#pragma unroll
      for (int k = 0; k < 4; ++k) {
        unsigned a = P.Pbuf[(size_t)(tok0 + t8 * 8 + k * 2) * PST + 1024 + c];
        unsigned bb = P.Pbuf[(size_t)(tok0 + t8 * 8 + k * 2 + 1) * PST + 1024 + c];
        wv[k] = a | (bb << 16);
      }
      *(uint4*)(dst + t8 * 8) = make_uint4(wv[0], wv[1], wv[2], wv[3]);
    }
  }
  if (lat) {
    const int hd = c & 63, i = hd & 31, hbase = c & ~63;
    const bool hi = hd >= 32;
    const int row = pos0 >> 6;
    const float* tc = P.ropetab; const float* ts = P.ropetab + 1024;
    for (int t = 0; t < 64; ++t) {
      const bf16_t* kr = P.Pbuf + (size_t)(tok0 + t) * PST + 768 + hbase;
      float x1 = bf2f(kr[i]), x2 = bf2f(kr[32 + i]);
      int pos = (i < 16) ? row : t;
      float cs = tc[pos * 16 + (i & 15)], sn = ts[pos * 16 + (i & 15)];
      float o = hi ? (x1 * sn + x2 * cs) : (x1 * cs - x2 * sn);
      P.krot[(size_t)(tok0 + t) * 256 + c] = f2bf(o);
    }
  }
  {
    float w[3][3], bsv[3];
#pragma unroll
    for (int q = 0; q < 3; ++q) {
      bsv[q] = P.hy_short_b[l * 768 + q * 256 + c];
#pragma unroll
      for (int k = 0; k < 3; ++k) w[q][k] = P.hy_short_w[(l * 3 + k) * 768 + q * 256 + c];
    }
    const size_t seqoff = lat ? ((size_t)b * 256 + c) * 2048 : (size_t)16 * 256 * 2048 + ((size_t)b * 256 + c) * 256;
    float pv[3], cu[3], nx[3];
#pragma unroll
    for (int q = 0; q < 3; ++q) {
      pv[q] = (pos0 > 0) ? bf2f(P.Pbuf[(size_t)(tok0 - 1) * PST + 1280 + q * 256 + c]) : 0.f;
      cu[q] = bf2f(P.Pbuf[(size_t)tok0 * PST + 1280 + q * 256 + c]);
    }
    for (int t8 = 0; t8 < 8; ++t8) {
      float uo[8], xo[8];
#pragma unroll
      for (int k = 0; k < 8; ++k) {
        int t = t8 * 8 + k;
        float r[3];
#pragma unroll
        for (int q = 0; q < 3; ++q) {
          nx[q] = (pos0 + t + 1 < len) ? bf2f(P.Pbuf[(size_t)(tok0 + t + 1) * PST + 1280 + q * 256 + c]) : 0.f;
          r[q] = w[q][0] * pv[q] + w[q][1] * cu[q] + w[q][2] * nx[q] + bsv[q];
          pv[q] = cu[q]; cu[q] = nx[q];
        }
        xo[k] = r[0]; uo[k] = r[2] * r[1];
      }
      *(uint4*)(P.uT + seqoff + pos0 + t8 * 8) = pack8(uo);
      *(uint4*)(P.x0T + seqoff + pos0 + t8 * 8) = pack8(xo);
    }
  }
}

__device__ __forceinline__ void hyfin_task(const Params& P, int l, bool lat, int b, int pos0) {
  const int c = tidx();
  const int tok0 = lat ? b * 2048 + pos0 : NLAT + b * 256 + pos0;
  const size_t seqoff = lat ? ((size_t)b * 256 + c) * 2048 : (size_t)16 * 256 * 2048 + ((size_t)b * 256 + c) * 256;
  const float skip = P.hy_bias[l * 256 + c];
  for (int t8 = 0; t8 < 8; ++t8) {
    float y[8], u[8], x0[8];
    unpack8(*(const uint4*)(P.yT + seqoff + pos0 + t8 * 8), y);
    unpack8(*(const uint4*)(P.uT + seqoff + pos0 + t8 * 8), u);
    unpack8(*(const uint4*)(P.x0T + seqoff + pos0 + t8 * 8), x0);
#pragma unroll
    for (int k = 0; k < 8; ++k)
      P.Ybuf[(size_t)(tok0 + t8 * 8 + k) * 1024 + 512 + c] = f2bf((y[k] + u[k] * skip) * x0[k]);
  }
}

__device__ __forceinline__ void hyconv_task(const Params& P, int l, bool lat, int c, int tb, unsigned char* smem) {
  const int L = lat ? 2048 : 256;
  unsigned* g = (unsigned*)smem;
  const int tid = tidx(), lane = tid & 63, wave = tid >> 6;
  __syncthreads();
  {
    const uint4* src = (const uint4*)gtab_ptr(P, l, lat ? 0 : 1, c);
    const int n16 = (4 * L * 2) / 16;
    for (int i = tid; i < n16; i += NTHREADS) ((uint4*)g)[i] = src[i];
  }
  __syncthreads();
  const int m = lane & 15, quad = lane >> 4;
  const size_t seqbase = lat ? 0 : (size_t)16 * 256 * 2048;
  bf16_t* ubuf = (bf16_t*)(smem + 4 * L * 2);
  const int pb0 = tid >> 5, pc0 = tid & 31;
  const bf16_t* ug0 = P.uT + seqbase + ((size_t)pb0 * 256 + c) * L + pc0 * 8;
  const bf16_t* ug1 = P.uT + seqbase + ((size_t)(pb0 + 8) * 256 + c) * L + pc0 * 8;
  const int t0 = tb + wave * 64;
  f32x4 acc[4];
#pragma unroll
  for (int i = 0; i < 4; ++i) acc[i] = (f32x4){0.f, 0.f, 0.f, 0.f};
  uint4 r0 = *(const uint4*)ug0, r1 = *(const uint4*)ug1;
  for (int s0 = 0; s0 < L; s0 += 256) {
    __syncthreads();
    *(uint4*)(ubuf + pb0 * 264 + pc0 * 8) = r0; *(uint4*)(ubuf + (pb0 + 8) * 264 + pc0 * 8) = r1;
    __syncthreads();
    if (s0 + 256 < L) { r0 = *(const uint4*)(ug0 + s0 + 256); r1 = *(const uint4*)(ug1 + s0 + 256); }
#pragma unroll
    for (int q = 0; q < 8; ++q) {
      const bf16x8 ufr = *(const bf16x8*)(ubuf + m * 264 + q * 32 + quad * 8);
#pragma unroll
      for (int i = 0; i < 4; ++i) {
        int o = (L - 1) + s0 + q * 32 - (t0 + i * 16) + quad * 8 - m;
        const unsigned* gp = g + (o & 1) * L + (o >> 1);
        uint4 tv = make_uint4(gp[0], gp[1], gp[2], gp[3]);
        acc[i] = mfma16(as_bf8(tv), ufr, acc[i]);
      }
    }
  }
  bf16_t* yb = P.yT + seqbase + ((size_t)m * 256 + c) * L;
#pragma unroll
  for (int i = 0; i < 4; ++i) {
    uint2 v; v.x = pack2(acc[i][0], acc[i][1]); v.y = pack2(acc[i][2], acc[i][3]);
    *(uint2*)(yb + t0 + i * 16 + quad * 4) = v;
  }
}

template <bool LOCAL>
__device__ __forceinline__ void attn_task(const Params& P, int l, int b, int r, int c0, int h, int lane) {
  const int n = lane & 15, quad = lane >> 4;
  const int qtok = LOCAL ? (b * 2048 + r * 64 + c0 + n) : (NLAT + b * 256 + c0 + n);
  const bf16_t* pq = P.Pbuf + (size_t)qtok * PST + 512 + h * 64 + quad * 8;
  const uint4 q0 = *(const uint4*)pq, q1 = *(const uint4*)(pq + 32);
  const bf16x8 qp0 = as_bf8(q0), qp1 = as_bf8(q1);
  bf16x8 qr0 = qp0, qr1 = qp1;
  const int rs = min(max(r - 4, 0), 24), kc0 = min(max(c0 - 8, 0), 32);
  const int cq = c0 + n, cs_ = min(max(cq - 8, 0), 48);
  const float* rpb = P.na_rpb + ((size_t)l * 4 + h) * 15 * 31;
  if (LOCAL) {
    float x1[8], x2[8], a[8], bq[8];
    unpack8(q0, x1); unpack8(q1, x2);
    const int pos = (quad < 2) ? r : (c0 + n);
    const float* tc = P.ropetab + pos * 16 + (quad & 1) * 8;
    const float* ts = tc + 1024;
#pragma unroll
    for (int j = 0; j < 8; ++j) { float cs = tc[j], sn = ts[j]; a[j] = x1[j] * cs - x2[j] * sn; bq[j] = x1[j] * sn + x2[j] * cs; }
    qr0 = as_bf8(pack8(a)); qr1 = as_bf8(pack8(bq));
  }
  auto local_scores = [&](int g) -> f32x4 {
    const int i = g >> 1, half = g & 1;
    const int ktok = b * 2048 + (rs + i) * 64 + kc0 + half * 16 + n;
    const bf16_t* kp = P.krot + (size_t)ktok * 256 + h * 64 + quad * 8;
    f32x4 acc = (f32x4){0.f, 0.f, 0.f, 0.f};
    acc = mfma16(*(const bf16x8*)kp, qr0, acc);
    acc = mfma16(*(const bf16x8*)(kp + 32), qr1, acc);
    const float* rb = rpb + (rs + i - r + 7) * 31;
    f32x4 o;
#pragma unroll
    for (int rr = 0; rr < 4; ++rr) {
      int kcol = kc0 + half * 16 + quad * 4 + rr;
      bool valid = (kcol >= cs_) && (kcol < cs_ + 16);
      int bi = min(max(kcol - cq + 15, 0), 30);
      o[rr] = valid ? (acc[rr] * 0.125f + rb[bi]) : -1e30f;
    }
    return o;
  };
  auto ctx_scores = [&](int g) -> f32x4 {
    const int ktok = NLAT + b * 256 + g * 16 + n;
    const bf16_t* kp = P.Pbuf + (size_t)ktok * PST + 768 + h * 64 + quad * 8;
    f32x4 acc = (f32x4){0.f, 0.f, 0.f, 0.f};
    acc = mfma16(*(const bf16x8*)kp, qp0, acc);
    acc = mfma16(*(const bf16x8*)(kp + 32), qp1, acc);
    return acc * 0.125f;
  };
  float mx = -1e30f, sum = 0.f;
  f32x4 O[4];
#pragma unroll
  for (int i = 0; i < 4; ++i) O[i] = (f32x4){0.f, 0.f, 0.f, 0.f};
  auto block = [&](const bool loc, const int sb) {
    f32x4 sc[8];
#pragma unroll
    for (int q = 0; q < 8; ++q) sc[q] = loc ? local_scores(sb * 8 + q) : ctx_scores(sb * 8 + q);
    float bm = -1e30f;
#pragma unroll
    for (int q = 0; q < 8; ++q) bm = fmaxf(bm, fmaxf(fmaxf(sc[q][0], sc[q][1]), fmaxf(sc[q][2], sc[q][3])));
    bm = fmaxf(bm, __shfl_xor(bm, 16)); bm = fmaxf(bm, __shfl_xor(bm, 32));
    const float mnew = fmaxf(mx, bm);
    const float scale = __expf(mx - mnew);
    mx = mnew; sum *= scale;
#pragma unroll
    for (int dt = 0; dt < 4; ++dt) O[dt] *= scale;
#pragma unroll
    for (int pr = 0; pr < 4; ++pr) {
      const int ip = sb * 4 + pr;
      float pa[4], pbv[4];
#pragma unroll
      for (int rr = 0; rr < 4; ++rr) { pa[rr] = __expf(sc[2 * pr][rr] - mx); pbv[rr] = __expf(sc[2 * pr + 1][rr] - mx); sum += pa[rr] + pbv[rr]; }
      uint4 pb; pb.x = pack2(pa[0], pa[1]); pb.y = pack2(pa[2], pa[3]); pb.z = pack2(pbv[0], pbv[1]); pb.w = pack2(pbv[2], pbv[3]);
#pragma unroll
      for (int dt = 0; dt < 4; ++dt) {
        const bf16_t* vp = loc ? P.vt_lat + ((size_t)(b * 4 + h) * 64 + dt * 16 + n) * 2048 + (rs + ip) * 64 + kc0 + quad * 4
                               : P.vt_ctx + ((size_t)(b * 4 + h) * 64 + dt * 16 + n) * 256 + ip * 32 + quad * 4;
        uint2 lo = *(const uint2*)vp, hi = *(const uint2*)(vp + 16);
        O[dt] = mfma16(as_bf8(make_uint4(lo.x, lo.y, hi.x, hi.y)), as_bf8(pb), O[dt]);
      }
    }
  };
  if (LOCAL) { block(true, 0); block(true, 1); }
  block(false, 0); block(false, 1);
  sum += __shfl_xor(sum, 16); sum += __shfl_xor(sum, 32);
  const float inv = 1.f / sum;
  bf16_t* yo = P.Ybuf + (size_t)qtok * 1024 + 256 + h * 64 + quad * 4;
#pragma unroll
  for (int dt = 0; dt < 4; ++dt) {
    uint2 v; v.x = pack2(O[dt][0] * inv, O[dt][1] * inv); v.y = pack2(O[dt][2] * inv, O[dt][3] * inv);
    *(uint2*)(yo + dt * 16) = v;
  }
}

template <bool PASS3>
__device__ __forceinline__ void ssd_task(const Params& P, int l, int b, int g, int ch, unsigned char* smem) {
  _Float16* xs = (_Float16*)smem;
  _Float16* Bs = xs + 64 * 128;
  _Float16* Cs = Bs + 64 * 64;
  float* dts = (float*)(Cs + 64 * 64);
  float* decs = dts + 256;
  float* as_ = decs + 256;
  _Float16* yt = (_Float16*)(as_ + 256);
  const int tid = tidx();
  const bool lat = ch >= 4;
  const int len = lat ? 2048 : 256;
  const int pos0 = lat ? (ch - 4) * 64 : ch * 64;
  const int tok0 = lat ? b * 2048 + pos0 : NLAT + b * 256 + pos0;
  __syncthreads();
  {
    const int col = (tid < 128) ? g * 128 + tid : (tid < 192 ? 256 + g * 64 + (tid - 128) : 384 + g * 64 + (tid - 192));
    const float w0 = P.ssd_conv_w[(l * 3 + 0) * 512 + col], w1 = P.ssd_conv_w[(l * 3 + 1) * 512 + col], w2 = P.ssd_conv_w[(l * 3 + 2) * 512 + col];
    const float bs = P.ssd_conv_b[l * 512 + col];
    const bf16_t* pp = P.Pbuf + (size_t)tok0 * PST + 2304 + col;
    float pv = (pos0 > 0) ? bf2f(pp[-(ptrdiff_t)PST]) : 0.f;
    float cu = bf2f(pp[0]);
    _Float16* dst = (tid < 128) ? xs + tid : (tid < 192 ? Bs + (tid - 128) : Cs + (tid - 192));
    const int dstride = (tid < 128) ? 128 : 64;
    for (int t = 0; t < 64; ++t) {
      float nx = (pos0 + t + 1 < len) ? bf2f(pp[(size_t)(t + 1) * PST]) : 0.f;
      float v = siluf_(w0 * pv + w1 * cu + w2 * nx + bs);
      dst[t * dstride] = (_Float16)v;
      pv = cu; cu = nx;
    }
    {
      const int t = tid >> 2, k = tid & 3, dir = k >> 1, hh = k & 1, head = g * 2 + hh;
      float raw = P.dtbuf[(size_t)(tok0 + t) * 8 + dir * 4 + head] + P.ssd_dt_bias[(l * 2 + dir) * 4 + head];
      float dtv = (raw > 20.f) ? raw : log1pf(expf(raw));
      float a = -dtv * expf(P.ssd_a_log[(l * 2 + dir) * 4 + head]);
      dts[tid] = dtv; as_[tid] = a; decs[tid] = expf(a);
    }
    if (PASS3) for (int i = tid; i < 64 * 128; i += NTHREADS) yt[i] = (_Float16)0.f;
  }
  __syncthreads();
  const int hh = tid >> 7, p = (tid >> 1) & 63, nh = tid & 1;
  const int head = g * 2 + hh;
  float stf[32], stb[32];
  float* sf = P.sst + ((((size_t)b * 2 + 0) * 4 + head) * NCH + ch) * 4096 + p * 64 + nh * 32;
  float* sb = P.sst + ((((size_t)b * 2 + 1) * 4 + head) * NCH + ch) * 4096 + p * 64 + nh * 32;
  if (PASS3) {
#pragma unroll
    for (int i = 0; i < 8; ++i) {
      float4 a = *(const float4*)(sf + i * 4); stf[i * 4] = a.x; stf[i * 4 + 1] = a.y; stf[i * 4 + 2] = a.z; stf[i * 4 + 3] = a.w;
      float4 c = *(const float4*)(sb + i * 4); stb[i * 4] = c.x; stb[i * 4 + 1] = c.y; stb[i * 4 + 2] = c.z; stb[i * 4 + 3] = c.w;
    }
  } else {
#pragma unroll
    for (int i = 0; i < 32; ++i) { stf[i] = 0.f; stb[i] = 0.f; }
  }
  for (int k = 0; k < 64; ++k) {
    {
      const float dtv = dts[k * 4 + hh], dec = decs[k * 4 + hh];
      const float xd = (float)xs[k * 128 + hh * 64 + p] * dtv;
      const _Float16* br = Bs + k * 64 + nh * 32;
#pragma unroll
      for (int i = 0; i < 32; ++i) stf[i] = stf[i] * dec + xd * (float)br[i];
      if (PASS3) {
        const _Float16* cr = Cs + k * 64 + nh * 32;
        float y0 = 0.f, y1 = 0.f, y2 = 0.f, y3 = 0.f;
#pragma unroll
        for (int i = 0; i < 32; i += 4) { y0 += stf[i] * (float)cr[i]; y1 += stf[i + 1] * (float)cr[i + 1]; y2 += stf[i + 2] * (float)cr[i + 2]; y3 += stf[i + 3] * (float)cr[i + 3]; }
        float y = (y0 + y1) + (y2 + y3);
        y += __shfl_xor(y, 1);
        if (nh == 0) { _Float16* yp = yt + k * 128 + hh * 64 + p; *yp = (_Float16)((float)*yp + y); }
      }
    }
    {
      const int kk = 63 - k;
      const float dtv = dts[kk * 4 + 2 + hh], dec = decs[kk * 4 + 2 + hh];
      const float xd = (float)xs[kk * 128 + hh * 64 + p] * dtv;
      const _Float16* br = Bs + kk * 64 + nh * 32;
#pragma unroll
      for (int i = 0; i < 32; ++i) stb[i] = stb[i] * dec + xd * (float)br[i];
      if (PASS3) {
        const _Float16* cr = Cs + kk * 64 + nh * 32;
        float y0 = 0.f, y1 = 0.f, y2 = 0.f, y3 = 0.f;
#pragma unroll
        for (int i = 0; i < 32; i += 4) { y0 += stb[i] * (float)cr[i]; y1 += stb[i + 1] * (float)cr[i + 1]; y2 += stb[i + 2] * (float)cr[i + 2]; y3 += stb[i + 3] * (float)cr[i + 3]; }
        float y = (y0 + y1) + (y2 + y3);
        y += __shfl_xor(y, 1);
        if (nh == 0) { _Float16* yp = yt + kk * 128 + hh * 64 + p; *yp = (_Float16)((float)*yp + y); }
      }
    }
  }
  if (!PASS3) {
#pragma unroll
    for (int i = 0; i < 8; ++i) {
      *(float4*)(sf + i * 4) = make_float4(stf[i * 4], stf[i * 4 + 1], stf[i * 4 + 2], stf[i * 4 + 3]);
      *(float4*)(sb + i * 4) = make_float4(stb[i * 4], stb[i * 4 + 1], stb[i * 4 + 2], stb[i * 4 + 3]);
    }
    if (tid < 4) {
      const int dir = tid >> 1, h2 = tid & 1;
      float a = 0.f;
      for (int t = 0; t < 64; ++t) a += as_[t * 4 + tid];
      P.ssumA[(((size_t)b * 2 + dir) * 4 + g * 2 + h2) * NCH + ch] = a;
    }
  } else {
    __syncthreads();
    const int t = tid >> 2, part = tid & 3;
    const int hd = g * 2 + (part >> 1);
    const float dsk = P.ssd_d[l * 4 + hd];
    float val[32];
    float sq = 0.f;
    const bf16_t* zr = P.Pbuf + (size_t)(tok0 + t) * PST + 2048 + g * 128 + part * 32;
#pragma unroll
    for (int i = 0; i < 32; ++i) {
      int cc = part * 32 + i;
      float y = (float)yt[t * 128 + cc] + (float)xs[t * 128 + cc] * dsk;
      float z = bf2f(zr[i]);
      y *= siluf_(z);
      val[i] = y; sq += y * y;
    }
    sq += __shfl_xor(sq, 1); sq += __shfl_xor(sq, 2);
    const float rinv = rsqrtf(sq * (1.f / 128.f) + LN_EPS);
    bf16_t* yo = P.Ybuf + (size_t)(tok0 + t) * 1024 + 768 + g * 128 + part * 32;
    const float* ngp = P.ssd_norm_g + l * 256 + g * 128 + part * 32;
#pragma unroll
    for (int i8 = 0; i8 < 4; ++i8) {
      float f[8];
#pragma unroll
      for (int j = 0; j < 8; ++j) f[j] = val[i8 * 8 + j] * rinv * ngp[i8 * 8 + j];
      *(uint4*)(yo + i8 * 8) = pack8(f);
    }
  }
}

__device__ __forceinline__ void ssd_prefix_task(const Params& P, int bdh, int part) {
  const int dir = (bdh >> 2) & 1;
  float* base = P.sst + (size_t)bdh * NCH * 4096 + part * 256 + tidx();
  const float* sa = P.ssumA + (size_t)bdh * NCH;
  float carry = 0.f;
  for (int i = 0; i < NCH; ++i) {
    int ch = dir ? (i < 4 ? 3 - i : 39 - i) : i;
    float loc = base[(size_t)ch * 4096];
    base[(size_t)ch * 4096] = carry;
    carry = expf(sa[ch]) * carry + loc;
  }
}

__device__ __forceinline__ int f2key(float f) { int b = __float_as_int(f); return b ^ ((b >> 31) & 0x7FFFFFFF); }
__device__ __forceinline__ float key2f(int k) { return __int_as_float(k ^ ((k >> 31) & 0x7FFFFFFF)); }
#define CE_DESC(a, b) { int _x = max(a, b); int _y = min(a, b); a = _x; b = _y; }
#define CE_ASC(a, b) { int _x = min(a, b); int _y = max(a, b); a = _x; b = _y; }
__device__ __forceinline__ void sort16_desc(int* a) {
#pragma unroll
  for (int k = 2; k <= 16; k <<= 1)
#pragma unroll
    for (int j = k >> 1; j > 0; j >>= 1)
#pragma unroll
      for (int i = 0; i < 16; ++i) {
        int lq = i ^ j;
        if (lq > i) { if ((i & k) == 0) CE_DESC(a[i], a[lq]) else CE_ASC(a[i], a[lq]) }
      }
}
__device__ __forceinline__ void merge16_desc(int* a, const int* b) {
#pragma unroll
  for (int i = 0; i < 16; ++i) a[i] = max(a[i], b[15 - i]);
#pragma unroll
  for (int j = 8; j > 0; j >>= 1)
#pragma unroll
    for (int i = 0; i < 16; ++i) {
      int lq = i ^ j;
      if (lq > i) CE_DESC(a[i], a[lq])
    }
}

__device__ __forceinline__ void gemm_acc32(const bf16_t* __restrict__ A, int lda, const bf16_t* __restrict__ Bt, int ldb,
                                           int K, int m0, int n0, unsigned char* smem, f32x4 (&acc)[4][4]) {
  bf16_t* As = (bf16_t*)smem;
  bf16_t* Bs = As + 2 * 128 * 40;
  const int tid = tidx(), lane = tid & 63, wave = tid >> 6;
  const int wm = wave >> 1, wn = wave & 1;
  const int lr = tid >> 1, lh = tid & 1;
  const bf16_t* ag = A + (size_t)(m0 + lr) * lda + lh * 16;
  const bf16_t* bg = Bt + (size_t)(n0 + lr) * ldb + lh * 16;
#pragma unroll
  for (int i = 0; i < 4; ++i)
#pragma unroll
    for (int j = 0; j < 4; ++j) acc[i][j] = (f32x4){0.f, 0.f, 0.f, 0.f};
  uint4 ra0 = *(const uint4*)ag, ra1 = *(const uint4*)(ag + 8);
  uint4 rb0 = *(const uint4*)bg, rb1 = *(const uint4*)(bg + 8);
  __syncthreads();
  {
    bf16_t* pa = As + lr * 40 + lh * 16; bf16_t* pb = Bs + lr * 40 + lh * 16;
    *(uint4*)pa = ra0; *(uint4*)(pa + 8) = ra1; *(uint4*)pb = rb0; *(uint4*)(pb + 8) = rb1;
  }
  __syncthreads();
  const int nk = K >> 5;
  for (int kt = 0; kt < nk; ++kt) {
    const int cur = kt & 1;
    if (kt + 1 < nk) {
      const bf16_t* a2 = ag + (kt + 1) * 32; const bf16_t* b2 = bg + (kt + 1) * 32;
      ra0 = *(const uint4*)a2; ra1 = *(const uint4*)(a2 + 8); rb0 = *(const uint4*)b2; rb1 = *(const uint4*)(b2 + 8);
    }
    const bf16_t* as = As + cur * 5120 + (wm * 64 + (lane & 15)) * 40 + (lane >> 4) * 8;
    const bf16_t* bs = Bs + cur * 5120 + (wn * 64 + (lane & 15)) * 40 + (lane >> 4) * 8;
    bf16x8 afr[4];
#pragma unroll
    for (int j = 0; j < 4; ++j) afr[j] = *(const bf16x8*)(bs + j * 16 * 40);
#pragma unroll
    for (int i = 0; i < 4; ++i) {
      const bf16x8 bfr = *(const bf16x8*)(as + i * 16 * 40);
#pragma unroll
      for (int j = 0; j < 4; ++j) acc[i][j] = mfma16(afr[j], bfr, acc[i][j]);
    }
    if (kt + 1 < nk) {
      bf16_t* pa = As + (cur ^ 1) * 5120 + lr * 40 + lh * 16; bf16_t* pb = Bs + (cur ^ 1) * 5120 + lr * 40 + lh * 16;
      *(uint4*)pa = ra0; *(uint4*)(pa + 8) = ra1; *(uint4*)pb = rb0; *(uint4*)(pb + 8) = rb1;
    }
    __syncthreads();
  }
}

__device__ __forceinline__ void peer_topk_task(const Params& P, int l, int tm, int h, unsigned char* smem) {
  float* sc = (float*)smem;
  int* fin = (int*)(smem + 33280);
  const int tid = tidx(), lane = tid & 63, wave = tid >> 6;
  const int wm = wave >> 1, wn = wave & 1;
  const int row64 = tid & 63, quarter = tid >> 6;
  int* K1 = (int*)(smem + 40960);
  int* K2a = (int*)(smem + 49152);
#pragma unroll
  for (int pp = 0; pp < 2; ++pp) {
    const bf16_t* A = P.qbuf + (h * 2 + pp) * 128;
    const bf16_t* Bt = P.keysb + ((size_t)(l * 8 + h) * 2 + pp) * 128 * 128;
#pragma unroll 1
    for (int half = 0; half < 2; ++half) {
      {
        f32x4 acc[4][4];
        gemm_acc32(A, 2048, Bt, 128, 128, tm * 128, 0, smem, acc);
        if (wm == half) {
#pragma unroll
          for (int i = 0; i < 4; ++i)
#pragma unroll
            for (int j = 0; j < 4; ++j) {
              float* d = sc + (i * 16 + (lane & 15)) * 129 + wn * 64 + j * 16 + (lane >> 4) * 4;
              d[0] = acc[i][j][0]; d[1] = acc[i][j][1]; d[2] = acc[i][j][2]; d[3] = acc[i][j][3];
            }
        }
      }
      __syncthreads();
      int run[16];
#pragma unroll
      for (int i = 0; i < 16; ++i) run[i] = (int)0x80000000;
#pragma unroll 1
      for (int grp = 0; grp < 2; ++grp) {
        int cur[16];
#pragma unroll
        for (int i = 0; i < 16; ++i) {
          int col = quarter * 32 + grp * 16 + i;
          cur[i] = (f2key(sc[row64 * 129 + col]) & ~127) | col;
        }
        sort16_desc(cur);
        merge16_desc(run, cur);
      }
      if (quarter != 0) {
#pragma unroll
        for (int i = 0; i < 16; ++i) sc[row64 * 129 + quarter * 32 + i] = __int_as_float(run[i]);
      }
      __syncthreads();
      if (quarter == 0) {
#pragma unroll 1
        for (int q = 1; q < 4; ++q) {
          int oth[16];
#pragma unroll
          for (int i = 0; i < 16; ++i) oth[i] = __float_as_int(sc[row64 * 129 + q * 32 + i]);
          merge16_desc(run, oth);
        }
        if (half == 0) {
#pragma unroll
          for (int i = 0; i < 16; ++i) { if (pp == 0) K1[row64 * 16 + i] = run[i]; else K2a[row64 * 16 + i] = run[i]; }
        } else {
#pragma unroll
          for (int i = 0; i < 16; ++i) fin[row64 * 16 + i] = run[i];
        }
      }
      __syncthreads();
    }
    if (pp == 0 && tid >= 64 && tid < 128) {
#pragma unroll
      for (int i = 0; i < 16; ++i) K1[tid * 16 + i] = fin[(tid - 64) * 16 + i];
    }
    __syncthreads();
  }
  const int row = tid & 127, half = tid >> 7;
  int* lists = (int*)smem;
  if (half == 0) {
#pragma unroll
    for (int i = 0; i < 16; ++i) { lists[row * 33 + i] = K1[row * 16 + i]; lists[row * 33 + 16 + i] = (row < 64) ? K2a[row * 16 + i] : fin[(row - 64) * 16 + i]; }
  }
  if (half == 0) {
    float v2[16];
#pragma unroll
    for (int i = 0; i < 16; ++i) v2[i] = key2f(lists[row * 33 + 16 + i] & ~127);
    int run[16];
    {
      const float v0 = key2f(lists[row * 33] & ~127);
#pragma unroll
      for (int j = 0; j < 16; ++j) run[j] = (f2key(v0 + v2[j]) & ~255) | (15 - j);
    }
#pragma unroll 1
    for (int i = 1; i < 16; ++i) {
      int cur[16];
      const float vi = key2f(lists[row * 33 + i] & ~127);
#pragma unroll
      for (int j = 0; j < 16; ++j) cur[j] = (f2key(vi + v2[j]) & ~255) | (i * 16 + 15 - j);
      merge16_desc(run, cur);
    }
    const float c0 = key2f(run[0] & ~255);
    float sum = 0.f;
#pragma unroll
    for (int k = 0; k < 16; ++k) sum += __expf(key2f(run[k] & ~255) - c0);
    const float inv = 1.f / sum;
    const int T = tm * 128 + row;
    int* eo = P.eidx + (size_t)T * 128 + h * 16;
    float* go = P.egate + (size_t)T * 128 + h * 16;
#pragma unroll
    for (int k = 0; k < 16; ++k) {
      int ci = run[k] & 255;
      int i = ci >> 4, j = 15 - (ci & 15);
      int i1 = lists[row * 33 + i] & 127, i2 = lists[row * 33 + 16 + j] & 127;
      eo[k] = i1 * 128 + i2;
      go[k] = __expf(key2f(run[k] & ~255) - c0) * inv;
    }
  }
}

#define XB_TMO      128
#define XB_XCNT(j)  (256  + 64 * (j))
#define XB_XSUB(j)  (1280 + 64 * (j))
#define XB_XGEN(j)  (2304 + 64 * (j))
#define XB_TOP      3328
#define XB_TOPGEN   3392
#define XCD_BAR_WORDS 3456
#define XB_SPIN_CAP (1u << 18)
#define LAS __attribute__((address_space(3)))

__device__ __forceinline__ unsigned xb_ld(unsigned* p)              { return __hip_atomic_load(p, __ATOMIC_RELAXED, __HIP_MEMORY_SCOPE_AGENT); }
__device__ __forceinline__ unsigned xb_add(unsigned* p, unsigned v) { return __hip_atomic_fetch_add(p, v, __ATOMIC_RELAXED, __HIP_MEMORY_SCOPE_AGENT); }
__device__ __forceinline__ unsigned xb_xcc_id() { return (unsigned)__builtin_amdgcn_s_getreg((3 << 11) | 20) & 0xFu; }
#define XB_SPIN(cond, bar) do { unsigned _sp = 0; while (cond) { __builtin_amdgcn_s_sleep(1); \
    if ((++_sp & 255u) == 0u) { if (xb_ld(&(bar)[XB_TMO])) break; if (_sp > XB_SPIN_CAP) { atomicAdd(&(bar)[XB_TMO], 1u); break; } } } } while (0)

struct XcdBarrier {
    unsigned* bar; unsigned x;
    volatile LAS unsigned* st;
};

__device__ __forceinline__ XcdBarrier xcd_barrier_post(unsigned* bar, volatile LAS unsigned* st) {
    XcdBarrier b; b.bar = bar; b.x = xb_xcc_id(); b.st = st;
    if (threadIdx.x == 0) (void)xb_add(&bar[XB_XCNT(b.x)], 1u);
    return b;
}
__device__ __forceinline__ void xcd_barrier_complete(unsigned* bar, unsigned x, unsigned& nloc, unsigned& nx) {
    const unsigned G = gridDim.x * gridDim.y * gridDim.z;
    unsigned sum, cnt, mine, sp = 0u;
    for (;;) {
        sum = 0u; cnt = 0u; mine = 0u;
#pragma unroll
        for (unsigned j = 0; j < 16; ++j) { const unsigned c = xb_ld(&bar[XB_XCNT(j)]); sum += c; cnt += (c > 0u) ? 1u : 0u; mine = (j == x) ? c : mine; }
        if (sum == G) break;
        __builtin_amdgcn_s_sleep(1);
        if ((++sp & 255u) == 0u) { if (xb_ld(&bar[XB_TMO])) break; if (sp > XB_SPIN_CAP) { atomicAdd(&bar[XB_TMO], 1u); break; } }
    }
    nloc = mine > 0u ? mine : 1u; nx = cnt > 0u ? cnt : 1u;
}

__device__ __forceinline__ void xcd_barrier(const XcdBarrier& b) {
    asm volatile("s_waitcnt vmcnt(0)" ::: "memory");
    __syncthreads();
    if (threadIdx.x == 0) {
        unsigned* bar = b.bar;
        __builtin_amdgcn_s_waitcnt(0);
        unsigned nloc = b.st[0], nx = b.st[1];
        if (nloc == 0u) { xcd_barrier_complete(bar, b.x, nloc, nx); b.st[0] = nloc; b.st[1] = nx; }
        const unsigned old = xb_add(&bar[XB_XSUB(b.x)], 1u);
        const unsigned gen = old / nloc;
        if (old + 1u == (gen + 1u) * nloc) {
            __builtin_amdgcn_fence(__ATOMIC_RELEASE, "agent");
            asm volatile("s_waitcnt vmcnt(0)" ::: "memory");
            const unsigned og = xb_add(&bar[XB_TOP], 1u);
            const unsigned tg = og / nx;
            if (og + 1u == (tg + 1u) * nx) xb_add(&bar[XB_TOPGEN], 1u);
            else XB_SPIN(xb_ld(&bar[XB_TOPGEN]) == tg, bar);
            __builtin_amdgcn_fence(__ATOMIC_ACQUIRE, "agent");
            xb_add(&bar[XB_XGEN(b.x)], 1u);
            asm volatile("s_waitcnt vmcnt(0)" ::: "memory");
        } else {
            XB_SPIN(xb_ld(&bar[XB_XGEN(b.x)]) == gen, bar);
            __builtin_amdgcn_fence(__ATOMIC_ACQUIRE, "agent");
            asm volatile("s_waitcnt vmcnt(0)" ::: "memory");
        }
    }
    __syncthreads();
}


__device__ __forceinline__ int next_task(unsigned* cnt, int* slot) {
  __syncthreads();
  if (tidx() == 0) *slot = (int)__hip_atomic_fetch_add(cnt, 1u, __ATOMIC_RELAXED, __HIP_MEMORY_SCOPE_AGENT);
  __syncthreads();
  return *slot;
}
enum { PH_PRE0 = 0, PH_PRE1, PH_PRE2, PH_L1, PH_L2, PH_L3, PH_L4, PH_L5, PH_L6, PH_L7, PH_L8, PH_L9, PH_L9W, PH_L9B, PH_L9C, PH_COUNT };
struct XInfo { int slot, nx, rank, nloc; };
#define QCNT(i) (XCD_BAR_WORDS + 16 * 64 + 64 * (i))

template <int ph>
__device__ __forceinline__ void run_phase(const Params& P, const XInfo& X, int l, unsigned char* smem, const bool rep = false) {
  const int nb = gridDim.x, bid = blockIdx.x, tid = tidx(), lane = tid & 63, wave = tid >> 6;
  const int rbid = nb - 1 - bid;
  __shared__ int sQ;
  const int ntok = (l == 0) ? NTOK : NLAT;
  const int mt_out = ntok / 128;
  switch (ph) {
    case PH_PRE0: {
      for (int u = bid; u < 768; u += nb) modpart_task(P, u / 384, (u / 24) % 16, u % 24, smem);
      for (int u = rbid; u < 2 * 46 * 16; u += nb) { int ll = u / 736, r = u % 736; transpose_task(P.w_in + (size_t)ll * 1024 * 2824, P.wt_in + (size_t)ll * 2944 * 1024, 1024, 2824, (r % 16) * 64, (r / 16) * 64, smem); }
      for (int u = bid; u < 2 * 16 * 16; u += nb) { int ll = u / 256, r = u % 256; transpose_task(P.w_out + (size_t)ll * 1024 * 1024, P.wt_out + (size_t)ll * 1024 * 1024, 1024, 1024, (r % 16) * 64, (r / 16) * 64, smem); }
      for (int u = rbid; u < 2 * 32 * 16; u += nb) { int ll = u / 512, r = u % 512; transpose_task(P.peer_wq + (size_t)ll * 1024 * 2048, P.wt_q + (size_t)ll * 2048 * 1024, 1024, 2048, (r % 16) * 64, (r / 16) * 64, smem); }
      for (int u = bid; u < 256; u += nb) {
        size_t o = ((size_t)u * 256 + tid) * 8; float f[8];
#pragma unroll
        for (int j = 0; j < 8; ++j) f[j] = P.peer_keys[o + j];
        *(uint4*)(P.keysb + o) = pack8(f);
      }
      for (int u = rbid; u < 2 * 576; u += nb) { int ll = u / 576, r = u % 576; if (r < 512) hm2_task(P, ll, 0, r, smem); else hm2_task(P, ll, 1, r - 512, smem); }
      if (bid == nb - 1) {
        for (int i = tid; i < 1024; i += NTHREADS) {
          int pos = i >> 4, f = i & 15;
          float inv = powf(10000.f, -(float)f / 16.f);
          float ang = (float)pos * inv;
          P.ropetab[i] = cosf(ang); P.ropetab[1024 + i] = sinf(ang);
        }
      }
    } break;
    case PH_PRE1: {
      for (int t = bid; t < 816; t += nb) {
        int i = t * 256 + tid;
        int ll = i / (17 * 6144), rem = i % (17 * 6144), col = rem % 6144;
        float a = P.b_ada[ll * 6144 + col];
#pragma unroll
        for (int ks = 0; ks < 16; ++ks) a += P.modp[((size_t)ll * 16 + ks) * 17 * 6144 + rem];
        P.mod[i] = a;
      }
      for (int u = rbid; u < 2048; u += nb) filt_task(P, u >> 10, (u >> 9) & 1, u & 511, smem);
    } break;
    case PH_PRE2: {
      for (int T = bid * 4 + wave; T < NTOK; T += nb * 4) hmod0_token(P, T, lane);
    } break;
    case PH_L1: {
      const int ntile = (NTOK / 128) * 23;
      bf16_t* Pb = P.Pbuf; float* dtb = P.dtbuf;
      const bf16_t* Ain = P.Ybuf; const bf16_t* Win = P.wt_in + (size_t)l * 2944 * 1024;
      for (int t = bid; t < ntile; t += nb) {
        int tm = t / 23, tn = t % 23;
        gemm_tile32(Ain, 1024, Win, 1024, 1024, tm * 128, tn * 128, smem, [&](int m, int n, f32x4 v) {
          if (n < 2816) { uint2 o; o.x = pack2(v[0], v[1]); o.y = pack2(v[2], v[3]); *(uint2*)(Pb + (size_t)m * PST + n) = o; }
          else if (n < 2824) { *(float4*)(dtb + (size_t)m * 8 + (n - 2816)) = make_float4(v[0], v[1], v[2], v[3]); }
        });
      }
    } break;
    case PH_L2: {
      const int nS = NB * 2 * NCH, nCf = 512 + (l == 0 ? 64 : 0), nPr = 576;
      unsigned* cnt = P.bar + QCNT(l * 3 + 0);
      for (;;) {
        int u = next_task(cnt, &sQ);
        if (u >= nS + nCf + nPr) break;
        if (u < nS) { ssd_task<false>(P, l, u / (2 * NCH), (u / NCH) & 1, u % NCH, smem); continue; }
        u -= nS;
        if (u < nCf) { if (u < 512) conf_task(P, l, (u >> 5) * 2048, 2048, (u & 31) * 64, smem); else { int v = u - 512; conf_task(P, l, NLAT + (v >> 2) * 256, 256, (v & 3) * 64, smem); } continue; }
        u -= nCf;
        if (u < 512) prep_task(P, l, true, u >> 5, (u & 31) * 64); else { int v = u - 512; prep_task(P, l, false, v >> 2, (v & 3) * 64); }
      }
    } break;
    case PH_L3: {
      const int nH = 2048 + (l == 0 ? 256 : 0), nA = 2048, nAc = (l == 0 ? 256 : 0), nPf = rep ? 0 : 2048;
      unsigned* cnt = P.bar + QCNT(l * 3 + 1);
      for (;;) {
        int u = next_task(cnt, &sQ);
        if (u >= nH + nA + nAc + nPf) break;
        if (u < nH) { if (u < 2048) hyconv_task(P, l, true, u >> 3, (u & 7) * 256, smem); else hyconv_task(P, l, false, u - 2048, 0, smem); continue; }
        u -= nH;
        if (u < nA) { int b = u >> 7, r = (u >> 2) & 31, c0 = (u & 3) * 16; attn_task<true>(P, l, b, r, c0, wave, lane); continue; }
        u -= nA;
        if (u < nAc) { attn_task<false>(P, l, u >> 4, 0, (u & 15) * 16, wave, lane); continue; }
        u -= nAc;
        ssd_prefix_task(P, u >> 4, u & 15);
      }
    } break;
    case PH_L4: {
      const int nS = (l == 0) ? NB * 2 * NCH : NB * 2 * 32, nHf = 512 + (l == 0 ? 64 : 0);
      unsigned* cnt = P.bar + QCNT(l * 3 + 2);
      for (;;) {
        int u = next_task(cnt, &sQ);
        if (u >= nS + nHf) break;
        if (u < nS) {
          if (l == 0) ssd_task<true>(P, l, u / (2 * NCH), (u / NCH) & 1, u % NCH, smem);
          else ssd_task<true>(P, l, u / 64, (u / 32) & 1, 4 + (u % 32), smem);
          continue;
        }
        u -= nS;
        if (u < 512) hyfin_task(P, l, true, u >> 5, (u & 31) * 64); else { int v = u - 512; hyfin_task(P, l, false, v >> 2, (v & 3) * 64); }
      }
    } break;
    case PH_L5: {
      const int ng = mt_out * 8;
      bf16_t* Yo = P.Pbuf;
      const bf16_t* Ain = P.Ybuf; const bf16_t* Wt = P.wt_out + (size_t)l * 1024 * 1024;
      for (int t = bid; t < ng; t += nb) {
        int tm = t >> 3, tn = t & 7;
        gemm_tile32(Ain, 1024, Wt, 1024, 1024, tm * 128, tn * 128, smem, [&](int m, int n, f32x4 v) {
          uint2 o; o.x = pack2(v[0], v[1]); o.y = pack2(v[2], v[3]); *(uint2*)(Yo + (size_t)m * 1024 + n) = o;
        });
      }
      for (int u = rbid; u < 4096; u += nb) {
        const bool isv = u >= 2048;
        const int e0 = (u & 2047) * 8;
        const float* src = (isv ? P.peer_v : P.peer_u) + (size_t)l * 16384 * 1024 + (size_t)e0 * 1024;
        unsigned char* dstb = (unsigned char*)(isv ? P.tabv : P.tabu);
#pragma unroll
        for (int i = 0; i < 2; ++i) {
          int o = (i * 256 + tid) * 16;
          float4 a = *(const float4*)(src + o), bq = *(const float4*)(src + o + 4), c = *(const float4*)(src + o + 8), d = *(const float4*)(src + o + 12);
          uint4 r;
          r.x = pack4_fp8(a.x * 256.f, a.y * 256.f, a.z * 256.f, a.w * 256.f);
          r.y = pack4_fp8(bq.x * 256.f, bq.y * 256.f, bq.z * 256.f, bq.w * 256.f);
          r.z = pack4_fp8(c.x * 256.f, c.y * 256.f, c.z * 256.f, c.w * 256.f);
          r.w = pack4_fp8(d.x * 256.f, d.y * 256.f, d.z * 256.f, d.w * 256.f);
          *(uint4*)(dstb + (size_t)e0 * 1024 + o) = r;
        }
      }
    } break;
    case PH_L6: {
      for (int T = bid * 4 + wave; T < ntok; T += nb * 4) r1_token(P, l, T, lane, rep);
    } break;
    case PH_L7: {
      const int ng = mt_out * 16;
      bf16_t* Q = P.qbuf;
      for (int t = bid; t < ng; t += nb) {
        int tm = t >> 4, tn = t & 15;
        gemm_tile32(P.Ybuf, 1024, P.wt_q + (size_t)l * 2048 * 1024, 1024, 1024, tm * 128, tn * 128, smem, [&](int m, int n, f32x4 v) {
          uint2 o; o.x = pack2(v[0], v[1]); o.y = pack2(v[2], v[3]); *(uint2*)(Q + (size_t)m * 2048 + n) = o;
        });
      }
    } break;
    case PH_L8: {
      const int ng = mt_out * 8;
      for (int t = bid; t < ng; t += nb) peer_topk_task(P, l, t >> 3, t & 7, smem);
    } break;
    case PH_L9: {
      float* wl = (float*)smem + wave * 128;
      __syncthreads();
      for (int T0 = bid * 4 + wave; T0 < ntok; T0 += nb * 4) { const int T = __builtin_amdgcn_readfirstlane(T0); peer_token(P, l, T, lane, wl, false); }
    } break;
    case PH_L9W: {
      const size_t n = (size_t)ntok * 128;
      for (size_t i = (size_t)bid * 256 + tid; i < n; i += (size_t)nb * 256) {
        float a = 0.f;
#pragma unroll
        for (int x = 0; x < 8; ++x) a += P.pact[(size_t)x * NTOK * 128 + i];
        P.egate[i] = P.egate[i] * gelu_tanh(a * (1.f / 256.f));
      }
    } break;
    case PH_L9B: {
      int* li = (int*)smem + wave * 1024;
      __syncthreads();
      for (int sl = X.slot; sl < 8; sl += X.nx)
        { const int pw = (ntok + X.nloc * 4 - 1) / (X.nloc * 4); const int tf = __builtin_amdgcn_readfirstlane((X.rank * 4 + wave) * pw); peer_v_phase(P, sl, tf, 1, min(ntok, tf + pw), lane, li); }
    } break;
    case PH_L9C: {
      for (int T0 = bid * 4 + wave; T0 < ntok; T0 += nb * 4) { const int T = __builtin_amdgcn_readfirstlane(T0); ln2_token(P, l, T, lane); }
    } break;
  }
}

#if MULTI_LAUNCH
__global__ void __launch_bounds__(NTHREADS) phase_kernel(Params P, int ph, int l) {
  extern __shared__ __attribute__((aligned(16))) unsigned char smem[];
  __shared__ Params sP;
  if (threadIdx.x == 0) sP = P;
  __syncthreads();
  switch (ph) {
    case 0: run_phase<0>(sP, sX, l, smem); break; case 1: run_phase<1>(sP, sX, l, smem); break; case 2: run_phase<2>(sP, sX, l, smem); break;
    case 3: run_phase<3>(sP, sX, l, smem); break; case 4: run_phase<4>(sP, sX, l, smem); break; case 5: run_phase<5>(sP, sX, l, smem); break;
    case 6: run_phase<6>(sP, sX, l, smem); break; case 7: run_phase<7>(sP, sX, l, smem); break; case 8: run_phase<8>(sP, sX, l, smem); break;
    case 9: run_phase<9>(sP, sX, l, smem); break; case 10: run_phase<10>(sP, sX, l, smem); break; case 11: run_phase<11>(sP, sX, l, smem); break;
  }
}
#else
__global__ void __launch_bounds__(NTHREADS, 3) mega_kernel(Params P) {
  extern __shared__ __attribute__((aligned(16))) unsigned char smem[];
  cg::grid_group grid = cg::this_grid();
  __shared__ uint4 xb_words;
  if (threadIdx.x == 0) xb_words = make_uint4(0u, 0u, 0u, 0u);
  __syncthreads();
  XcdBarrier xb = xcd_barrier_post(P.bar, (volatile LAS unsigned*)&xb_words);
  __shared__ XInfo sX;
  if (threadIdx.x == 0) sX.rank = (int)xb_add(&P.bar[XCD_BAR_WORDS + 64 * xb.x], 1u);
  run_phase<PH_PRE0>(P, sX, 0, smem);
  if (P.bar == nullptr) grid.sync();
  xcd_barrier(xb);
  if (threadIdx.x == 0) {
    int slot = 0, nx = 0, nloc = 1;
    for (unsigned j = 0; j < 16; ++j) {
      const int c = (int)xb_ld(&P.bar[XCD_BAR_WORDS + 64 * j]);
      if (c > 0) { if (j < xb.x) ++slot; ++nx; }
      if (j == xb.x) nloc = c > 0 ? c : 1;
    }
    sX.slot = slot; sX.nx = nx > 0 ? nx : 1; sX.nloc = nloc;
  }
  __syncthreads();
  run_phase<PH_PRE1>(P, sX, 0, smem); xcd_barrier(xb);
  run_phase<PH_PRE2>(P, sX, 0, smem); xcd_barrier(xb);
  {
    constexpr int l = 0;
    run_phase<PH_L1>(P, sX, l, smem); xcd_barrier(xb);
#if defined(REPEAT_PH)
    if (REPEAT_PH == PH_L1) { run_phase<PH_L1>(P, sX, l, smem, true); xcd_barrier(xb); }
#endif
    run_phase<PH_L2>(P, sX, l, smem); xcd_barrier(xb);
#if defined(REPEAT_PH)
    if (REPEAT_PH == PH_L2) { run_phase<PH_L2>(P, sX, l, smem, true); xcd_barrier(xb); }
#endif
    run_phase<PH_L3>(P, sX, l, smem); xcd_barrier(xb);
#if defined(REPEAT_PH)
    if (REPEAT_PH == PH_L3) { run_phase<PH_L3>(P, sX, l, smem, true); xcd_barrier(xb); }
#endif
    run_phase<PH_L4>(P, sX, l, smem); xcd_barrier(xb);
#if defined(REPEAT_PH)
    if (REPEAT_PH == PH_L4) { run_phase<PH_L4>(P, sX, l, smem, true); xcd_barrier(xb); }
#endif
    run_phase<PH_L5>(P, sX, l, smem); xcd_barrier(xb);
#if defined(REPEAT_PH)
    if (REPEAT_PH == PH_L5) { run_phase<PH_L5>(P, sX, l, smem, true); xcd_barrier(xb); }
#endif
    run_phase<PH_L6>(P, sX, l, smem); xcd_barrier(xb);
#if defined(REPEAT_PH)
    if (REPEAT_PH == PH_L6) { run_phase<PH_L6>(P, sX, l, smem, true); xcd_barrier(xb); }
#endif
    run_phase<PH_L7>(P, sX, l, smem); xcd_barrier(xb);
#if defined(REPEAT_PH)
    if (REPEAT_PH == PH_L7) { run_phase<PH_L7>(P, sX, l, smem, true); xcd_barrier(xb); }
#endif
    run_phase<PH_L8>(P, sX, l, smem); xcd_barrier(xb);
#if defined(REPEAT_PH)
    if (REPEAT_PH == PH_L8) { run_phase<PH_L8>(P, sX, l, smem, true); xcd_barrier(xb); }
#endif
    run_phase<PH_L9>(P, sX, l, smem); xcd_barrier(xb);
#if defined(REPEAT_PH)
    if (REPEAT_PH == PH_L9) { run_phase<PH_L9>(P, sX, l, smem, true); xcd_barrier(xb); }
#endif
  }
  {
    constexpr int l = 1;
    run_phase<PH_L1>(P, sX, l, smem); xcd_barrier(xb);
#if defined(REPEAT_PH)
    if (REPEAT_PH == PH_L1) { run_phase<PH_L1>(P, sX, l, smem, true); xcd_barrier(xb); }
#endif
    run_phase<PH_L2>(P, sX, l, smem); xcd_barrier(xb);
#if defined(REPEAT_PH)
    if (REPEAT_PH == PH_L2) { run_phase<PH_L2>(P, sX, l, smem, true); xcd_barrier(xb); }
#endif
    run_phase<PH_L3>(P, sX, l, smem); xcd_barrier(xb);
#if defined(REPEAT_PH)
    if (REPEAT_PH == PH_L3) { run_phase<PH_L3>(P, sX, l, smem, true); xcd_barrier(xb); }
#endif
    run_phase<PH_L4>(P, sX, l, smem); xcd_barrier(xb);
#if defined(REPEAT_PH)
    if (REPEAT_PH == PH_L4) { run_phase<PH_L4>(P, sX, l, smem, true); xcd_barrier(xb); }
#endif
    run_phase<PH_L5>(P, sX, l, smem); xcd_barrier(xb);
#if defined(REPEAT_PH)
    if (REPEAT_PH == PH_L5) { run_phase<PH_L5>(P, sX, l, smem, true); xcd_barrier(xb); }
#endif
    run_phase<PH_L6>(P, sX, l, smem); xcd_barrier(xb);
#if defined(REPEAT_PH)
    if (REPEAT_PH == PH_L6) { run_phase<PH_L6>(P, sX, l, smem, true); xcd_barrier(xb); }
#endif
    run_phase<PH_L7>(P, sX, l, smem); xcd_barrier(xb);
#if defined(REPEAT_PH)
    if (REPEAT_PH == PH_L7) { run_phase<PH_L7>(P, sX, l, smem, true); xcd_barrier(xb); }
#endif
    run_phase<PH_L8>(P, sX, l, smem); xcd_barrier(xb);
#if defined(REPEAT_PH)
    if (REPEAT_PH == PH_L8) { run_phase<PH_L8>(P, sX, l, smem, true); xcd_barrier(xb); }
#endif
    run_phase<PH_L9>(P, sX, l, smem); xcd_barrier(xb);
#if defined(REPEAT_PH)
    if (REPEAT_PH == PH_L9) { run_phase<PH_L9>(P, sX, l, smem, true); xcd_barrier(xb); }
#endif
  }
}
#endif

extern "C" void kernel_launch(void* const* d_in, const int* in_sizes, int n_in, void* d_out, int out_size, void* d_ws, size_t ws_size, hipStream_t stream) {
  Params P{};
  const float** pf = (const float**)&P;
  for (int i = 0; i < 36; ++i) pf[i] = (const float*)d_in[i];
  P.out = (float*)d_out;
  unsigned char* w = (unsigned char*)d_ws;
  size_t off = 0;
  auto take = [&](size_t bytes) { unsigned char* p = w + off; off += (bytes + 255) & ~(size_t)255; return p; };
  P.Pbuf = (bf16_t*)take((size_t)NTOK * PST * 2);
  P.Ybuf = (bf16_t*)take((size_t)NTOK * 1024 * 2);
  P.xc = (float*)take((size_t)4096 * 1024 * 4);
  P.dtbuf = (float*)take((size_t)NTOK * 8 * 4);
  P.wt_in = (bf16_t*)take((size_t)2 * 2944 * 1024 * 2);
  P.wt_out = (bf16_t*)take((size_t)2 * 1024 * 1024 * 2);
  P.wt_q = (bf16_t*)take((size_t)2 * 2048 * 1024 * 2);
  P.keysb = (bf16_t*)take((size_t)2 * 8 * 2 * 128 * 128 * 2);
  P.modp = (float*)take((size_t)2 * 16 * 17 * 6144 * 4);
  P.mod = (float*)take((size_t)3 * 17 * 6144 * 4);
  P.hm2 = (float*)take((size_t)2 * 2 * 2048 * 64 * 4);
  P.gtab = (bf16_t*)take((size_t)2 * (256 * 2 * 4096 + 256 * 2 * 512) * 2);
  P.ropetab = (float*)take(2048 * 4);
  P.bar = (unsigned*)take((XCD_BAR_WORDS + 16 * 64 + 8 * 64) * 4);
  unsigned char* treg = w + off;
  P.krot = (bf16_t*)take((size_t)NLAT * 256 * 2);
  P.vt_lat = (bf16_t*)take((size_t)16 * 256 * 2048 * 2);
  P.vt_ctx = (bf16_t*)take((size_t)16 * 256 * 256 * 2);
  P.sst = (float*)take((size_t)16 * 2 * 4 * NCH * 4096 * 4);
  P.ssumA = (float*)take((size_t)16 * 2 * 4 * NCH * 4);
  const size_t hysz = (size_t)16 * 256 * (2048 + 256) * 2;
  P.uT = (bf16_t*)take(hysz);
  P.x0T = (bf16_t*)take(hysz);
  P.yT = (bf16_t*)take(hysz);
  P.tabu = (bf16_t*)treg;
  P.tabv = (bf16_t*)(treg + (size_t)16384 * 1024);
  P.pout = (bf16_t*)(treg + (size_t)40 * 1024 * 1024);
  P.pact = (float*)P.Pbuf;
  P.qbuf = P.Pbuf;
  P.eidx = (int*)((unsigned char*)P.Pbuf + (size_t)NTOK * 2048 * 2);
  P.egate = (float*)((unsigned char*)P.eidx + (size_t)NTOK * 128 * 4);
  if (off > ws_size || n_in != 36) { fprintf(stderr, "kernel_launch: workspace too small (%zu > %zu) or n_in %d != 36\n", off, ws_size, n_in); return; }

  static int grid = 0;
#if MULTI_LAUNCH
  if (!grid) {
    hipFuncSetAttribute((const void*)phase_kernel, hipFuncAttributeMaxDynamicSharedMemorySize, LDS_BYTES);
    grid = 512;
  }
  hipLaunchKernelGGL(phase_kernel, dim3(grid), dim3(NTHREADS), LDS_BYTES, stream, P, PH_PRE0, 0);
  hipLaunchKernelGGL(phase_kernel, dim3(grid), dim3(NTHREADS), LDS_BYTES, stream, P, PH_PRE1, 0);
  hipLaunchKernelGGL(phase_kernel, dim3(grid), dim3(NTHREADS), LDS_BYTES, stream, P, PH_PRE2, 0);
  for (int l = 0; l < 2; ++l)
    for (int ph = PH_L1; ph <= PH_L9; ++ph) hipLaunchKernelGGL(phase_kernel, dim3(grid), dim3(NTHREADS), LDS_BYTES, stream, P, ph, l);
#else
  if (!grid) {
    int dev = 0, cus = 0, per_cu = 0;
    hipGetDevice(&dev);
    hipDeviceGetAttribute(&cus, hipDeviceAttributeMultiprocessorCount, dev);
    hipFuncSetAttribute((const void*)mega_kernel, hipFuncAttributeMaxDynamicSharedMemorySize, LDS_BYTES);
    hipOccupancyMaxActiveBlocksPerMultiprocessor(&per_cu, (const void*)mega_kernel, NTHREADS, LDS_BYTES);
    if (per_cu < 1) { fprintf(stderr, "kernel_launch: occupancy query returned %d\n", per_cu); per_cu = 1; }
    if (per_cu > 3) per_cu = 3;
    grid = cus * per_cu;
  }
  if (hipMemsetAsync(P.bar, 0, (XCD_BAR_WORDS + 16 * 64 + 8 * 64) * 4, stream) != hipSuccess) { fprintf(stderr, "kernel_launch: memset of barrier words failed\n"); return; }
  void* args[] = {&P};
  hipError_t e = hipLaunchCooperativeKernel((const void*)mega_kernel, dim3(grid), dim3(NTHREADS), args, LDS_BYTES, stream);
  if (e != hipSuccess) fprintf(stderr, "cooperative launch failed: %s (grid %d)\n", hipGetErrorString(e), grid);
#endif
}
```

```cpp
#include <hip/hip_runtime.h>
#include <hip/hip_cooperative_groups.h>
#include <cstdio>
#include <cstdint>
namespace cg = cooperative_groups;

#ifndef MULTI_LAUNCH
#define MULTI_LAUNCH 0
#endif

typedef unsigned short bf16_t;
typedef __attribute__((ext_vector_type(8))) short bf16x8;
typedef __attribute__((ext_vector_type(4))) float f32x4;

#define D_MODEL 1024
#define NB 16
#define SEQ 2048
#define CTXL 256
#define NLAT 32768
#define NTOK 36864
#define PST 2816
#define NCH 36
#define LDS_BYTES 53248
#define NTHREADS 256
#define ALPHA 1.41421356237f
#define LN_EPS 1e-5f

struct Params {
  const float *x, *c, *ctx, *c_ctx, *w_ada, *b_ada, *w_in, *w_out, *ln1_g, *ln1_b, *ln2_g, *ln2_b;
  const float *conf_dw_w, *conf_dw_b, *conf_norm_g, *conf_norm_b, *na_rpb, *hy_short_w, *hy_short_b;
  const float *hy_w1, *hy_b1, *hy_w2, *hy_b2, *hy_w3, *hy_decay, *hy_bias;
  const float *ssd_conv_w, *ssd_conv_b, *ssd_a_log, *ssd_dt_bias, *ssd_d, *ssd_norm_g;
  const float *peer_wq, *peer_keys, *peer_u, *peer_v;
  float* out;
  bf16_t* Pbuf;
  bf16_t* Ybuf;
  float*  xc;
  float*  dtbuf;
  bf16_t* wt_in;
  bf16_t* wt_out;
  bf16_t* wt_q;
  bf16_t* keysb;
  float*  modp;
  float*  mod;
  float*  hm2;
  bf16_t* gtab;
  float*  ropetab;
  bf16_t* krot;
  bf16_t* vt_lat;
  bf16_t* vt_ctx;
  float*  sst;
  float*  ssumA;
  bf16_t* uT;
  bf16_t* x0T;
  bf16_t* yT;
  bf16_t* tabu;
  bf16_t* tabv;
  int*    eidx;
  float*  egate;
  bf16_t* qbuf;
  unsigned* bar;
  float* pact;
  bf16_t* pout;
};

__device__ __forceinline__ bf16_t f2bf(float f) { unsigned u = __float_as_uint(f); u += 0x7FFFu + ((u >> 16) & 1u); return (bf16_t)(u >> 16); }
__device__ __forceinline__ float bf2f(bf16_t h) { return __uint_as_float(((unsigned)h) << 16); }
__device__ __forceinline__ unsigned pack2(float a, float b) { return (unsigned)f2bf(a) | ((unsigned)f2bf(b) << 16); }
__device__ __forceinline__ float lo2f(unsigned u) { return __uint_as_float(u << 16); }
__device__ __forceinline__ float hi2f(unsigned u) { return __uint_as_float(u & 0xFFFF0000u); }
__device__ __forceinline__ float sigmoidf_(float x) { return 1.f / (1.f + __expf(-x)); }
__device__ __forceinline__ float siluf_(float x) { return x / (1.f + __expf(-x)); }
__device__ __forceinline__ float wave_sum(float v) {
#pragma unroll
  for (int o = 32; o >= 1; o >>= 1) v += __shfl_xor(v, o);
  return v;
}
__device__ __forceinline__ void unpack8(uint4 v, float* f) {
  f[0] = lo2f(v.x); f[1] = hi2f(v.x); f[2] = lo2f(v.y); f[3] = hi2f(v.y);
  f[4] = lo2f(v.z); f[5] = hi2f(v.z); f[6] = lo2f(v.w); f[7] = hi2f(v.w);
}
__device__ __forceinline__ uint4 pack8(const float* f) {
  uint4 v; v.x = pack2(f[0], f[1]); v.y = pack2(f[2], f[3]); v.z = pack2(f[4], f[5]); v.w = pack2(f[6], f[7]); return v;
}
__device__ __forceinline__ bf16x8 as_bf8(uint4 v) { union { uint4 u; bf16x8 b; } x; x.u = v; return x.b; }
__device__ __forceinline__ f32x4 mfma16(bf16x8 a, bf16x8 b, f32x4 c) { return __builtin_amdgcn_mfma_f32_16x16x32_bf16(a, b, c, 0, 0, 0); }

__device__ __forceinline__ int tidx() { int t = threadIdx.x; asm volatile("" : "+v"(t)); return t; }
template <class Epi>
__device__ __forceinline__ void gemm_tile(const bf16_t* __restrict__ A, int lda, const bf16_t* __restrict__ Bt, int ldb,
                                          int K, int m0, int n0, unsigned char* smem, Epi epi) {
  bf16_t* As = (bf16_t*)smem;
  bf16_t* Bs = As + 3 * 128 * 40;
  const int tid = tidx(), lane = tid & 63, wave = tid >> 6;
  const int wm = wave >> 1, wn = wave & 1;
  const int lr = tid >> 1, lh = tid & 1;
  const bf16_t* ag = A + (size_t)(m0 + lr) * lda + lh * 16;
  const bf16_t* bg = Bt + (size_t)(n0 + lr) * ldb + lh * 16;
  f32x4 acc[4][4];
#pragma unroll
  for (int i = 0; i < 4; ++i)
#pragma unroll
    for (int j = 0; j < 4; ++j) acc[i][j] = (f32x4){0.f, 0.f, 0.f, 0.f};
  const int nk = K >> 5;
  uint4 pa0 = *(const uint4*)ag, pa1 = *(const uint4*)(ag + 8), pb0 = *(const uint4*)bg, pb1 = *(const uint4*)(bg + 8);
  uint4 qa0 = *(const uint4*)(ag + 32), qa1 = *(const uint4*)(ag + 40), qb0 = *(const uint4*)(bg + 32), qb1 = *(const uint4*)(bg + 40);
  __syncthreads();
  {
    bf16_t* wa = As + lr * 40 + lh * 16; bf16_t* wb = Bs + lr * 40 + lh * 16;
    *(uint4*)wa = pa0; *(uint4*)(wa + 8) = pa1; *(uint4*)wb = pb0; *(uint4*)(wb + 8) = pb1;
  }
  __syncthreads();
  int st = 0;
  auto compute = [&](int stage) {
    const bf16_t* as = As + stage * 5120 + (wm * 64 + (lane & 15)) * 40 + (lane >> 4) * 8;
    const bf16_t* bs = Bs + stage * 5120 + (wn * 64 + (lane & 15)) * 40 + (lane >> 4) * 8;
    bf16x8 afr[4];
#pragma unroll
    for (int j = 0; j < 4; ++j) afr[j] = *(const bf16x8*)(bs + j * 16 * 40);
#pragma unroll
    for (int i = 0; i < 4; ++i) {
      const bf16x8 bfr = *(const bf16x8*)(as + i * 16 * 40);
#pragma unroll
      for (int j = 0; j < 4; ++j) acc[i][j] = mfma16(afr[j], bfr, acc[i][j]);
    }
  };
  for (int kt = 0; kt < nk; kt += 2) {
    if (kt + 2 < nk) { const bf16_t* a2 = ag + (kt + 2) * 32; const bf16_t* b2 = bg + (kt + 2) * 32; pa0 = *(const uint4*)a2; pa1 = *(const uint4*)(a2 + 8); pb0 = *(const uint4*)b2; pb1 = *(const uint4*)(b2 + 8); }
    compute(st);
    {
      const int s1 = (st == 2) ? 0 : st + 1;
      bf16_t* wa = As + s1 * 5120 + lr * 40 + lh * 16; bf16_t* wb = Bs + s1 * 5120 + lr * 40 + lh * 16;
      *(uint4*)wa = qa0; *(uint4*)(wa + 8) = qa1; *(uint4*)wb = qb0; *(uint4*)(wb + 8) = qb1;
      st = s1;
    }
    __syncthreads();
    if (kt + 3 < nk) { const bf16_t* a2 = ag + (kt + 3) * 32; const bf16_t* b2 = bg + (kt + 3) * 32; qa0 = *(const uint4*)a2; qa1 = *(const uint4*)(a2 + 8); qb0 = *(const uint4*)b2; qb1 = *(const uint4*)(b2 + 8); }
    compute(st);
    if (kt + 2 < nk) {
      const int s1 = (st == 2) ? 0 : st + 1;
      bf16_t* wa = As + s1 * 5120 + lr * 40 + lh * 16; bf16_t* wb = Bs + s1 * 5120 + lr * 40 + lh * 16;
      *(uint4*)wa = pa0; *(uint4*)(wa + 8) = pa1; *(uint4*)wb = pb0; *(uint4*)(wb + 8) = pb1;
      st = s1;
    }
    __syncthreads();
  }
#pragma unroll
  for (int i = 0; i < 4; ++i)
#pragma unroll
    for (int j = 0; j < 4; ++j) {
      int m = m0 + wm * 64 + i * 16 + (lane & 15);
      int n = n0 + wn * 64 + j * 16 + (lane >> 4) * 4;
      epi(m, n, acc[i][j]);
    }
}

template <class Epi>
__device__ __forceinline__ void gemm_tile32(const bf16_t* __restrict__ A, int lda, const bf16_t* __restrict__ Bt, int ldb,
                                          int K, int m0, int n0, unsigned char* smem, Epi epi) {
  bf16_t* As = (bf16_t*)smem;
  bf16_t* Bs = As + 2 * 128 * 40;
  const int tid = tidx(), lane = tid & 63, wave = tid >> 6;
  const int wm = wave >> 1, wn = wave & 1;
  const int lr = tid >> 1, lh = tid & 1;
  const bf16_t* ag = A + (size_t)(m0 + lr) * lda + lh * 16;
  const bf16_t* bg = Bt + (size_t)(n0 + lr) * ldb + lh * 16;
  f32x4 acc[4][4];
#pragma unroll
  for (int i = 0; i < 4; ++i)
#pragma unroll
    for (int j = 0; j < 4; ++j) acc[i][j] = (f32x4){0.f, 0.f, 0.f, 0.f};
  uint4 ra0 = *(const uint4*)ag, ra1 = *(const uint4*)(ag + 8);
  uint4 rb0 = *(const uint4*)bg, rb1 = *(const uint4*)(bg + 8);
  __syncthreads();
  {
    bf16_t* pa = As + lr * 40 + lh * 16; bf16_t* pb = Bs + lr * 40 + lh * 16;
    *(uint4*)pa = ra0; *(uint4*)(pa + 8) = ra1; *(uint4*)pb = rb0; *(uint4*)(pb + 8) = rb1;
  }
  __syncthreads();
  const int nk = K >> 5;
  for (int kt = 0; kt < nk; ++kt) {
    const int cur = kt & 1;
    if (kt + 1 < nk) {
      const bf16_t* a2 = ag + (kt + 1) * 32; const bf16_t* b2 = bg + (kt + 1) * 32;
      ra0 = *(const uint4*)a2; ra1 = *(const uint4*)(a2 + 8); rb0 = *(const uint4*)b2; rb1 = *(const uint4*)(b2 + 8);
    }
    const bf16_t* as = As + cur * 5120 + (wm * 64 + (lane & 15)) * 40 + (lane >> 4) * 8;
    const bf16_t* bs = Bs + cur * 5120 + (wn * 64 + (lane & 15)) * 40 + (lane >> 4) * 8;
    bf16x8 afr[4];
#pragma unroll
    for (int j = 0; j < 4; ++j) afr[j] = *(const bf16x8*)(bs + j * 16 * 40);
#pragma unroll
    for (int i = 0; i < 4; ++i) {
      const bf16x8 bfr = *(const bf16x8*)(as + i * 16 * 40);
#pragma unroll
      for (int j = 0; j < 4; ++j) acc[i][j] = mfma16(afr[j], bfr, acc[i][j]);
    }
    if (kt + 1 < nk) {
      bf16_t* pa = As + (cur ^ 1) * 5120 + lr * 40 + lh * 16; bf16_t* pb = Bs + (cur ^ 1) * 5120 + lr * 40 + lh * 16;
      *(uint4*)pa = ra0; *(uint4*)(pa + 8) = ra1; *(uint4*)pb = rb0; *(uint4*)(pb + 8) = rb1;
    }
    __syncthreads();
  }
#pragma unroll
  for (int i = 0; i < 4; ++i)
#pragma unroll
    for (int j = 0; j < 4; ++j) {
      int m = m0 + wm * 64 + i * 16 + (lane & 15);
      int n = n0 + wn * 64 + j * 16 + (lane >> 4) * 4;
      epi(m, n, acc[i][j]);
    }
}

__device__ __forceinline__ void transpose_task(const float* __restrict__ src, bf16_t* __restrict__ dst, int K, int N, int k0, int n0, unsigned char* smem) {
  float* tile = (float*)smem;
  const int tid = tidx();
  __syncthreads();
  {
    int r = tid >> 4, c4 = tid & 15;
#pragma unroll
    for (int rr = 0; rr < 4; ++rr) {
      int row = rr * 16 + r;
      float4 v = make_float4(0.f, 0.f, 0.f, 0.f);
      if (n0 + c4 * 4 < N) v = *(const float4*)(src + (size_t)(k0 + row) * N + n0 + c4 * 4);
      float* t = tile + row * 65 + c4 * 4;
      t[0] = v.x; t[1] = v.y; t[2] = v.z; t[3] = v.w;
    }
  }
  __syncthreads();
  {
    int n = tid >> 2, kq = tid & 3;
    float f[16];
#pragma unroll
    for (int i = 0; i < 16; ++i) f[i] = tile[(kq * 16 + i) * 65 + n];
    bf16_t* d = dst + (size_t)(n0 + n) * K + k0 + kq * 16;
    *(uint4*)d = pack8(f); *(uint4*)(d + 8) = pack8(f + 8);
  }
}

__device__ __forceinline__ void modpart_task(const Params& P, int l, int ks, int cb, unsigned char* smem) {
  float* s = (float*)smem;
  const int tid = tidx();
  __syncthreads();
  for (int i = tid; i < 17 * 64; i += NTHREADS) {
    int r = i >> 6, k = i & 63;
    float v = (r < 16) ? P.c[r * 1024 + ks * 64 + k] : P.c_ctx[ks * 64 + k];
    s[i] = siluf_(v);
  }
  __syncthreads();
  float acc[17];
#pragma unroll
  for (int r = 0; r < 17; ++r) acc[r] = 0.f;
  const int col = cb * 256 + tid;
  const float* w = P.w_ada + ((size_t)l * 1024 + ks * 64) * 6144 + col;
#pragma unroll 8
  for (int k = 0; k < 64; ++k) {
    float wv = w[(size_t)k * 6144];
#pragma unroll
    for (int r = 0; r < 17; ++r) acc[r] += s[r * 64 + k] * wv;
  }
#pragma unroll
  for (int r = 0; r < 17; ++r) P.modp[(((size_t)l * 16 + ks) * 17 + r) * 6144 + col] = acc[r];
}

__device__ __forceinline__ void hm2_task(const Params& P, int l, int lsel, int t4, unsigned char* smem) {
  float* z = (float*)smem;
  float* h1 = z + 4 * 36;
  const int tid = tidx(), tt = tid >> 6, j = tid & 63;
  const int L = lsel ? 256 : 2048;
  const int t = t4 * 4 + tt;
  const float tn = (float)t / (float)L;
  __syncthreads();
  if (j < 33) {
    float v;
    if (j == 0) v = tn;
    else if (j <= 16) v = sinf((6.2831855f * (float)j) * tn);
    else v = cosf((6.2831855f * (float)(j - 16)) * tn);
    z[tt * 36 + j] = v;
  }
  __syncthreads();
  float a = P.hy_b1[l * 64 + j];
  for (int i = 0; i < 33; ++i) a += z[tt * 36 + i] * P.hy_w1[(l * 33 + i) * 64 + j];
  h1[tt * 64 + j] = sinf(a);
  __syncthreads();
  float b = P.hy_b2[l * 64 + j];
  for (int i = 0; i < 64; ++i) b += h1[tt * 64 + i] * P.hy_w2[(l * 64 + i) * 64 + j];
  P.hm2[(((size_t)l * 2 + lsel) * 2048 + t) * 64 + j] = sinf(b);
}

__device__ __forceinline__ bf16_t* gtab_ptr(const Params& P, int l, int lsel, int c) {
  bf16_t* base = P.gtab + (size_t)l * (256 * 2 * 4096 + 256 * 2 * 512);
  return lsel ? base + 256 * 2 * 4096 + (size_t)c * 1024 : base + (size_t)c * 8192;
}

__device__ __forceinline__ void filt_task(const Params& P, int l, int lsel, int col, unsigned char* smem) {
  float* kv = (float*)smem;
  float* red = kv + 2048;
  float* w3s = red + 8;
  const int tid = tidx();
  const int L = lsel ? 256 : 2048;
  __syncthreads();
  if (tid < 64) w3s[tid] = P.hy_w3[(l * 64 + tid) * 512 + col];
  __syncthreads();
  const float dec = P.hy_decay[l * 512 + col];
  float asum = 0.f;
  for (int t = tid; t < L; t += NTHREADS) {
    const float* h = P.hm2 + (((size_t)l * 2 + lsel) * 2048 + t) * 64;
    float a = 0.f;
#pragma unroll 8
    for (int i = 0; i < 64; ++i) a += h[i] * w3s[i];
    float tn = (float)t / (float)L;
    a *= expf(-tn * dec);
    kv[t] = a; asum += fabsf(a);
  }
  asum = wave_sum(asum);
  if ((tid & 63) == 0) red[tid >> 6] = asum;
  __syncthreads();
  const float inv = 1.f / (red[0] + red[1] + red[2] + red[3] + 1e-6f);
  const int c = col & 255;
  const bool bwd = col >= 256;
  bf16_t* g0 = gtab_ptr(P, l, lsel, c);
  bf16_t* g1 = g0 + 2 * L;
  for (int d = tid; d < L; d += NTHREADS) {
    if (bwd && d == 0) continue;
    int i = bwd ? (L - 1 + d) : (L - 1 - d);
    bf16_t v = f2bf(kv[d] * inv);
    g0[i] = v;
    if (i >= 1) g1[i - 1] = v;
  }
}

__device__ __forceinline__ int mod_row(int T) { return T < NLAT ? (T >> 11) : 16; }

__device__ __forceinline__ void hmod0_token(const Params& P, int T, int lane) {
  const float* xr = (T < NLAT) ? P.x + (size_t)T * 1024 : P.ctx + (size_t)(T - NLAT) * 1024;
  const float* m = P.mod + (size_t)mod_row(T) * 6144;
#pragma unroll
  for (int i = 0; i < 2; ++i) {
    int d = i * 512 + lane * 8;
    float f[8];
#pragma unroll
    for (int j = 0; j < 8; ++j) f[j] = xr[d + j] * (1.f + m[1024 + d + j]) + m[d + j];
    *(uint4*)(P.Ybuf + (size_t)T * 1024 + d) = pack8(f);
  }
}

__device__ __forceinline__ void r1_token(const Params& P, int l, int T, int lane, const bool dry) {
  const float* xr;
  float* xw;
  if (T < NLAT) { xr = (l == 0) ? P.x + (size_t)T * 1024 : P.out + (size_t)T * 1024; xw = P.out + (size_t)T * 1024; }
  else { xr = (l == 0) ? P.ctx + (size_t)(T - NLAT) * 1024 : P.xc + (size_t)(T - NLAT) * 1024; xw = P.xc + (size_t)(T - NLAT) * 1024; }
  bf16_t* hw = P.Ybuf + (size_t)T * 1024;
  if (dry) { xw = (float*)P.uT + (size_t)(T & 2047) * 1024; hw = P.x0T + (size_t)(T & 2047) * 1024; }
  const float* m = P.mod + ((size_t)l * 17 + mod_row(T)) * 6144;
  const bf16_t* yo = P.Pbuf + (size_t)T * 1024;
  float v[16];
  float s = 0.f;
#pragma unroll
  for (int i = 0; i < 2; ++i) {
    int d = i * 512 + lane * 8;
    float y[8]; unpack8(*(const uint4*)(yo + d), y);
#pragma unroll
    for (int j = 0; j < 8; ++j) { v[i * 8 + j] = ALPHA * xr[d + j] + m[2048 + d + j] * y[j]; s += v[i * 8 + j]; }
  }
  float mean = wave_sum(s) * (1.f / 1024.f);
  float q = 0.f;
#pragma unroll
  for (int i = 0; i < 16; ++i) { v[i] -= mean; q += v[i] * v[i]; }
  float rstd = rsqrtf(wave_sum(q) * (1.f / 1024.f) + LN_EPS);
#pragma unroll
  for (int i = 0; i < 2; ++i) {
    int d = i * 512 + lane * 8;
    float h[8];
#pragma unroll
    for (int j = 0; j < 8; ++j) {
      float x1 = v[i * 8 + j] * rstd * P.ln1_g[l * 1024 + d + j] + P.ln1_b[l * 1024 + d + j];
      xw[d + j] = x1;
      h[j] = x1 * (1.f + m[4096 + d + j]) + m[3072 + d + j];
    }
    *(uint4*)(hw + d) = pack8(h);
  }
}

__device__ __forceinline__ float gelu_tanh(float x) {
  float u = 0.7978845608f * (x + 0.044715f * x * x * x);
  float t = 1.f - 2.f / (1.f + __expf(2.f * u));
  return 0.5f * x * (1.f + t);
}

typedef float f32x2 __attribute__((ext_vector_type(2)));
__device__ __forceinline__ unsigned pack4_fp8(float a, float b, float c, float d) {
  int v = 0;
  v = __builtin_amdgcn_cvt_pk_fp8_f32(a, b, v, false);
  v = __builtin_amdgcn_cvt_pk_fp8_f32(c, d, v, true);
  return (unsigned)v;
}
__device__ __forceinline__ float dot16_fp8(uint4 v, const float* h) {
  f32x2 acc = (f32x2){0.f, 0.f};
  unsigned w[4] = {v.x, v.y, v.z, v.w};
#pragma unroll
  for (int q = 0; q < 4; ++q) {
    acc += __builtin_amdgcn_cvt_pk_f32_fp8((int)w[q], false) * (f32x2){h[q * 4], h[q * 4 + 1]};
    acc += __builtin_amdgcn_cvt_pk_f32_fp8((int)w[q], true) * (f32x2){h[q * 4 + 2], h[q * 4 + 3]};
  }
  return acc[0] + acc[1];
}
typedef float f32x4_t __attribute__((ext_vector_type(4)));
__device__ __forceinline__ void peer_u_phase(const Params& P, int sl, int Tfirst, int Tstride, int ntok, int lane, int* li) {
  const int m = lane & 15, quad = lane >> 4;
  const unsigned char* tu = (const unsigned char*)P.tabu + (size_t)sl * 16384 * 128 + quad * 32;
  const int wpos = (lane & 15) * 8 + (lane >> 4);
  for (int T0 = Tfirst; T0 < ntok; T0 += 4 * Tstride) {
    int Tk[4];
    {
      int ir[4][2];
#pragma unroll
      for (int k = 0; k < 4; ++k) {
        Tk[k] = min(T0 + k * Tstride, ntok - 1);
        const int* er = P.eidx + (size_t)Tk[k] * 128;
        ir[k][0] = er[lane]; ir[k][1] = er[64 + lane];
      }
#pragma unroll
      for (int k = 0; k < 4; ++k) { li[k * 128 + wpos] = ir[k][0]; li[k * 128 + wpos + 4] = ir[k][1]; }
    }
#pragma unroll 1
    for (int k = 0; k < 4; ++k) {
      const int Tc = min(T0 + k * Tstride, ntok - 1);
      uint4 hr[4];
      const bf16_t* hp = P.Ybuf + (size_t)Tc * 1024 + sl * 128 + quad * 32;
#pragma unroll
      for (int q = 0; q < 4; ++q) hr[q] = *(const uint4*)(hp + q * 8);
      uint4 rv[16];
      {
        int idx[8];
#pragma unroll
        for (int q = 0; q < 2; ++q) { int4 v = *(const int4*)(li + k * 128 + m * 8 + q * 4); idx[q * 4] = v.x; idx[q * 4 + 1] = v.y; idx[q * 4 + 2] = v.z; idx[q * 4 + 3] = v.w; }
#pragma unroll
        for (int t = 0; t < 8; ++t) { const unsigned char* rp = tu + (size_t)idx[t] * 128; rv[2 * t] = *(const uint4*)rp; rv[2 * t + 1] = *(const uint4*)(rp + 16); }
      }
      long hb[4];
#pragma unroll
      for (int q = 0; q < 4; ++q) {
        float f[8]; unpack8(hr[q], f);
        unsigned lo = pack4_fp8(f[0], f[1], f[2], f[3]), hi = pack4_fp8(f[4], f[5], f[6], f[7]);
        hb[q] = (long)(((unsigned long long)hi << 32) | (unsigned long long)lo);
      }
      const bool live = (T0 + k * Tstride) < ntok;
      float* po = P.pact + ((size_t)sl * NTOK + Tc) * 128 + quad * 4;
#pragma unroll
      for (int t = 0; t < 8; ++t) {
        f32x4_t acc = (f32x4_t){0.f, 0.f, 0.f, 0.f};
        const uint4 r0 = rv[2 * t], r1 = rv[2 * t + 1];
        acc = __builtin_amdgcn_mfma_f32_16x16x32_fp8_fp8((long)(((unsigned long long)r0.y << 32) | r0.x), hb[0], acc, 0, 0, 0);
        acc = __builtin_amdgcn_mfma_f32_16x16x32_fp8_fp8((long)(((unsigned long long)r0.w << 32) | r0.z), hb[1], acc, 0, 0, 0);
        acc = __builtin_amdgcn_mfma_f32_16x16x32_fp8_fp8((long)(((unsigned long long)r1.y << 32) | r1.x), hb[2], acc, 0, 0, 0);
        acc = __builtin_amdgcn_mfma_f32_16x16x32_fp8_fp8((long)(((unsigned long long)r1.w << 32) | r1.z), hb[3], acc, 0, 0, 0);
        if (m == 0 && live) *(float4*)(po + t * 16) = make_float4(acc[0], acc[1], acc[2], acc[3]);
      }
    }
  }
}
__device__ __forceinline__ void peer_v_phase(const Params& P, int sl, int Tfirst, int Tstride, int ntok, int lane, int* li) {
  const int grp = lane >> 3, j8 = lane & 7;
  const unsigned char* tv = (const unsigned char*)P.tabv + (size_t)sl * 16384 * 128 + j8 * 16;
  float* lw = (float*)(li + 512);
  const int wpos = (lane & 7) * 16 + (lane >> 3);
  for (int T0 = Tfirst; T0 < ntok; T0 += 4 * Tstride) {
    int Tk[4];
    {
      int ir[4][2]; float wr[4][2];
#pragma unroll
      for (int k = 0; k < 4; ++k) {
        Tk[k] = min(T0 + k * Tstride, ntok - 1);
        const int* er = P.eidx + (size_t)Tk[k] * 128; const float* gr = P.egate + (size_t)Tk[k] * 128;
        ir[k][0] = er[lane]; ir[k][1] = er[64 + lane]; wr[k][0] = gr[lane]; wr[k][1] = gr[64 + lane];
      }
#pragma unroll
      for (int k = 0; k < 4; ++k) { li[k * 128 + wpos] = ir[k][0]; li[k * 128 + wpos + 8] = ir[k][1]; lw[k * 128 + wpos] = wr[k][0]; lw[k * 128 + wpos + 8] = wr[k][1]; }
    }
    uint4 rv[1][16];
#pragma unroll
    for (int k = 0; k < 4; ++k) {
      {
        int idx[16];
#pragma unroll
        for (int q = 0; q < 4; ++q) { int4 v = *(const int4*)(li + k * 128 + grp * 16 + q * 4); idx[q * 4] = v.x; idx[q * 4 + 1] = v.y; idx[q * 4 + 2] = v.z; idx[q * 4 + 3] = v.w; }
#pragma unroll
        for (int t = 0; t < 16; ++t) rv[0][t] = *(const uint4*)(tv + (size_t)idx[t] * 128);
      }
      {
        const int kk = k;
        float w[16];
#pragma unroll
        for (int q = 0; q < 4; ++q) { float4 f = *(const float4*)(lw + kk * 128 + grp * 16 + q * 4); w[q * 4] = f.x; w[q * 4 + 1] = f.y; w[q * 4 + 2] = f.z; w[q * 4 + 3] = f.w; }
        f32x2 o[8];
#pragma unroll
        for (int i = 0; i < 8; ++i) o[i] = (f32x2){0.f, 0.f};
#pragma unroll
        for (int t = 0; t < 16; ++t) {
          const f32x2 w2 = (f32x2){w[t], w[t]};
          const uint4 r = rv[0][t];
          unsigned ww[4] = {r.x, r.y, r.z, r.w};
#pragma unroll
          for (int q = 0; q < 4; ++q) {
            o[q * 2] += w2 * __builtin_amdgcn_cvt_pk_f32_fp8((int)ww[q], false);
            o[q * 2 + 1] += w2 * __builtin_amdgcn_cvt_pk_f32_fp8((int)ww[q], true);
          }
        }
        float of[16];
#pragma unroll
        for (int i = 0; i < 8; ++i) { of[2 * i] = o[i][0]; of[2 * i + 1] = o[i][1]; }
#pragma unroll
        for (int i = 0; i < 16; ++i) { of[i] += __shfl_xor(of[i], 8); of[i] += __shfl_xor(of[i], 16); of[i] += __shfl_xor(of[i], 32); }
        if (grp == 0 && (T0 + kk * Tstride) < ntok) {
#pragma unroll
          for (int i = 0; i < 16; ++i) of[i] *= (1.f / 256.f);
          bf16_t* d = P.pout + (size_t)Tk[kk] * 1024 + sl * 128 + j8 * 16;
          *(uint4*)d = pack8(of); *(uint4*)(d + 8) = pack8(of + 8);
        }
      }
    }
  }
}
__device__ __forceinline__ void ln2_token(const Params& P, int l, int T, int lane) {
  float* xw = (T < NLAT) ? P.out + (size_t)T * 1024 : P.xc + (size_t)(T - NLAT) * 1024;
  bf16_t* hw = P.Ybuf + (size_t)T * 1024;
  const float* m = P.mod + ((size_t)l * 17 + mod_row(T)) * 6144;
  const int d0 = lane * 16;
  float o[16];
  unpack8(*(const uint4*)(P.pout + (size_t)T * 1024 + d0), o); unpack8(*(const uint4*)(P.pout + (size_t)T * 1024 + d0 + 8), o + 8);
  float s = 0.f;
#pragma unroll
  for (int i = 0; i < 16; ++i) { o[i] = ALPHA * xw[d0 + i] + m[5120 + d0 + i] * o[i]; s += o[i]; }
  float mean = wave_sum(s) * (1.f / 1024.f);
  float q = 0.f;
#pragma unroll
  for (int i = 0; i < 16; ++i) { o[i] -= mean; q += o[i] * o[i]; }
  float rstd = rsqrtf(wave_sum(q) * (1.f / 1024.f) + LN_EPS);
  const float* mn = P.mod + ((size_t)(l + 1) * 17 + mod_row(T)) * 6144;
  float hh[16];
#pragma unroll
  for (int i = 0; i < 16; ++i) {
    float x2 = o[i] * rstd * P.ln2_g[l * 1024 + d0 + i] + P.ln2_b[l * 1024 + d0 + i];
    o[i] = x2;
    if (l == 0) hh[i] = x2 * (1.f + mn[1024 + d0 + i]) + mn[d0 + i];
  }
#pragma unroll
  for (int i = 0; i < 4; ++i) *(float4*)(xw + d0 + i * 4) = make_float4(o[i * 4], o[i * 4 + 1], o[i * 4 + 2], o[i * 4 + 3]);
  if (l == 0) { *(uint4*)(hw + d0) = pack8(hh); *(uint4*)(hw + d0 + 8) = pack8(hh + 8); }
}

__device__ __forceinline__ void peer_token(const Params& P, int l, int T, int lane, float* wl, const bool dry) {
  const int sub = lane >> 4, j16 = lane & 15;
  float h[64];
  {
    const bf16_t* hr = P.Ybuf + (size_t)T * 1024 + j16 * 16;
#pragma unroll
    for (int i = 0; i < 4; ++i) { unpack8(*(const uint4*)(hr + i * 256), h + i * 16); unpack8(*(const uint4*)(hr + i * 256 + 8), h + i * 16 + 8); }
  }
  const int* er = P.eidx + (size_t)T * 128;
  const float* gr = P.egate + (size_t)T * 128;
  const unsigned char* tu = (const unsigned char*)P.tabu;
  const unsigned char* tv = (const unsigned char*)P.tabv;
  for (int it = 0; it < 32; it += 2) {
    uint4 rv[2][4];
#pragma unroll
    for (int u2 = 0; u2 < 2; ++u2) {
      int e = er[(it + u2) * 4 + sub];
      const unsigned char* row = tu + (size_t)e * 1024 + j16 * 16;
#pragma unroll
      for (int i = 0; i < 4; ++i) rv[u2][i] = *(const uint4*)(row + i * 256);
    }
#pragma unroll
    for (int u2 = 0; u2 < 2; ++u2) {
      float acc = 0.f;
#pragma unroll
      for (int i = 0; i < 4; ++i) acc += dot16_fp8(rv[u2][i], h + i * 16);
      acc += __shfl_xor(acc, 1); acc += __shfl_xor(acc, 2); acc += __shfl_xor(acc, 4); acc += __shfl_xor(acc, 8);
      if (j16 == 0) wl[(it + u2) * 4 + sub] = gr[(it + u2) * 4 + sub] * gelu_tanh(acc * (1.f / 256.f));
    }
  }
  float o[16];
#pragma unroll
  for (int i = 0; i < 16; ++i) o[i] = 0.f;
  for (int e8 = 0; e8 < 128; e8 += 8) {
    uint4 rv[8];
    float w[8];
#pragma unroll
    for (int k = 0; k < 8; ++k) {
      int e = er[e8 + k];
      rv[k] = *(const uint4*)(tv + (size_t)e * 1024 + lane * 16);
      w[k] = wl[e8 + k];
    }
#pragma unroll
    for (int k = 0; k < 8; ++k) {
      unsigned ww[4] = {rv[k].x, rv[k].y, rv[k].z, rv[k].w};
#pragma unroll
      for (int q = 0; q < 4; ++q) {
        f32x2 lo = __builtin_amdgcn_cvt_pk_f32_fp8((int)ww[q], false);
        f32x2 hi = __builtin_amdgcn_cvt_pk_f32_fp8((int)ww[q], true);
        o[q * 4] += w[k] * lo[0]; o[q * 4 + 1] += w[k] * lo[1]; o[q * 4 + 2] += w[k] * hi[0]; o[q * 4 + 3] += w[k] * hi[1];
      }
    }
  }
  float* xw = (T < NLAT) ? P.out + (size_t)T * 1024 : P.xc + (size_t)(T - NLAT) * 1024;
  const float* xrd = xw;
  bf16_t* hw = P.Ybuf + (size_t)T * 1024;
  if (dry) { xw = (float*)P.uT + (size_t)(T & 2047) * 1024; hw = P.x0T + (size_t)(T & 2047) * 1024; }
  const float* m = P.mod + ((size_t)l * 17 + mod_row(T)) * 6144;
  const int d0 = lane * 16;
  float s = 0.f;
#pragma unroll
  for (int i = 0; i < 16; ++i) { o[i] = ALPHA * xrd[d0 + i] + m[5120 + d0 + i] * (o[i] * (1.f / 256.f)); s += o[i]; }
  float mean = wave_sum(s) * (1.f / 1024.f);
  float q = 0.f;
#pragma unroll
  for (int i = 0; i < 16; ++i) { o[i] -= mean; q += o[i] * o[i]; }
  float rstd = rsqrtf(wave_sum(q) * (1.f / 1024.f) + LN_EPS);
  const float* mn = P.mod + ((size_t)(l + 1) * 17 + mod_row(T)) * 6144;
  float hh[16];
#pragma unroll
  for (int i = 0; i < 16; ++i) {
    float x2 = o[i] * rstd * P.ln2_g[l * 1024 + d0 + i] + P.ln2_b[l * 1024 + d0 + i];
    o[i] = x2;
    if (l == 0) hh[i] = x2 * (1.f + mn[1024 + d0 + i]) + mn[d0 + i];
  }
#pragma unroll
  for (int i = 0; i < 4; ++i) *(float4*)(xw + d0 + i * 4) = make_float4(o[i * 4], o[i * 4 + 1], o[i * 4 + 2], o[i * 4 + 3]);
  if (l == 0) { *(uint4*)(hw + d0) = pack8(hh); *(uint4*)(hw + d0 + 8) = pack8(hh + 8); }
}

__device__ __forceinline__ void conf_task(const Params& P, int l, int tok_base, int len, int pos0, unsigned char* smem) {
  _Float16* u = (_Float16*)smem;
  const int c = tidx();
  __syncthreads();
  for (int i = 0; i < 94; ++i) {
    int pos = pos0 - 15 + i;
    float v = 0.f;
    if (pos >= 0 && pos < len) {
      const bf16_t* pr = P.Pbuf + (size_t)(tok_base + pos) * PST;
      v = bf2f(pr[c]) * sigmoidf_(bf2f(pr[256 + c]));
    }
    u[i * 256 + c] = (_Float16)v;
  }
  __syncthreads();
  float w[31];
#pragma unroll
  for (int j = 0; j < 31; ++j) w[j] = P.conf_dw_w[(l * 31 + j) * 256 + c];
  const float bias = P.conf_dw_b[l * 256 + c], ng = P.conf_norm_g[l * 256 + c], nb = P.conf_norm_b[l * 256 + c];
  for (int t = 0; t < 64; ++t) {
    float acc = bias;
#pragma unroll
    for (int j = 0; j < 31; ++j) acc += w[j] * (float)u[(t + j) * 256 + c];
    float mean = wave_sum(acc) * (1.f / 64.f);
    float d = acc - mean;
    float var = wave_sum(d * d) * (1.f / 64.f);
    float un = d * rsqrtf(var + LN_EPS) * ng + nb;
    P.Ybuf[(size_t)(tok_base + pos0 + t) * 1024 + c] = f2bf(siluf_(un));
  }
}

__device__ __forceinline__ void prep_task(const Params& P, int l, bool lat, int b, int pos0) {
  const int c = tidx();
  const int len = lat ? 2048 : 256;
  const int tok0 = lat ? b * 2048 + pos0 : NLAT + b * 256 + pos0;
  {
    bf16_t* dst = (lat ? P.vt_lat : P.vt_ctx) + ((size_t)b * 256 + c) * len + pos0;
    for (int t8 = 0; t8 < 8; ++t8) {
      unsigned wv[4];
#pragma unroll
      for (int k = 0; k < 4; ++k) {
        unsigned a = P.Pbuf[(size_t)(tok0 + t8 * 8 + k * 2) * PST + 1024 + c];
        unsigned bb = P.Pbuf[(size_t)(tok0 + t8 * 8 + k * 2 + 1) * PST + 1024 + c];
        wv[k] = a | (bb << 16);
      }
      *(uint4*)(dst + t8 * 8) = make_uint4(wv[0], wv[1], wv[2], wv[3]);
    }
  }
  if (lat) {
    const int hd = c & 63, i = hd & 31, hbase = c & ~63;
    const bool hi = hd >= 32;
    const int row = pos0 >> 6;
    const float* tc = P.ropetab; const float* ts = P.ropetab + 1024;
    for (int t = 0; t < 64; ++t) {
      const bf16_t* kr = P.Pbuf + (size_t)(tok0 + t) * PST + 768 + hbase;
      float x1 = bf2f(kr[i]), x2 = bf2f(kr[32 + i]);
      int pos = (i < 16) ? row : t;
      float cs = tc[pos * 16 + (i & 15)], sn = ts[pos * 16 + (i & 15)];
      float o = hi ? (x1 * sn + x2 * cs) : (x1 * cs - x2 * sn);
      P.krot[(size_t)(tok0 + t) * 256 + c] = f2bf(o);
    }
  }
  {
    float w[3][3], bsv[3];
#pragma unroll
    for (int q = 0; q < 3; ++q) {
      bsv[q] = P.hy_short_b[l * 768 + q * 256 + c];
#pragma unroll
      for (int k = 0; k < 3; ++k) w[q][k] = P.hy_short_w[(l * 3 + k) * 768 + q * 256 + c];
    }
    const size_t seqoff = lat ? ((size_t)b * 256 + c) * 2048 : (size_t)16 * 256 * 2048 + ((size_t)b * 256 + c) * 256;
    float pv[3], cu[3], nx[3];
#pragma unroll
    for (int q = 0; q < 3; ++q) {
      pv[q] = (pos0 > 0) ? bf2f(P.Pbuf[(size_t)(tok0 - 1) * PST + 1280 + q * 256 + c]) : 0.f;
      cu[q] = bf2f(P.Pbuf[(size_t)tok0 * PST + 1280 + q * 256 + c]);
    }
    for (int t8 = 0; t8 < 8; ++t8) {
      float uo[8], xo[8];
#pragma unroll
      for (int k = 0; k < 8; ++k) {
        int t = t8 * 8 + k;
        float r[3];
#pragma unroll
        for (int q = 0; q < 3; ++q) {
          nx[q] = (pos0 + t + 1 < len) ? bf2f(P.Pbuf[(size_t)(tok0 + t + 1) * PST + 1280 + q * 256 + c]) : 0.f;
          r[q] = w[q][0] * pv[q] + w[q][1] * cu[q] + w[q][2] * nx[q] + bsv[q];
          pv[q] = cu[q]; cu[q] = nx[q];
        }
        xo[k] = r[0]; uo[k] = r[2] * r[1];
      }
      *(uint4*)(P.uT + seqoff + pos0 + t8 * 8) = pack8(uo);
      *(uint4*)(P.x0T + seqoff + pos0 + t8 * 8) = pack8(xo);
    }
  }
}

__device__ __forceinline__ void hyfin_task(const Params& P, int l, bool lat, int b, int pos0) {
  const int c = tidx();
  const int tok0 = lat ? b * 2048 + pos0 : NLAT + b * 256 + pos0;
  const size_t seqoff = lat ? ((size_t)b * 256 + c) * 2048 : (size_t)16 * 256 * 2048 + ((size_t)b * 256 + c) * 256;
  const float skip = P.hy_bias[l * 256 + c];
  for (int t8 = 0; t8 < 8; ++t8) {
    float y[8], u[8], x0[8];
    unpack8(*(const uint4*)(P.yT + seqoff + pos0 + t8 * 8), y);
    unpack8(*(const uint4*)(P.uT + seqoff + pos0 + t8 * 8), u);
    unpack8(*(const uint4*)(P.x0T + seqoff + pos0 + t8 * 8), x0);
#pragma unroll
    for (int k = 0; k < 8; ++k)
      P.Ybuf[(size_t)(tok0 + t8 * 8 + k) * 1024 + 512 + c] = f2bf((y[k] + u[k] * skip) * x0[k]);
  }
}

__device__ __forceinline__ void hyconv_task(const Params& P, int l, bool lat, int c, int tb, unsigned char* smem) {
  const int L = lat ? 2048 : 256;
  unsigned* g = (unsigned*)smem;
  const int tid = tidx(), lane = tid & 63, wave = tid >> 6;
  __syncthreads();
  {
    const uint4* src = (const uint4*)gtab_ptr(P, l, lat ? 0 : 1, c);
    const int n16 = (4 * L * 2) / 16;
    for (int i = tid; i < n16; i += NTHREADS) ((uint4*)g)[i] = src[i];
  }
  __syncthreads();
  const int m = lane & 15, quad = lane >> 4;
  const size_t seqbase = lat ? 0 : (size_t)16 * 256 * 2048;
  bf16_t* ubuf = (bf16_t*)(smem + 4 * L * 2);
  const int pb0 = tid >> 5, pc0 = tid & 31;
  const bf16_t* ug0 = P.uT + seqbase + ((size_t)pb0 * 256 + c) * L + pc0 * 8;
  const bf16_t* ug1 = P.uT + seqbase + ((size_t)(pb0 + 8) * 256 + c) * L + pc0 * 8;
  const int t0 = tb + wave * 64;
  f32x4 acc[4];
#pragma unroll
  for (int i = 0; i < 4; ++i) acc[i] = (f32x4){0.f, 0.f, 0.f, 0.f};
  uint4 r0 = *(const uint4*)ug0, r1 = *(const uint4*)ug1;
  for (int s0 = 0; s0 < L; s0 += 256) {
    __syncthreads();
    *(uint4*)(ubuf + pb0 * 264 + pc0 * 8) = r0; *(uint4*)(ubuf + (pb0 + 8) * 264 + pc0 * 8) = r1;
    __syncthreads();
    if (s0 + 256 < L) { r0 = *(const uint4*)(ug0 + s0 + 256); r1 = *(const uint4*)(ug1 + s0 + 256); }
#pragma unroll
    for (int q = 0; q < 8; ++q) {
      const bf16x8 ufr = *(const bf16x8*)(ubuf + m * 264 + q * 32 + quad * 8);
#pragma unroll
      for (int i = 0; i < 4; ++i) {
        int o = (L - 1) + s0 + q * 32 - (t0 + i * 16) + quad * 8 - m;
        const unsigned* gp = g + (o & 1) * L + (o >> 1);
        uint4 tv = make_uint4(gp[0], gp[1], gp[2], gp[3]);
        acc[i] = mfma16(as_bf8(tv), ufr, acc[i]);
      }
    }
  }
  bf16_t* yb = P.yT + seqbase + ((size_t)m * 256 + c) * L;
#pragma unroll
  for (int i = 0; i < 4; ++i) {
    uint2 v; v.x = pack2(acc[i][0], acc[i][1]); v.y = pack2(acc[i][2], acc[i][3]);
    *(uint2*)(yb + t0 + i * 16 + quad * 4) = v;
  }
}

template <bool LOCAL>
__device__ __forceinline__ void attn_task(const Params& P, int l, int b, int r, int c0, int h, int lane) {
  const int n = lane & 15, quad = lane >> 4;
  const int qtok = LOCAL ? (b * 2048 + r * 64 + c0 + n) : (NLAT + b * 256 + c0 + n);
  const bf16_t* pq = P.Pbuf + (size_t)qtok * PST + 512 + h * 64 + quad * 8;
  const uint4 q0 = *(const uint4*)pq, q1 = *(const uint4*)(pq + 32);
  const bf16x8 qp0 = as_bf8(q0), qp1 = as_bf8(q1);
  bf16x8 qr0 = qp0, qr1 = qp1;
  const int rs = min(max(r - 4, 0), 24), kc0 = min(max(c0 - 8, 0), 32);
  const int cq = c0 + n, cs_ = min(max(cq - 8, 0), 48);
  const float* rpb = P.na_rpb + ((size_t)l * 4 + h) * 15 * 31;
  if (LOCAL) {
    float x1[8], x2[8], a[8], bq[8];
    unpack8(q0, x1); unpack8(q1, x2);
    const int pos = (quad < 2) ? r : (c0 + n);
    const float* tc = P.ropetab + pos * 16 + (quad & 1) * 8;
    const float* ts = tc + 1024;
#pragma unroll
    for (int j = 0; j < 8; ++j) { float cs = tc[j], sn = ts[j]; a[j] = x1[j] * cs - x2[j] * sn; bq[j] = x1[j] * sn + x2[j] * cs; }
    qr0 = as_bf8(pack8(a)); qr1 = as_bf8(pack8(bq));
  }
  auto local_scores = [&](int g) -> f32x4 {
    const int i = g >> 1, half = g & 1;
    const int ktok = b * 2048 + (rs + i) * 64 + kc0 + half * 16 + n;
    const bf16_t* kp = P.krot + (size_t)ktok * 256 + h * 64 + quad * 8;
    f32x4 acc = (f32x4){0.f, 0.f, 0.f, 0.f};
    acc = mfma16(*(const bf16x8*)kp, qr0, acc);
    acc = mfma16(*(const bf16x8*)(kp + 32), qr1, acc);
    const float* rb = rpb + (rs + i - r + 7) * 31;
    f32x4 o;
#pragma unroll
    for (int rr = 0; rr < 4; ++rr) {
      int kcol = kc0 + half * 16 + quad * 4 + rr;
      bool valid = (kcol >= cs_) && (kcol < cs_ + 16);
      int bi = min(max(kcol - cq + 15, 0), 30);
      o[rr] = valid ? (acc[rr] * 0.125f + rb[bi]) : -1e30f;
    }
    return o;
  };
  auto ctx_scores = [&](int g) -> f32x4 {
    const int ktok = NLAT + b * 256 + g * 16 + n;
    const bf16_t* kp = P.Pbuf + (size_t)ktok * PST + 768 + h * 64 + quad * 8;
    f32x4 acc = (f32x4){0.f, 0.f, 0.f, 0.f};
    acc = mfma16(*(const bf16x8*)kp, qp0, acc);
    acc = mfma16(*(const bf16x8*)(kp + 32), qp1, acc);
    return acc * 0.125f;
  };
  float mx = -1e30f, sum = 0.f;
  f32x4 O[4];
#pragma unroll
  for (int i = 0; i < 4; ++i) O[i] = (f32x4){0.f, 0.f, 0.f, 0.f};
  auto block = [&](const bool loc, const int sb) {
    f32x4 sc[8];
#pragma unroll
    for (int q = 0; q < 8; ++q) sc[q] = loc ? local_scores(sb * 8 + q) : ctx_scores(sb * 8 + q);
    float bm = -1e30f;
#pragma unroll
    for (int q = 0; q < 8; ++q) bm = fmaxf(bm, fmaxf(fmaxf(sc[q][0], sc[q][1]), fmaxf(sc[q][2], sc[q][3])));
    bm = fmaxf(bm, __shfl_xor(bm, 16)); bm = fmaxf(bm, __shfl_xor(bm, 32));
    const float mnew = fmaxf(mx, bm);
    const float scale = __expf(mx - mnew);
    mx = mnew; sum *= scale;
#pragma unroll
    for (int dt = 0; dt < 4; ++dt) O[dt] *= scale;
#pragma unroll
    for (int pr = 0; pr < 4; ++pr) {
      const int ip = sb * 4 + pr;
      float pa[4], pbv[4];
#pragma unroll
      for (int rr = 0; rr < 4; ++rr) { pa[rr] = __expf(sc[2 * pr][rr] - mx); pbv[rr] = __expf(sc[2 * pr + 1][rr] - mx); sum += pa[rr] + pbv[rr]; }
      uint4 pb; pb.x = pack2(pa[0], pa[1]); pb.y = pack2(pa[2], pa[3]); pb.z = pack2(pbv[0], pbv[1]); pb.w = pack2(pbv[2], pbv[3]);
#pragma unroll
      for (int dt = 0; dt < 4; ++dt) {
        const bf16_t* vp = loc ? P.vt_lat + ((size_t)(b * 4 + h) * 64 + dt * 16 + n) * 2048 + (rs + ip) * 64 + kc0 + quad * 4
                               : P.vt_ctx + ((size_t)(b * 4 + h) * 64 + dt * 16 + n) * 256 + ip * 32 + quad * 4;
        uint2 lo = *(const uint2*)vp, hi = *(const uint2*)(vp + 16);
        O[dt] = mfma16(as_bf8(make_uint4(lo.x, lo.y, hi.x, hi.y)), as_bf8(pb), O[dt]);
      }
    }
  };
  if (LOCAL) { block(true, 0); block(true, 1); }
  block(false, 0); block(false, 1);
  sum += __shfl_xor(sum, 16); sum += __shfl_xor(sum, 32);
  const float inv = 1.f / sum;
  bf16_t* yo = P.Ybuf + (size_t)qtok * 1024 + 256 + h * 64 + quad * 4;
#pragma unroll
  for (int dt = 0; dt < 4; ++dt) {
    uint2 v; v.x = pack2(O[dt][0] * inv, O[dt][1] * inv); v.y = pack2(O[dt][2] * inv, O[dt][3] * inv);
    *(uint2*)(yo + dt * 16) = v;
  }
}

template <bool PASS3>
__device__ __forceinline__ void ssd_task(const Params& P, int l, int b, int g, int ch, unsigned char* smem) {
  _Float16* xs = (_Float16*)smem;
  _Float16* Bs = xs + 64 * 128;
  _Float16* Cs = Bs + 64 * 64;
  float* dts = (float*)(Cs + 64 * 64);
  float* decs = dts + 256;
  float* as_ = decs + 256;
  _Float16* yt = (_Float16*)(as_ + 256);
  const int tid = tidx();
  const bool lat = ch >= 4;
  const int len = lat ? 2048 : 256;
  const int pos0 = lat ? (ch - 4) * 64 : ch * 64;
  const int tok0 = lat ? b * 2048 + pos0 : NLAT + b * 256 + pos0;
  __syncthreads();
  {
    const int col = (tid < 128) ? g * 128 + tid : (tid < 192 ? 256 + g * 64 + (tid - 128) : 384 + g * 64 + (tid - 192));
    const float w0 = P.ssd_conv_w[(l * 3 + 0) * 512 + col], w1 = P.ssd_conv_w[(l * 3 + 1) * 512 + col], w2 = P.ssd_conv_w[(l * 3 + 2) * 512 + col];
    const float bs = P.ssd_conv_b[l * 512 + col];
    const bf16_t* pp = P.Pbuf + (size_t)tok0 * PST + 2304 + col;
    float pv = (pos0 > 0) ? bf2f(pp[-(ptrdiff_t)PST]) : 0.f;
    float cu = bf2f(pp[0]);
    _Float16* dst = (tid < 128) ? xs + tid : (tid < 192 ? Bs + (tid - 128) : Cs + (tid - 192));
    const int dstride = (tid < 128) ? 128 : 64;
    for (int t = 0; t < 64; ++t) {
      float nx = (pos0 + t + 1 < len) ? bf2f(pp[(size_t)(t + 1) * PST]) : 0.f;
      float v = siluf_(w0 * pv + w1 * cu + w2 * nx + bs);
      dst[t * dstride] = (_Float16)v;
      pv = cu; cu = nx;
    }
    {
      const int t = tid >> 2, k = tid & 3, dir = k >> 1, hh = k & 1, head = g * 2 + hh;
      float raw = P.dtbuf[(size_t)(tok0 + t) * 8 + dir * 4 + head] + P.ssd_dt_bias[(l * 2 + dir) * 4 + head];
      float dtv = (raw > 20.f) ? raw : log1pf(expf(raw));
      float a = -dtv * expf(P.ssd_a_log[(l * 2 + dir) * 4 + head]);
      dts[tid] = dtv; as_[tid] = a; decs[tid] = expf(a);
    }
    if (PASS3) for (int i = tid; i < 64 * 128; i += NTHREADS) yt[i] = (_Float16)0.f;
  }
  __syncthreads();
  const int hh = tid >> 7, p = (tid >> 1) & 63, nh = tid & 1;
  const int head = g * 2 + hh;
  float stf[32], stb[32];
  float* sf = P.sst + ((((size_t)b * 2 + 0) * 4 + head) * NCH + ch) * 4096 + p * 64 + nh * 32;
  float* sb = P.sst + ((((size_t)b * 2 + 1) * 4 + head) * NCH + ch) * 4096 + p * 64 + nh * 32;
  if (PASS3) {
#pragma unroll
    for (int i = 0; i < 8; ++i) {
      float4 a = *(const float4*)(sf + i * 4); stf[i * 4] = a.x; stf[i * 4 + 1] = a.y; stf[i * 4 + 2] = a.z; stf[i * 4 + 3] = a.w;
      float4 c = *(const float4*)(sb + i * 4); stb[i * 4] = c.x; stb[i * 4 + 1] = c.y; stb[i * 4 + 2] = c.z; stb[i * 4 + 3] = c.w;
    }
  } else {
#pragma unroll
    for (int i = 0; i < 32; ++i) { stf[i] = 0.f; stb[i] = 0.f; }
  }
  for (int k = 0; k < 64; ++k) {
    {
      const float dtv = dts[k * 4 + hh], dec = decs[k * 4 + hh];
      const float xd = (float)xs[k * 128 + hh * 64 + p] * dtv;
      const _Float16* br = Bs + k * 64 + nh * 32;
#pragma unroll
      for (int i = 0; i < 32; ++i) stf[i] = stf[i] * dec + xd * (float)br[i];
      if (PASS3) {
        const _Float16* cr = Cs + k * 64 + nh * 32;
        float y0 = 0.f, y1 = 0.f, y2 = 0.f, y3 = 0.f;
#pragma unroll
        for (int i = 0; i < 32; i += 4) { y0 += stf[i] * (float)cr[i]; y1 += stf[i + 1] * (float)cr[i + 1]; y2 += stf[i + 2] * (float)cr[i + 2]; y3 += stf[i + 3] * (float)cr[i + 3]; }
        float y = (y0 + y1) + (y2 + y3);
        y += __shfl_xor(y, 1);
        if (nh == 0) { _Float16* yp = yt + k * 128 + hh * 64 + p; *yp = (_Float16)((float)*yp + y); }
      }
    }
    {
      const int kk = 63 - k;
      const float dtv = dts[kk * 4 + 2 + hh], dec = decs[kk * 4 + 2 + hh];
      const float xd = (float)xs[kk * 128 + hh * 64 + p] * dtv;
      const _Float16* br = Bs + kk * 64 + nh * 32;
#pragma unroll
      for (int i = 0; i < 32; ++i) stb[i] = stb[i] * dec + xd * (float)br[i];
      if (PASS3) {
        const _Float16* cr = Cs + kk * 64 + nh * 32;
        float y0 = 0.f, y1 = 0.f, y2 = 0.f, y3 = 0.f;
#pragma unroll
        for (int i = 0; i < 32; i += 4) { y0 += stb[i] * (float)cr[i]; y1 += stb[i + 1] * (float)cr[i + 1]; y2 += stb[i + 2] * (float)cr[i + 2]; y3 += stb[i + 3] * (float)cr[i + 3]; }
        float y = (y0 + y1) + (y2 + y3);
        y += __shfl_xor(y, 1);
        if (nh == 0) { _Float16* yp = yt + kk * 128 + hh * 64 + p; *yp = (_Float16)((float)*yp + y); }
      }
    }
  }
  if (!PASS3) {
#pragma unroll
    for (int i = 0; i < 8; ++i) {
      *(float4*)(sf + i * 4) = make_float4(stf[i * 4], stf[i * 4 + 1], stf[i * 4 + 2], stf[i * 4 + 3]);
      *(float4*)(sb + i * 4) = make_float4(stb[i * 4], stb[i * 4 + 1], stb[i * 4 + 2], stb[i * 4 + 3]);
    }
    if (tid < 4) {
      const int dir = tid >> 1, h2 = tid & 1;
      float a = 0.f;
      for (int t = 0; t < 64; ++t) a += as_[t * 4 + tid];
      P.ssumA[(((size_t)b * 2 + dir) * 4 + g * 2 + h2) * NCH + ch] = a;
    }
  } else {
    __syncthreads();
    const int t = tid >> 2, part = tid & 3;
    const int hd = g * 2 + (part >> 1);
    const float dsk = P.ssd_d[l * 4 + hd];
    float val[32];
    float sq = 0.f;
    const bf16_t* zr = P.Pbuf + (size_t)(tok0 + t) * PST + 2048 + g * 128 + part * 32;
#pragma unroll
    for (int i = 0; i < 32; ++i) {
      int cc = part * 32 + i;
      float y = (float)yt[t * 128 + cc] + (float)xs[t * 128 + cc] * dsk;
      float z = bf2f(zr[i]);
      y *= siluf_(z);
      val[i] = y; sq += y * y;
    }
    sq += __shfl_xor(sq, 1); sq += __shfl_xor(sq, 2);
    const float rinv = rsqrtf(sq * (1.f / 128.f) + LN_EPS);
    bf16_t* yo = P.Ybuf + (size_t)(tok0 + t) * 1024 + 768 + g * 128 + part * 32;
    const float* ngp = P.ssd_norm_g + l * 256 + g * 128 + part * 32;
#pragma unroll
    for (int i8 = 0; i8 < 4; ++i8) {
      float f[8];
#pragma unroll
      for (int j = 0; j < 8; ++j) f[j] = val[i8 * 8 + j] * rinv * ngp[i8 * 8 + j];
      *(uint4*)(yo + i8 * 8) = pack8(f);
    }
  }
}


typedef _Float16 h8v_t __attribute__((ext_vector_type(8)));
__device__ __forceinline__ void ssd1m_task(const Params& P, int l, int b, int g, int ch, unsigned char* smem) {
  _Float16* xT = (_Float16*)smem;
  _Float16* bT = xT + 128 * 72;
  float* dts = (float*)(bT + 64 * 72);
  float* as_ = dts + 256;
  float* wv = as_ + 256;
  const int tid = tidx(), lane = tid & 63, wave = tid >> 6;
  const bool lat = ch >= 4;
  const int len = lat ? 2048 : 256;
  const int pos0 = lat ? (ch - 4) * 64 : ch * 64;
  const int tok0 = lat ? b * 2048 + pos0 : NLAT + b * 256 + pos0;
  __syncthreads();
  if (tid < 192) {
    const int col = (tid < 128) ? g * 128 + tid : 256 + g * 64 + (tid - 128);
    const float w0 = P.ssd_conv_w[(l * 3 + 0) * 512 + col], w1 = P.ssd_conv_w[(l * 3 + 1) * 512 + col], w2 = P.ssd_conv_w[(l * 3 + 2) * 512 + col];
    const float bs = P.ssd_conv_b[l * 512 + col];
    const bf16_t* pp = P.Pbuf + (size_t)tok0 * PST + 2304 + col;
    float pv = (pos0 > 0) ? bf2f(pp[-(ptrdiff_t)PST]) : 0.f;
    float cu = bf2f(pp[0]);
    _Float16* dst = (tid < 128) ? xT + tid * 72 : bT + (tid - 128) * 72;
    for (int t = 0; t < 64; ++t) {
      float nx = (pos0 + t + 1 < len) ? bf2f(pp[(size_t)(t + 1) * PST]) : 0.f;
      dst[t] = (_Float16)siluf_(w0 * pv + w1 * cu + w2 * nx + bs);
      pv = cu; cu = nx;
    }
  }
  {
    const int t = tid >> 2, k = tid & 3, dir = k >> 1, head = g * 2 + (k & 1);
    float raw = P.dtbuf[(size_t)(tok0 + t) * 8 + dir * 4 + head] + P.ssd_dt_bias[(l * 2 + dir) * 4 + head];
    float dtv = (raw > 20.f) ? raw : log1pf(expf(raw));
    dts[k * 64 + t] = dtv; as_[k * 64 + t] = -dtv * expf(P.ssd_a_log[(l * 2 + dir) * 4 + head]);
  }
  __syncthreads();
  if (tid < 4) {
    const int k = tid, dir = k >> 1;
    float sacc = 0.f;
    if (dir == 0) { for (int t = 63; t >= 0; --t) { wv[k * 64 + t] = dts[k * 64 + t] * expf(sacc); sacc += as_[k * 64 + t]; } }
    else          { for (int t = 0; t < 64; ++t)  { wv[k * 64 + t] = dts[k * 64 + t] * expf(sacc); sacc += as_[k * 64 + t]; } }
    P.ssumA[(((size_t)b * 2 + dir) * 4 + g * 2 + (k & 1)) * NCH + ch] = sacc;
  }
  __syncthreads();
  const int k = wave, dir = k >> 1, hh = k & 1, head = g * 2 + hh;
  const int m = lane & 15, quad = lane >> 4;
  f32x4 acc[4][4];
#pragma unroll
  for (int i = 0; i < 4; ++i)
#pragma unroll
    for (int j = 0; j < 4; ++j) acc[i][j] = (f32x4){0.f, 0.f, 0.f, 0.f};
#pragma unroll
  for (int ks = 0; ks < 2; ++ks) {
    float w8[8];
#pragma unroll
    for (int j = 0; j < 8; ++j) w8[j] = wv[k * 64 + ks * 32 + quad * 8 + j];
    h8v_t bfrag[4];
#pragma unroll
    for (int pi = 0; pi < 4; ++pi) {
      const h8v_t raw = *(const h8v_t*)(xT + (hh * 64 + pi * 16 + m) * 72 + ks * 32 + quad * 8);
#pragma unroll
      for (int j = 0; j < 8; ++j) bfrag[pi][j] = (_Float16)((float)raw[j] * w8[j]);
    }
#pragma unroll
    for (int ni = 0; ni < 4; ++ni) {
      const h8v_t afrag = *(const h8v_t*)(bT + (ni * 16 + m) * 72 + ks * 32 + quad * 8);
#pragma unroll
      for (int pi = 0; pi < 4; ++pi) acc[ni][pi] = __builtin_amdgcn_mfma_f32_16x16x32_f16(afrag, bfrag[pi], acc[ni][pi], 0, 0, 0);
    }
  }
  float* sp = P.sst + ((((size_t)b * 2 + dir) * 4 + head) * NCH + ch) * 4096;
#pragma unroll
  for (int ni = 0; ni < 4; ++ni)
#pragma unroll
    for (int pi = 0; pi < 4; ++pi)
      *(float4*)(sp + (pi * 16 + m) * 64 + ni * 16 + quad * 4) = make_float4(acc[ni][pi][0], acc[ni][pi][1], acc[ni][pi][2], acc[ni][pi][3]);
}

__device__ __forceinline__ void ssd_prefix_task(const Params& P, int bdh, int part) {
  const int dir = (bdh >> 2) & 1;
  float* base = P.sst + (size_t)bdh * NCH * 4096 + part * 256 + tidx();
  const float* sa = P.ssumA + (size_t)bdh * NCH;
  float carry = 0.f;
  for (int i = 0; i < NCH; ++i) {
    int ch = dir ? (i < 4 ? 3 - i : 39 - i) : i;
    float loc = base[(size_t)ch * 4096];
    base[(size_t)ch * 4096] = carry;
    carry = expf(sa[ch]) * carry + loc;
  }
}

__device__ __forceinline__ int f2key(float f) { int b = __float_as_int(f); return b ^ ((b >> 31) & 0x7FFFFFFF); }
__device__ __forceinline__ float key2f(int k) { return __int_as_float(k ^ ((k >> 31) & 0x7FFFFFFF)); }
#define CE_DESC(a, b) { int _x = max(a, b); int _y = min(a, b); a = _x; b = _y; }
#define CE_ASC(a, b) { int _x = min(a, b); int _y = max(a, b); a = _x; b = _y; }
__device__ __forceinline__ void sort16_desc(int* a) {
#pragma unroll
  for (int k = 2; k <= 16; k <<= 1)
#pragma unroll
    for (int j = k >> 1; j > 0; j >>= 1)
#pragma unroll
      for (int i = 0; i < 16; ++i) {
        int lq = i ^ j;
        if (lq > i) { if ((i & k) == 0) CE_DESC(a[i], a[lq]) else CE_ASC(a[i], a[lq]) }
      }
}
__device__ __forceinline__ void merge16_desc(int* a, const int* b) {
#pragma unroll
  for (int i = 0; i < 16; ++i) a[i] = max(a[i], b[15 - i]);
#pragma unroll
  for (int j = 8; j > 0; j >>= 1)
#pragma unroll
    for (int i = 0; i < 16; ++i) {
      int lq = i ^ j;
      if (lq > i) CE_DESC(a[i], a[lq])
    }
}

__device__ __forceinline__ void gemm_acc32(const bf16_t* __restrict__ A, int lda, const bf16_t* __restrict__ Bt, int ldb,
                                           int K, int m0, int n0, unsigned char* smem, f32x4 (&acc)[4][4]) {
  bf16_t* As = (bf16_t*)smem;
  bf16_t* Bs = As + 2 * 128 * 40;
  const int tid = tidx(), lane = tid & 63, wave = tid >> 6;
  const int wm = wave >> 1, wn = wave & 1;
  const int lr = tid >> 1, lh = tid & 1;
  const bf16_t* ag = A + (size_t)(m0 + lr) * lda + lh * 16;
  const bf16_t* bg = Bt + (size_t)(n0 + lr) * ldb + lh * 16;
#pragma unroll
  for (int i = 0; i < 4; ++i)
#pragma unroll
    for (int j = 0; j < 4; ++j) acc[i][j] = (f32x4){0.f, 0.f, 0.f, 0.f};
  uint4 ra0 = *(const uint4*)ag, ra1 = *(const uint4*)(ag + 8);
  uint4 rb0 = *(const uint4*)bg, rb1 = *(const uint4*)(bg + 8);
  __syncthreads();
  {
    bf16_t* pa = As + lr * 40 + lh * 16; bf16_t* pb = Bs + lr * 40 + lh * 16;
    *(uint4*)pa = ra0; *(uint4*)(pa + 8) = ra1; *(uint4*)pb = rb0; *(uint4*)(pb + 8) = rb1;
  }
  __syncthreads();
  const int nk = K >> 5;
  for (int kt = 0; kt < nk; ++kt) {
    const int cur = kt & 1;
    if (kt + 1 < nk) {
      const bf16_t* a2 = ag + (kt + 1) * 32; const bf16_t* b2 = bg + (kt + 1) * 32;
      ra0 = *(const uint4*)a2; ra1 = *(const uint4*)(a2 + 8); rb0 = *(const uint4*)b2; rb1 = *(const uint4*)(b2 + 8);
    }
    const bf16_t* as = As + cur * 5120 + (wm * 64 + (lane & 15)) * 40 + (lane >> 4) * 8;
    const bf16_t* bs = Bs + cur * 5120 + (wn * 64 + (lane & 15)) * 40 + (lane >> 4) * 8;
    bf16x8 afr[4];
#pragma unroll
    for (int j = 0; j < 4; ++j) afr[j] = *(const bf16x8*)(bs + j * 16 * 40);
#pragma unroll
    for (int i = 0; i < 4; ++i) {
      const bf16x8 bfr = *(const bf16x8*)(as + i * 16 * 40);
#pragma unroll
      for (int j = 0; j < 4; ++j) acc[i][j] = mfma16(afr[j], bfr, acc[i][j]);
    }
    if (kt + 1 < nk) {
      bf16_t* pa = As + (cur ^ 1) * 5120 + lr * 40 + lh * 16; bf16_t* pb = Bs + (cur ^ 1) * 5120 + lr * 40 + lh * 16;
      *(uint4*)pa = ra0; *(uint4*)(pa + 8) = ra1; *(uint4*)pb = rb0; *(uint4*)(pb + 8) = rb1;
    }
    __syncthreads();
  }
}

__device__ __forceinline__ void peer_topk_task(const Params& P, int l, int tm, int h, unsigned char* smem) {
  float* sc = (float*)smem;
  int* fin = (int*)(smem + 33280);
  const int tid = tidx(), lane = tid & 63, wave = tid >> 6;
  const int wm = wave >> 1, wn = wave & 1;
  const int row64 = tid & 63, quarter = tid >> 6;
  int* K1 = (int*)(smem + 40960);
  int* K2a = (int*)(smem + 49152);
#pragma unroll
  for (int pp = 0; pp < 2; ++pp) {
    const bf16_t* A = P.qbuf + (h * 2 + pp) * 128;
    const bf16_t* Bt = P.keysb + ((size_t)(l * 8 + h) * 2 + pp) * 128 * 128;
#pragma unroll 1
    for (int half = 0; half < 2; ++half) {
      {
        f32x4 acc[4][4];
        gemm_acc32(A, 2048, Bt, 128, 128, tm * 128, 0, smem, acc);
        if (wm == half) {
#pragma unroll
          for (int i = 0; i < 4; ++i)
#pragma unroll
            for (int j = 0; j < 4; ++j) {
              float* d = sc + (i * 16 + (lane & 15)) * 129 + wn * 64 + j * 16 + (lane >> 4) * 4;
              d[0] = acc[i][j][0]; d[1] = acc[i][j][1]; d[2] = acc[i][j][2]; d[3] = acc[i][j][3];
            }
        }
      }
      __syncthreads();
      int run[16];
#pragma unroll
      for (int i = 0; i < 16; ++i) run[i] = (int)0x80000000;
#pragma unroll 1
      for (int grp = 0; grp < 2; ++grp) {
        int cur[16];
#pragma unroll
        for (int i = 0; i < 16; ++i) {
          int col = quarter * 32 + grp * 16 + i;
          cur[i] = (f2key(sc[row64 * 129 + col]) & ~127) | col;
        }
        sort16_desc(cur);
        merge16_desc(run, cur);
      }
      if (quarter != 0) {
#pragma unroll
        for (int i = 0; i < 16; ++i) sc[row64 * 129 + quarter * 32 + i] = __int_as_float(run[i]);
      }
      __syncthreads();
      if (quarter == 0) {
#pragma unroll 1
        for (int q = 1; q < 4; ++q) {
          int oth[16];
#pragma unroll
          for (int i = 0; i < 16; ++i) oth[i] = __float_as_int(sc[row64 * 129 + q * 32 + i]);
          merge16_desc(run, oth);
        }
        if (half == 0) {
#pragma unroll
          for (int i = 0; i < 16; ++i) { if (pp == 0) K1[row64 * 16 + i] = run[i]; else K2a[row64 * 16 + i] = run[i]; }
        } else {
#pragma unroll
          for (int i = 0; i < 16; ++i) fin[row64 * 16 + i] = run[i];
        }
      }
      __syncthreads();
    }
    if (pp == 0 && tid >= 64 && tid < 128) {
#pragma unroll
      for (int i = 0; i < 16; ++i) K1[tid * 16 + i] = fin[(tid - 64) * 16 + i];
    }
    __syncthreads();
  }
  const int row = tid & 127, half = tid >> 7;
  int* lists = (int*)smem;
  if (half == 0) {
#pragma unroll
    for (int i = 0; i < 16; ++i) { lists[row * 33 + i] = K1[row * 16 + i]; lists[row * 33 + 16 + i] = (row < 64) ? K2a[row * 16 + i] : fin[(row - 64) * 16 + i]; }
  }
  if (half == 0) {
    float v2[16];
#pragma unroll
    for (int i = 0; i < 16; ++i) v2[i] = key2f(lists[row * 33 + 16 + i] & ~127);
    int run[16];
    {
      const float v0 = key2f(lists[row * 33] & ~127);
#pragma unroll
      for (int j = 0; j < 16; ++j) run[j] = (f2key(v0 + v2[j]) & ~255) | (15 - j);
    }
#pragma unroll 1
    for (int i = 1; i < 16; ++i) {
      int cur[16];
      const float vi = key2f(lists[row * 33 + i] & ~127);
#pragma unroll
      for (int j = 0; j < 16; ++j) cur[j] = (f2key(vi + v2[j]) & ~255) | (i * 16 + 15 - j);
      merge16_desc(run, cur);
    }
    const float c0 = key2f(run[0] & ~255);
    float sum = 0.f;
#pragma unroll
    for (int k = 0; k < 16; ++k) sum += __expf(key2f(run[k] & ~255) - c0);
    const float inv = 1.f / sum;
    const int T = tm * 128 + row;
    int* eo = P.eidx + (size_t)T * 128 + h * 16;
    float* go = P.egate + (size_t)T * 128 + h * 16;
#pragma unroll
    for (int k = 0; k < 16; ++k) {
      int ci = run[k] & 255;
      int i = ci >> 4, j = 15 - (ci & 15);
      int i1 = lists[row * 33 + i] & 127, i2 = lists[row * 33 + 16 + j] & 127;
      eo[k] = i1 * 128 + i2;
      go[k] = __expf(key2f(run[k] & ~255) - c0) * inv;
    }
  }
}

#define XB_TMO      128
#define XB_XCNT(j)  (256  + 64 * (j))
#define XB_XSUB(j)  (1280 + 64 * (j))
#define XB_XGEN(j)  (2304 + 64 * (j))
#define XB_TOP      3328
#define XB_TOPGEN   3392
#define XCD_BAR_WORDS 3456
#define XB_SPIN_CAP (1u << 18)
#define LAS __attribute__((address_space(3)))

__device__ __forceinline__ unsigned xb_ld(unsigned* p)              { return __hip_atomic_load(p, __ATOMIC_RELAXED, __HIP_MEMORY_SCOPE_AGENT); }
__device__ __forceinline__ unsigned xb_add(unsigned* p, unsigned v) { return __hip_atomic_fetch_add(p, v, __ATOMIC_RELAXED, __HIP_MEMORY_SCOPE_AGENT); }
__device__ __forceinline__ unsigned xb_xcc_id() { return (unsigned)__builtin_amdgcn_s_getreg((3 << 11) | 20) & 0xFu; }
#define XB_SPIN(cond, bar) do { unsigned _sp = 0; while (cond) { __builtin_amdgcn_s_sleep(1); \
    if ((++_sp & 255u) == 0u) { if (xb_ld(&(bar)[XB_TMO])) break; if (_sp > XB_SPIN_CAP) { atomicAdd(&(bar)[XB_TMO], 1u); break; } } } } while (0)

struct XcdBarrier {
    unsigned* bar; unsigned x;
    volatile LAS unsigned* st;
};

__device__ __forceinline__ XcdBarrier xcd_barrier_post(unsigned* bar, volatile LAS unsigned* st) {
    XcdBarrier b; b.bar = bar; b.x = xb_xcc_id(); b.st = st;
    if (threadIdx.x == 0) (void)xb_add(&bar[XB_XCNT(b.x)], 1u);
    return b;
}
__device__ __forceinline__ void xcd_barrier_complete(unsigned* bar, unsigned x, unsigned& nloc, unsigned& nx) {
    const unsigned G = gridDim.x * gridDim.y * gridDim.z;
    unsigned sum, cnt, mine, sp = 0u;
    for (;;) {
        sum = 0u; cnt = 0u; mine = 0u;
#pragma unroll
        for (unsigned j = 0; j < 16; ++j) { const unsigned c = xb_ld(&bar[XB_XCNT(j)]); sum += c; cnt += (c > 0u) ? 1u : 0u; mine = (j == x) ? c : mine; }
        if (sum == G) break;
        __builtin_amdgcn_s_sleep(1);
        if ((++sp & 255u) == 0u) { if (xb_ld(&bar[XB_TMO])) break; if (sp > XB_SPIN_CAP) { atomicAdd(&bar[XB_TMO], 1u); break; } }
    }
    nloc = mine > 0u ? mine : 1u; nx = cnt > 0u ? cnt : 1u;
}

__device__ __forceinline__ void xcd_barrier(const XcdBarrier& b) {
    asm volatile("s_waitcnt vmcnt(0)" ::: "memory");
    __syncthreads();
    if (threadIdx.x == 0) {
        unsigned* bar = b.bar;
        __builtin_amdgcn_s_waitcnt(0);
        unsigned nloc = b.st[0], nx = b.st[1];
        if (nloc == 0u) { xcd_barrier_complete(bar, b.x, nloc, nx); b.st[0] = nloc; b.st[1] = nx; }
        const unsigned old = xb_add(&bar[XB_XSUB(b.x)], 1u);
        const unsigned gen = old / nloc;
        if (old + 1u == (gen + 1u) * nloc) {
            __builtin_amdgcn_fence(__ATOMIC_RELEASE, "agent");
            asm volatile("s_waitcnt vmcnt(0)" ::: "memory");
            const unsigned og = xb_add(&bar[XB_TOP], 1u);
            const unsigned tg = og / nx;
            if (og + 1u == (tg + 1u) * nx) xb_add(&bar[XB_TOPGEN], 1u);
            else XB_SPIN(xb_ld(&bar[XB_TOPGEN]) == tg, bar);
            __builtin_amdgcn_fence(__ATOMIC_ACQUIRE, "agent");
            xb_add(&bar[XB_XGEN(b.x)], 1u);
            asm volatile("s_waitcnt vmcnt(0)" ::: "memory");
        } else {
            XB_SPIN(xb_ld(&bar[XB_XGEN(b.x)]) == gen, bar);
            __builtin_amdgcn_fence(__ATOMIC_ACQUIRE, "agent");
            asm volatile("s_waitcnt vmcnt(0)" ::: "memory");
        }
    }
    __syncthreads();
}


__device__ __forceinline__ int next_task(unsigned* cnt, int* slot) {
  __syncthreads();
  if (tidx() == 0) *slot = (int)__hip_atomic_fetch_add(cnt, 1u, __ATOMIC_RELAXED, __HIP_MEMORY_SCOPE_AGENT);
  __syncthreads();
  return *slot;
}
enum { PH_PRE0 = 0, PH_PRE1, PH_PRE2, PH_L1, PH_L2, PH_L3, PH_L4, PH_L5, PH_L6, PH_L7, PH_L8, PH_L9, PH_L9W, PH_L9B, PH_L9C, PH_COUNT };
struct XInfo { int slot, nx, rank, nloc; };
#define QCNT(i) (XCD_BAR_WORDS + 16 * 64 + 64 * (i))

template <int ph>
__device__ __forceinline__ void run_phase(const Params& P, const XInfo& X, int l, unsigned char* smem, const bool rep = false) {
  const int nb = gridDim.x, bid = blockIdx.x, tid = tidx(), lane = tid & 63, wave = tid >> 6;
  const int rbid = nb - 1 - bid;
  __shared__ int sQ;
  const int ntok = (l == 0) ? NTOK : NLAT;
  const int mt_out = ntok / 128;
  switch (ph) {
    case PH_PRE0: {
      for (int u = bid; u < 768; u += nb) modpart_task(P, u / 384, (u / 24) % 16, u % 24, smem);
      for (int u = rbid; u < 2 * 46 * 16; u += nb) { int ll = u / 736, r = u % 736; transpose_task(P.w_in + (size_t)ll * 1024 * 2824, P.wt_in + (size_t)ll * 2944 * 1024, 1024, 2824, (r % 16) * 64, (r / 16) * 64, smem); }
      for (int u = bid; u < 2 * 16 * 16; u += nb) { int ll = u / 256, r = u % 256; transpose_task(P.w_out + (size_t)ll * 1024 * 1024, P.wt_out + (size_t)ll * 1024 * 1024, 1024, 1024, (r % 16) * 64, (r / 16) * 64, smem); }
      for (int u = rbid; u < 2 * 32 * 16; u += nb) { int ll = u / 512, r = u % 512; transpose_task(P.peer_wq + (size_t)ll * 1024 * 2048, P.wt_q + (size_t)ll * 2048 * 1024, 1024, 2048, (r % 16) * 64, (r / 16) * 64, smem); }
      for (int u = bid; u < 256; u += nb) {
        size_t o = ((size_t)u * 256 + tid) * 8; float f[8];
#pragma unroll
        for (int j = 0; j < 8; ++j) f[j] = P.peer_keys[o + j];
        *(uint4*)(P.keysb + o) = pack8(f);
      }
      for (int u = rbid; u < 2 * 576; u += nb) { int ll = u / 576, r = u % 576; if (r < 512) hm2_task(P, ll, 0, r, smem); else hm2_task(P, ll, 1, r - 512, smem); }
      if (bid == nb - 1) {
        for (int i = tid; i < 1024; i += NTHREADS) {
          int pos = i >> 4, f = i & 15;
          float inv = powf(10000.f, -(float)f / 16.f);
          float ang = (float)pos * inv;
          P.ropetab[i] = cosf(ang); P.ropetab[1024 + i] = sinf(ang);
        }
      }
    } break;
    case PH_PRE1: {
      for (int t = bid; t < 816; t += nb) {
        int i = t * 256 + tid;
        int ll = i / (17 * 6144), rem = i % (17 * 6144), col = rem % 6144;
        float a = P.b_ada[ll * 6144 + col];
#pragma unroll
        for (int ks = 0; ks < 16; ++ks) a += P.modp[((size_t)ll * 16 + ks) * 17 * 6144 + rem];
        P.mod[i] = a;
      }
      for (int u = rbid; u < 2048; u += nb) filt_task(P, u >> 10, (u >> 9) & 1, u & 511, smem);
    } break;
    case PH_PRE2: {
      for (int T = bid * 4 + wave; T < NTOK; T += nb * 4) hmod0_token(P, T, lane);
    } break;
    case PH_L1: {
      const int ntile = (NTOK / 128) * 23;
      bf16_t* Pb = P.Pbuf; float* dtb = P.dtbuf;
      const bf16_t* Ain = P.Ybuf; const bf16_t* Win = P.wt_in + (size_t)l * 2944 * 1024;
      for (int t = bid; t < ntile; t += nb) {
        int tm = t / 23, tn = t % 23;
        gemm_tile32(Ain, 1024, Win, 1024, 1024, tm * 128, tn * 128, smem, [&](int m, int n, f32x4 v) {
          if (n < 2816) { uint2 o; o.x = pack2(v[0], v[1]); o.y = pack2(v[2], v[3]); *(uint2*)(Pb + (size_t)m * PST + n) = o; }
          else if (n < 2824) { *(float4*)(dtb + (size_t)m * 8 + (n - 2816)) = make_float4(v[0], v[1], v[2], v[3]); }
        });
      }
    } break;
    case PH_L2: {
      const int nS = NB * 2 * NCH, nCf = 512 + (l == 0 ? 64 : 0), nPr = 576;
      unsigned* cnt = P.bar + QCNT(l * 3 + 0);
      for (;;) {
        int u = next_task(cnt, &sQ);
        if (u >= nS + nCf + nPr) break;
        if (u < nS) { ssd1m_task(P, l, u / (2 * NCH), (u / NCH) & 1, u % NCH, smem); continue; }
        u -= nS;
        if (u < nCf) { if (u < 512) conf_task(P, l, (u >> 5) * 2048, 2048, (u & 31) * 64, smem); else { int v = u - 512; conf_task(P, l, NLAT + (v >> 2) * 256, 256, (v & 3) * 64, smem); } continue; }
        u -= nCf;
        if (u < 512) prep_task(P, l, true, u >> 5, (u & 31) * 64); else { int v = u - 512; prep_task(P, l, false, v >> 2, (v & 3) * 64); }
      }
    } break;
    case PH_L3: {
      const int nH = 2048 + (l == 0 ? 256 : 0), nA = 2048, nAc = (l == 0 ? 256 : 0), nPf = rep ? 0 : 2048;
      unsigned* cnt = P.bar + QCNT(l * 3 + 1);
      for (;;) {
        int u = next_task(cnt, &sQ);
        if (u >= nH + nA + nAc + nPf) break;
        if (u < nH) { if (u < 2048) hyconv_task(P, l, true, u >> 3, (u & 7) * 256, smem); else hyconv_task(P, l, false, u - 2048, 0, smem); continue; }
        u -= nH;
        if (u < nA) { int b = u >> 7, r = (u >> 2) & 31, c0 = (u & 3) * 16; attn_task<true>(P, l, b, r, c0, wave, lane); continue; }
        u -= nA;
        if (u < nAc) { attn_task<false>(P, l, u >> 4, 0, (u & 15) * 16, wave, lane); continue; }
        u -= nAc;
        ssd_prefix_task(P, u >> 4, u & 15);
      }
    } break;
    case PH_L4: {
      const int nS = (l == 0) ? NB * 2 * NCH : NB * 2 * 32, nHf = 512 + (l == 0 ? 64 : 0);
      unsigned* cnt = P.bar + QCNT(l * 3 + 2);
      for (;;) {
        int u = next_task(cnt, &sQ);
        if (u >= nS + nHf) break;
        if (u < nS) {
          if (l == 0) ssd_task<true>(P, l, u / (2 * NCH), (u / NCH) & 1, u % NCH, smem);
          else ssd_task<true>(P, l, u / 64, (u / 32) & 1, 4 + (u % 32), smem);
          continue;
        }
        u -= nS;
        if (u < 512) hyfin_task(P, l, true, u >> 5, (u & 31) * 64); else { int v = u - 512; hyfin_task(P, l, false, v >> 2, (v & 3) * 64); }
      }
    } break;
    case PH_L5: {
      const int ng = mt_out * 8;
      bf16_t* Yo = P.Pbuf;
      const bf16_t* Ain = P.Ybuf; const bf16_t* Wt = P.wt_out + (size_t)l * 1024 * 1024;
      for (int t = bid; t < ng; t += nb) {
        int tm = t >> 3, tn = t & 7;
        gemm_tile32(Ain, 1024, Wt, 1024, 1024, tm * 128, tn * 128, smem, [&](int m, int n, f32x4 v) {
          uint2 o; o.x = pack2(v[0], v[1]); o.y = pack2(v[2], v[3]); *(uint2*)(Yo + (size_t)m * 1024 + n) = o;
        });
      }
      for (int u = rbid; u < 4096; u += nb) {
        const bool isv = u >= 2048;
        const int e0 = (u & 2047) * 8;
        const float* src = (isv ? P.peer_v : P.peer_u) + (size_t)l * 16384 * 1024 + (size_t)e0 * 1024;
        unsigned char* dstb = (unsigned char*)(isv ? P.tabv : P.tabu);
#pragma unroll
        for (int i = 0; i < 2; ++i) {
          int o = (i * 256 + tid) * 16;
          float4 a = *(const float4*)(src + o), bq = *(const float4*)(src + o + 4), c = *(const float4*)(src + o + 8), d = *(const float4*)(src + o + 12);
          uint4 r;
          r.x = pack4_fp8(a.x * 256.f, a.y * 256.f, a.z * 256.f, a.w * 256.f);
          r.y = pack4_fp8(bq.x * 256.f, bq.y * 256.f, bq.z * 256.f, bq.w * 256.f);
          r.z = pack4_fp8(c.x * 256.f, c.y * 256.f, c.z * 256.f, c.w * 256.f);
          r.w = pack4_fp8(d.x * 256.f, d.y * 256.f, d.z * 256.f, d.w * 256.f);
          *(uint4*)(dstb + (size_t)e0 * 1024 + o) = r;
        }
      }
    } break;
    case PH_L6: {
      for (int T = bid * 4 + wave; T < ntok; T += nb * 4) r1_token(P, l, T, lane, rep);
    } break;
    case PH_L7: {
      const int ng = mt_out * 16;
      bf16_t* Q = P.qbuf;
      for (int t = bid; t < ng; t += nb) {
        int tm = t >> 4, tn = t & 15;
        gemm_tile32(P.Ybuf, 1024, P.wt_q + (size_t)l * 2048 * 1024, 1024, 1024, tm * 128, tn * 128, smem, [&](int m, int n, f32x4 v) {
          uint2 o; o.x = pack2(v[0], v[1]); o.y = pack2(v[2], v[3]); *(uint2*)(Q + (size_t)m * 2048 + n) = o;
        });
      }
    } break;
    case PH_L8: {
      const int ng = mt_out * 8;
      for (int t = bid; t < ng; t += nb) peer_topk_task(P, l, t >> 3, t & 7, smem);
    } break;
    case PH_L9: {
      float* wl = (float*)smem + wave * 128;
      __syncthreads();
      for (int T0 = bid * 4 + wave; T0 < ntok; T0 += nb * 4) { const int T = __builtin_amdgcn_readfirstlane(T0); peer_token(P, l, T, lane, wl, false); }
    } break;
    case PH_L9W: {
      const size_t n = (size_t)ntok * 128;
      for (size_t i = (size_t)bid * 256 + tid; i < n; i += (size_t)nb * 256) {
        float a = 0.f;
#pragma unroll
        for (int x = 0; x < 8; ++x) a += P.pact[(size_t)x * NTOK * 128 + i];
        P.egate[i] = P.egate[i] * gelu_tanh(a * (1.f / 256.f));
      }
    } break;
    case PH_L9B: {
      int* li = (int*)smem + wave * 1024;
      __syncthreads();
      for (int sl = X.slot; sl < 8; sl += X.nx)
        { const int pw = (ntok + X.nloc * 4 - 1) / (X.nloc * 4); const int tf = __builtin_amdgcn_readfirstlane((X.rank * 4 + wave) * pw); peer_v_phase(P, sl, tf, 1, min(ntok, tf + pw), lane, li); }
    } break;
    case PH_L9C: {
      for (int T0 = bid * 4 + wave; T0 < ntok; T0 += nb * 4) { const int T = __builtin_amdgcn_readfirstlane(T0); ln2_token(P, l, T, lane); }
    } break;
  }
}

#if MULTI_LAUNCH
__global__ void __launch_bounds__(NTHREADS) phase_kernel(Params P, int ph, int l) {
  extern __shared__ __attribute__((aligned(16))) unsigned char smem[];
  __shared__ Params sP;
  if (threadIdx.x == 0) sP = P;
  __syncthreads();
  switch (ph) {
    case 0: run_phase<0>(sP, sX, l, smem); break; case 1: run_phase<1>(sP, sX, l, smem); break; case 2: run_phase<2>(sP, sX, l, smem); break;
    case 3: run_phase<3>(sP, sX, l, smem); break; case 4: run_phase<4>(sP, sX, l, smem); break; case 5: run_phase<5>(sP, sX, l, smem); break;
    case 6: run_phase<6>(sP, sX, l, smem); break; case 7: run_phase<7>(sP, sX, l, smem); break; case 8: run_phase<8>(sP, sX, l, smem); break;
    case 9: run_phase<9>(sP, sX, l, smem); break; case 10: run_phase<10>(sP, sX, l, smem); break; case 11: run_phase<11>(sP, sX, l, smem); break;
  }
}
#else
__global__ void __launch_bounds__(NTHREADS, 3) mega_kernel(Params P) {
  extern __shared__ __attribute__((aligned(16))) unsigned char smem[];
  cg::grid_group grid = cg::this_grid();
  __shared__ uint4 xb_words;
  if (threadIdx.x == 0) xb_words = make_uint4(0u, 0u, 0u, 0u);
  __syncthreads();
  XcdBarrier xb = xcd_barrier_post(P.bar, (volatile LAS unsigned*)&xb_words);
  __shared__ XInfo sX;
  if (threadIdx.x == 0) sX.rank = (int)xb_add(&P.bar[XCD_BAR_WORDS + 64 * xb.x], 1u);
  run_phase<PH_PRE0>(P, sX, 0, smem);
  if (P.bar == nullptr) grid.sync();
  xcd_barrier(xb);
  if (threadIdx.x == 0) {
    int slot = 0, nx = 0, nloc = 1;
    for (unsigned j = 0; j < 16; ++j) {
      const int c = (int)xb_ld(&P.bar[XCD_BAR_WORDS + 64 * j]);
      if (c > 0) { if (j < xb.x) ++slot; ++nx; }
      if (j == xb.x) nloc = c > 0 ? c : 1;
    }
    sX.slot = slot; sX.nx = nx > 0 ? nx : 1; sX.nloc = nloc;
  }
  __syncthreads();
  run_phase<PH_PRE1>(P, sX, 0, smem); xcd_barrier(xb);
  run_phase<PH_PRE2>(P, sX, 0, smem); xcd_barrier(xb);
  {
    constexpr int l = 0;
    run_phase<PH_L1>(P, sX, l, smem); xcd_barrier(xb);
#if defined(REPEAT_PH)
    if (REPEAT_PH == PH_L1) { run_phase<PH_L1>(P, sX, l, smem, true); xcd_barrier(xb); }
#endif
    run_phase<PH_L2>(P, sX, l, smem); xcd_barrier(xb);
#if defined(REPEAT_PH)
    if (REPEAT_PH == PH_L2) { run_phase<PH_L2>(P, sX, l, smem, true); xcd_barrier(xb); }
#endif
    run_phase<PH_L3>(P, sX, l, smem); xcd_barrier(xb);
#if defined(REPEAT_PH)
    if (REPEAT_PH == PH_L3) { run_phase<PH_L3>(P, sX, l, smem, true); xcd_barrier(xb); }
#endif
    run_phase<PH_L4>(P, sX, l, smem); xcd_barrier(xb);
#if defined(REPEAT_PH)
    if (REPEAT_PH == PH_L4) { run_phase<PH_L4>(P, sX, l, smem, true); xcd_barrier(xb); }
#endif
    run_phase<PH_L5>(P, sX, l, smem); xcd_barrier(xb);
#if defined(REPEAT_PH)
    if (REPEAT_PH == PH_L5) { run_phase<PH_L5>(P, sX, l, smem, true); xcd_barrier(xb); }
#endif
    run_phase<PH_L6>(P, sX, l, smem); xcd_barrier(xb);
#if defined(REPEAT_PH)
    if (REPEAT_PH == PH_L6) { run_phase<PH_L6>(P, sX, l, smem, true); xcd_barrier(xb); }
#endif
    run_phase<PH_L7>(P, sX, l, smem); xcd_barrier(xb);
#if defined(REPEAT_PH)
    if (REPEAT_PH == PH_L7) { run_phase<PH_L7>(P, sX, l, smem, true); xcd_barrier(xb); }
#endif
    run_phase<PH_L8>(P, sX, l, smem); xcd_barrier(xb);
#if defined(REPEAT_PH)
    if (REPEAT_PH == PH_L8) { run_phase<PH_L8>(P, sX, l, smem, true); xcd_barrier(xb); }
#endif
    run_phase<PH_L9>(P, sX, l, smem); xcd_barrier(xb);
#if defined(REPEAT_PH)
    if (REPEAT_PH == PH_L9) { run_phase<PH_L9>(P, sX, l, smem, true); xcd_barrier(xb); }
#endif
  }
  {
    constexpr int l = 1;
    run_phase<PH_L1>(P, sX, l, smem); xcd_barrier(xb);
#if defined(REPEAT_PH)
    if (REPEAT_PH == PH_L1) { run_phase<PH_L1>(P, sX, l, smem, true); xcd_barrier(xb); }
#endif
    run_phase<PH_L2>(P, sX, l, smem); xcd_barrier(xb);
#if defined(REPEAT_PH)
    if (REPEAT_PH == PH_L2) { run_phase<PH_L2>(P, sX, l, smem, true); xcd_barrier(xb); }
#endif
    run_phase<PH_L3>(P, sX, l, smem); xcd_barrier(xb);
#if defined(REPEAT_PH)
    if (REPEAT_PH == PH_L3) { run_phase<PH_L3>(P, sX, l, smem, true); xcd_barrier(xb); }
#endif
    run_phase<PH_L4>(P, sX, l, smem); xcd_barrier(xb);
#if defined(REPEAT_PH)
    if (REPEAT_PH == PH_L4) { run_phase<PH_L4>(P, sX, l, smem, true); xcd_barrier(xb); }
#endif
    run_phase<PH_L5>(P, sX, l, smem); xcd_barrier(xb);
#if defined(REPEAT_PH)
    if (REPEAT_PH == PH_L5) { run_phase<PH_L5>(P, sX, l, smem, true); xcd_barrier(xb); }
#endif
    run_phase<PH_L6>(P, sX, l, smem); xcd_barrier(xb);
#if defined(REPEAT_PH)
    if (REPEAT_PH == PH_L6) { run_phase<PH_L6>(P, sX, l, smem, true); xcd_barrier(xb); }
#endif
    run_phase<PH_L7>(P, sX, l, smem); xcd_barrier(xb);
#if defined(REPEAT_PH)
    if (REPEAT_PH == PH_L7) { run_phase<PH_L7>(P, sX, l, smem, true); xcd_barrier(xb); }
#endif
    run_phase<PH_L8>(P, sX, l, smem); xcd_barrier(xb);
#if defined(REPEAT_PH)
    if (REPEAT_PH == PH_L8) { run_phase<PH_L8>(P, sX, l, smem, true); xcd_barrier(xb); }
#endif
    run_phase<PH_L9>(P, sX, l, smem); xcd_barrier(xb);
#if defined(REPEAT_PH)
    if (REPEAT_PH == PH_L9) { run_phase<PH_L9>(P, sX, l, smem, true); xcd_barrier(xb); }
#endif
  }
}
#endif

extern "C" void kernel_launch(void* const* d_in, const int* in_sizes, int n_in, void* d_out, int out_size, void* d_ws, size_t ws_size, hipStream_t stream) {
  Params P{};
  const float** pf = (const float**)&P;
  for (int i = 0; i < 36; ++i) pf[i] = (const float*)d_in[i];
  P.out = (float*)d_out;
  unsigned char* w = (unsigned char*)d_ws;
  size_t off = 0;
  auto take = [&](size_t bytes) { unsigned char* p = w + off; off += (bytes + 255) & ~(size_t)255; return p; };
  P.Pbuf = (bf16_t*)take((size_t)NTOK * PST * 2);
  P.Ybuf = (bf16_t*)take((size_t)NTOK * 1024 * 2);
  P.xc = (float*)take((size_t)4096 * 1024 * 4);
  P.dtbuf = (float*)take((size_t)NTOK * 8 * 4);
  P.wt_in = (bf16_t*)take((size_t)2 * 2944 * 1024 * 2);
  P.wt_out = (bf16_t*)take((size_t)2 * 1024 * 1024 * 2);
  P.wt_q = (bf16_t*)take((size_t)2 * 2048 * 1024 * 2);
  P.keysb = (bf16_t*)take((size_t)2 * 8 * 2 * 128 * 128 * 2);
  P.modp = (float*)take((size_t)2 * 16 * 17 * 6144 * 4);
  P.mod = (float*)take((size_t)3 * 17 * 6144 * 4);
  P.hm2 = (float*)take((size_t)2 * 2 * 2048 * 64 * 4);
  P.gtab = (bf16_t*)take((size_t)2 * (256 * 2 * 4096 + 256 * 2 * 512) * 2);
  P.ropetab = (float*)take(2048 * 4);
  P.bar = (unsigned*)take((XCD_BAR_WORDS + 16 * 64 + 8 * 64) * 4);
  unsigned char* treg = w + off;
  P.krot = (bf16_t*)take((size_t)NLAT * 256 * 2);
  P.vt_lat = (bf16_t*)take((size_t)16 * 256 * 2048 * 2);
  P.vt_ctx = (bf16_t*)take((size_t)16 * 256 * 256 * 2);
  P.sst = (float*)take((size_t)16 * 2 * 4 * NCH * 4096 * 4);
  P.ssumA = (float*)take((size_t)16 * 2 * 4 * NCH * 4);
  const size_t hysz = (size_t)16 * 256 * (2048 + 256) * 2;
  P.uT = (bf16_t*)take(hysz);
  P.x0T = (bf16_t*)take(hysz);
  P.yT = (bf16_t*)take(hysz);
  P.tabu = (bf16_t*)treg;
  P.tabv = (bf16_t*)(treg + (size_t)16384 * 1024);
  P.pout = (bf16_t*)(treg + (size_t)40 * 1024 * 1024);
  P.pact = (float*)P.Pbuf;
  P.qbuf = P.Pbuf;
  P.eidx = (int*)((unsigned char*)P.Pbuf + (size_t)NTOK * 2048 * 2);
  P.egate = (float*)((unsigned char*)P.eidx + (size_t)NTOK * 128 * 4);
  if (off > ws_size || n_in != 36) { fprintf(stderr, "kernel_launch: workspace too small (%zu > %zu) or n_in %d != 36\n", off, ws_size, n_in); return; }

  static int grid = 0;
#if MULTI_LAUNCH
  if (!grid) {
    hipFuncSetAttribute((const void*)phase_kernel, hipFuncAttributeMaxDynamicSharedMemorySize, LDS_BYTES);
    grid = 512;
  }
  hipLaunchKernelGGL(phase_kernel, dim3(grid), dim3(NTHREADS), LDS_BYTES, stream, P, PH_PRE0, 0);
  hipLaunchKernelGGL(phase_kernel, dim3(grid), dim3(NTHREADS), LDS_BYTES, stream, P, PH_PRE1, 0);
  hipLaunchKernelGGL(phase_kernel, dim3(grid), dim3(NTHREADS), LDS_BYTES, stream, P, PH_PRE2, 0);
  for (int l = 0; l < 2; ++l)
    for (int ph = PH_L1; ph <= PH_L9; ++ph) hipLaunchKernelGGL(phase_kernel, dim3(grid), dim3(NTHREADS), LDS_BYTES, stream, P, ph, l);
#else
  if (!grid) {
    int dev = 0, cus = 0, per_cu = 0;
    hipGetDevice(&dev);
    hipDeviceGetAttribute(&cus, hipDeviceAttributeMultiprocessorCount, dev);
    hipFuncSetAttribute((const void*)mega_kernel, hipFuncAttributeMaxDynamicSharedMemorySize, LDS_BYTES);
    hipOccupancyMaxActiveBlocksPerMultiprocessor(&per_cu, (const void*)mega_kernel, NTHREADS, LDS_BYTES);
    if (per_cu < 1) { fprintf(stderr, "kernel_launch: occupancy query returned %d\n", per_cu); per_cu = 1; }
    if (per_cu > 3) per_cu = 3;
    grid = cus * per_cu;
  }
  if (hipMemsetAsync(P.bar, 0, (XCD_BAR_WORDS + 16 * 64 + 8 * 64) * 4, stream) != hipSuccess) { fprintf(stderr, "kernel_launch: memset of barrier words failed\n"); return; }
  void* args[] = {&P};
  hipError_t e = hipLaunchCooperativeKernel((const void*)mega_kernel, dim3(grid), dim3(NTHREADS), args, LDS_BYTES, stream);
  if (e != hipSuccess) fprintf(stderr, "cooperative launch failed: %s (grid %d)\n", hipGetErrorString(e), grid);
#endif
}
```

```cpp
#include <hip/hip_runtime.h>
#include <hip/hip_cooperative_groups.h>
#include <cstdio>
#include <cstdint>
namespace cg = cooperative_groups;

#ifndef MULTI_LAUNCH
#define MULTI_LAUNCH 0
#endif

typedef unsigned short bf16_t;
typedef __attribute__((ext_vector_type(8))) short bf16x8;
typedef __attribute__((ext_vector_type(4))) float f32x4;

#define D_MODEL 1024
#define NB 16
#define SEQ 2048
#define CTXL 256
#define NLAT 32768
#define NTOK 36864
#define PST 2816
#define NCH 36
#define LDS_BYTES 53248
#define NTHREADS 256
#define ALPHA 1.41421356237f
#define LN_EPS 1e-5f

struct Params {
  const float *x, *c, *ctx, *c_ctx, *w_ada, *b_ada, *w_in, *w_out, *ln1_g, *ln1_b, *ln2_g, *ln2_b;
  const float *conf_dw_w, *conf_dw_b, *conf_norm_g, *conf_norm_b, *na_rpb, *hy_short_w, *hy_short_b;
  const float *hy_w1, *hy_b1, *hy_w2, *hy_b2, *hy_w3, *hy_decay, *hy_bias;
  const float *ssd_conv_w, *ssd_conv_b, *ssd_a_log, *ssd_dt_bias, *ssd_d, *ssd_norm_g;
  const float *peer_wq, *peer_keys, *peer_u, *peer_v;
  float* out;
  bf16_t* Pbuf;
  bf16_t* Ybuf;
  float*  xc;
  float*  dtbuf;
  bf16_t* wt_in;
  bf16_t* wt_out;
  bf16_t* wt_q;
  bf16_t* keysb;
  float*  modp;
  float*  mod;
  float*  hm2;
  bf16_t* gtab;
  float*  ropetab;
  bf16_t* krot;
  bf16_t* vt_lat;
  bf16_t* vt_ctx;
  float*  sst;
  float*  ssumA;
  bf16_t* uT;
  bf16_t* x0T;
  bf16_t* yT;
  bf16_t* tabu;
  bf16_t* tabv;
  int*    eidx;
  float*  egate;
  bf16_t* qbuf;
  unsigned* bar;
  float* pact;
  bf16_t* pout;
};

__device__ __forceinline__ bf16_t f2bf(float f) { unsigned u = __float_as_uint(f); u += 0x7FFFu + ((u >> 16) & 1u); return (bf16_t)(u >> 16); }
__device__ __forceinline__ float bf2f(bf16_t h) { return __uint_as_float(((unsigned)h) << 16); }
__device__ __forceinline__ unsigned pack2(float a, float b) { return (unsigned)f2bf(a) | ((unsigned)f2bf(b) << 16); }
__device__ __forceinline__ float lo2f(unsigned u) { return __uint_as_float(u << 16); }
__device__ __forceinline__ float hi2f(unsigned u) { return __uint_as_float(u & 0xFFFF0000u); }
__device__ __forceinline__ float sigmoidf_(float x) { return 1.f / (1.f + __expf(-x)); }
__device__ __forceinline__ float siluf_(float x) { return x / (1.f + __expf(-x)); }
__device__ __forceinline__ float wave_sum(float v) {
#pragma unroll
  for (int o = 32; o >= 1; o >>= 1) v += __shfl_xor(v, o);
  return v;
}
__device__ __forceinline__ void unpack8(uint4 v, float* f) {
  f[0] = lo2f(v.x); f[1] = hi2f(v.x); f[2] = lo2f(v.y); f[3] = hi2f(v.y);
  f[4] = lo2f(v.z); f[5] = hi2f(v.z); f[6] = lo2f(v.w); f[7] = hi2f(v.w);
}
__device__ __forceinline__ uint4 pack8(const float* f) {
  uint4 v; v.x = pack2(f[0], f[1]); v.y = pack2(f[2], f[3]); v.z = pack2(f[4], f[5]); v.w = pack2(f[6], f[7]); return v;
}
__device__ __forceinline__ bf16x8 as_bf8(uint4 v) { union { uint4 u; bf16x8 b; } x; x.u = v; return x.b; }
__device__ __forceinline__ f32x4 mfma16(bf16x8 a, bf16x8 b, f32x4 c) { return __builtin_amdgcn_mfma_f32_16x16x32_bf16(a, b, c, 0, 0, 0); }

__device__ __forceinline__ int tidx() { int t = threadIdx.x; asm volatile("" : "+v"(t)); return t; }
template <class Epi>
__device__ __forceinline__ void gemm_tile(const bf16_t* __restrict__ A, int lda, const bf16_t* __restrict__ Bt, int ldb,
                                          int K, int m0, int n0, unsigned char* smem, Epi epi) {
  bf16_t* As = (bf16_t*)smem;
  bf16_t* Bs = As + 3 * 128 * 40;
  const int tid = tidx(), lane = tid & 63, wave = tid >> 6;
  const int wm = wave >> 1, wn = wave & 1;
  const int lr = tid >> 1, lh = tid & 1;
  const bf16_t* ag = A + (size_t)(m0 + lr) * lda + lh * 16;
  const bf16_t* bg = Bt + (size_t)(n0 + lr) * ldb + lh * 16;
  f32x4 acc[4][4];
#pragma unroll
  for (int i = 0; i < 4; ++i)
#pragma unroll
    for (int j = 0; j < 4; ++j) acc[i][j] = (f32x4){0.f, 0.f, 0.f, 0.f};
  const int nk = K >> 5;
  uint4 pa0 = *(const uint4*)ag, pa1 = *(const uint4*)(ag + 8), pb0 = *(const uint4*)bg, pb1 = *(const uint4*)(bg + 8);
  uint4 qa0 = *(const uint4*)(ag + 32), qa1 = *(const uint4*)(ag + 40), qb0 = *(const uint4*)(bg + 32), qb1 = *(const uint4*)(bg + 40);
  __syncthreads();
  {
    bf16_t* wa = As + lr * 40 + lh * 16; bf16_t* wb = Bs + lr * 40 + lh * 16;
    *(uint4*)wa = pa0; *(uint4*)(wa + 8) = pa1; *(uint4*)wb = pb0; *(uint4*)(wb + 8) = pb1;
  }
  __syncthreads();
  int st = 0;
  auto compute = [&](int stage) {
    const bf16_t* as = As + stage * 5120 + (wm * 64 + (lane & 15)) * 40 + (lane >> 4) * 8;
    const bf16_t* bs = Bs + stage * 5120 + (wn * 64 + (lane & 15)) * 40 + (lane >> 4) * 8;
    bf16x8 afr[4];
#pragma unroll
    for (int j = 0; j < 4; ++j) afr[j] = *(const bf16x8*)(bs + j * 16 * 40);
#pragma unroll
    for (int i = 0; i < 4; ++i) {
      const bf16x8 bfr = *(const bf16x8*)(as + i * 16 * 40);
#pragma unroll
      for (int j = 0; j < 4; ++j) acc[i][j] = mfma16(afr[j], bfr, acc[i][j]);
    }
  };
  for (int kt = 0; kt < nk; kt += 2) {
    if (kt + 2 < nk) { const bf16_t* a2 = ag + (kt + 2) * 32; const bf16_t* b2 = bg + (kt + 2) * 32; pa0 = *(const uint4*)a2; pa1 = *(const uint4*)(a2 + 8); pb0 = *(const uint4*)b2; pb1 = *(const uint4*)(b2 + 8); }
    compute(st);
    {
      const int s1 = (st == 2) ? 0 : st + 1;
      bf16_t* wa = As + s1 * 5120 + lr * 40 + lh * 16; bf16_t* wb = Bs + s1 * 5120 + lr * 40 + lh * 16;
      *(uint4*)wa = qa0; *(uint4*)(wa + 8) = qa1; *(uint4*)wb = qb0; *(uint4*)(wb + 8) = qb1;
      st = s1;
    }
    __syncthreads();
    if (kt + 3 < nk) { const bf16_t* a2 = ag + (kt + 3) * 32; const bf16_t* b2 = bg + (kt + 3) * 32; qa0 = *(const uint4*)a2; qa1 = *(const uint4*)(a2 + 8); qb0 = *(const uint4*)b2; qb1 = *(const uint4*)(b2 + 8); }
    compute(st);
    if (kt + 2 < nk) {
      const int s1 = (st == 2) ? 0 : st + 1;
      bf16_t* wa = As + s1 * 5120 + lr * 40 + lh * 16; bf16_t* wb = Bs + s1 * 5120 + lr * 40 + lh * 16;
      *(uint4*)wa = pa0; *(uint4*)(wa + 8) = pa1; *(uint4*)wb = pb0; *(uint4*)(wb + 8) = pb1;
      st = s1;
    }
    __syncthreads();
  }
#pragma unroll
  for (int i = 0; i < 4; ++i)
#pragma unroll
    for (int j = 0; j < 4; ++j) {
      int m = m0 + wm * 64 + i * 16 + (lane & 15);
      int n = n0 + wn * 64 + j * 16 + (lane >> 4) * 4;
      epi(m, n, acc[i][j]);
    }
}

template <class Epi>
__device__ __forceinline__ void gemm_tile32(const bf16_t* __restrict__ A, int lda, const bf16_t* __restrict__ Bt, int ldb,
                                          int K, int m0, int n0, unsigned char* smem, Epi epi) {
  bf16_t* As = (bf16_t*)smem;
  bf16_t* Bs = As + 2 * 128 * 40;
  const int tid = tidx(), lane = tid & 63, wave = tid >> 6;
  const int wm = wave >> 1, wn = wave & 1;
  const int lr = tid >> 1, lh = tid & 1;
  const bf16_t* ag = A + (size_t)(m0 + lr) * lda + lh * 16;
  const bf16_t* bg = Bt + (size_t)(n0 + lr) * ldb + lh * 16;
  f32x4 acc[4][4];
#pragma unroll
  for (int i = 0; i < 4; ++i)
#pragma unroll
    for (int j = 0; j < 4; ++j) acc[i][j] = (f32x4){0.f, 0.f, 0.f, 0.f};
  uint4 ra0 = *(const uint4*)ag, ra1 = *(const uint4*)(ag + 8);
  uint4 rb0 = *(const uint4*)bg, rb1 = *(const uint4*)(bg + 8);
  __syncthreads();
  {
    bf16_t* pa = As + lr * 40 + lh * 16; bf16_t* pb = Bs + lr * 40 + lh * 16;
    *(uint4*)pa = ra0; *(uint4*)(pa + 8) = ra1; *(uint4*)pb = rb0; *(uint4*)(pb + 8) = rb1;
  }
  __syncthreads();
  const int nk = K >> 5;
  for (int kt = 0; kt < nk; ++kt) {
    const int cur = kt & 1;
    if (kt + 1 < nk) {
      const bf16_t* a2 = ag + (kt + 1) * 32; const bf16_t* b2 = bg + (kt + 1) * 32;
      ra0 = *(const uint4*)a2; ra1 = *(const uint4*)(a2 + 8); rb0 = *(const uint4*)b2; rb1 = *(const uint4*)(b2 + 8);
    }
    const bf16_t* as = As + cur * 5120 + (wm * 64 + (lane & 15)) * 40 + (lane >> 4) * 8;
    const bf16_t* bs = Bs + cur * 5120 + (wn * 64 + (lane & 15)) * 40 + (lane >> 4) * 8;
    bf16x8 afr[4];
#pragma unroll
    for (int j = 0; j < 4; ++j) afr[j] = *(const bf16x8*)(bs + j * 16 * 40);
#pragma unroll
    for (int i = 0; i < 4; ++i) {
      const bf16x8 bfr = *(const bf16x8*)(as + i * 16 * 40);
#pragma unroll
      for (int j = 0; j < 4; ++j) acc[i][j] = mfma16(afr[j], bfr, acc[i][j]);
    }
    if (kt + 1 < nk) {
      bf16_t* pa = As + (cur ^ 1) * 5120 + lr * 40 + lh * 16; bf16_t* pb = Bs + (cur ^ 1) * 5120 + lr * 40 + lh * 16;
      *(uint4*)pa = ra0; *(uint4*)(pa + 8) = ra1; *(uint4*)pb = rb0; *(uint4*)(pb + 8) = rb1;
    }
    __syncthreads();
  }
#pragma unroll
  for (int i = 0; i < 4; ++i)
#pragma unroll
    for (int j = 0; j < 4; ++j) {
      int m = m0 + wm * 64 + i * 16 + (lane & 15);
      int n = n0 + wn * 64 + j * 16 + (lane >> 4) * 4;
      epi(m, n, acc[i][j]);
    }
}

__device__ __forceinline__ void transpose_task(const float* __restrict__ src, bf16_t* __restrict__ dst, int K, int N, int k0, int n0, unsigned char* smem) {
  float* tile = (float*)smem;
  const int tid = tidx();
  __syncthreads();
  {
    int r = tid >> 4, c4 = tid & 15;
#pragma unroll
    for (int rr = 0; rr < 4; ++rr) {
      int row = rr * 16 + r;
      float4 v = make_float4(0.f, 0.f, 0.f, 0.f);
      if (n0 + c4 * 4 < N) v = *(const float4*)(src + (size_t)(k0 + row) * N + n0 + c4 * 4);
      float* t = tile + row * 65 + c4 * 4;
      t[0] = v.x; t[1] = v.y; t[2] = v.z; t[3] = v.w;
    }
  }
  __syncthreads();
  {
    int n = tid >> 2, kq = tid & 3;
    float f[16];
#pragma unroll
    for (int i = 0; i < 16; ++i) f[i] = tile[(kq * 16 + i) * 65 + n];
    bf16_t* d = dst + (size_t)(n0 + n) * K + k0 + kq * 16;
    *(uint4*)d = pack8(f); *(uint4*)(d + 8) = pack8(f + 8);
  }
}

__device__ __forceinline__ void modpart_task(const Params& P, int l, int ks, int cb, unsigned char* smem) {
  float* s = (float*)smem;
  const int tid = tidx();
  __syncthreads();
  for (int i = tid; i < 17 * 64; i += NTHREADS) {
    int r = i >> 6, k = i & 63;
    float v = (r < 16) ? P.c[r * 1024 + ks * 64 + k] : P.c_ctx[ks * 64 + k];
    s[i] = siluf_(v);
  }
  __syncthreads();
  float acc[17];
#pragma unroll
  for (int r = 0; r < 17; ++r) acc[r] = 0.f;
  const int col = cb * 256 + tid;
  const float* w = P.w_ada + ((size_t)l * 1024 + ks * 64) * 6144 + col;
#pragma unroll 8
  for (int k = 0; k < 64; ++k) {
    float wv = w[(size_t)k * 6144];
#pragma unroll
    for (int r = 0; r < 17; ++r) acc[r] += s[r * 64 + k] * wv;
  }
#pragma unroll
  for (int r = 0; r < 17; ++r) P.modp[(((size_t)l * 16 + ks) * 17 + r) * 6144 + col] = acc[r];
}

__device__ __forceinline__ void hm2_task(const Params& P, int l, int lsel, int t4, unsigned char* smem) {
  float* z = (float*)smem;
  float* h1 = z + 4 * 36;
  const int tid = tidx(), tt = tid >> 6, j = tid & 63;
  const int L = lsel ? 256 : 2048;
  const int t = t4 * 4 + tt;
  const float tn = (float)t / (float)L;
  __syncthreads();
  if (j < 33) {
    float v;
    if (j == 0) v = tn;
    else if (j <= 16) v = sinf((6.2831855f * (float)j) * tn);
    else v = cosf((6.2831855f * (float)(j - 16)) * tn);
    z[tt * 36 + j] = v;
  }
  __syncthreads();
  float a = P.hy_b1[l * 64 + j];
  for (int i = 0; i < 33; ++i) a += z[tt * 36 + i] * P.hy_w1[(l * 33 + i) * 64 + j];
  h1[tt * 64 + j] = sinf(a);
  __syncthreads();
  float b = P.hy_b2[l * 64 + j];
  for (int i = 0; i < 64; ++i) b += h1[tt * 64 + i] * P.hy_w2[(l * 64 + i) * 64 + j];
  P.hm2[(((size_t)l * 2 + lsel) * 2048 + t) * 64 + j] = sinf(b);
}

__device__ __forceinline__ bf16_t* gtab_ptr(const Params& P, int l, int lsel, int c) {
  bf16_t* base = P.gtab + (size_t)l * (256 * 2 * 4096 + 256 * 2 * 512);
  return lsel ? base + 256 * 2 * 4096 + (size_t)c * 1024 : base + (size_t)c * 8192;
}

__device__ __forceinline__ void filt_task(const Params& P, int l, int lsel, int col, unsigned char* smem) {
  float* kv = (float*)smem;
  float* red = kv + 2048;
  float* w3s = red + 8;
  const int tid = tidx();
  const int L = lsel ? 256 : 2048;
  __syncthreads();
  if (tid < 64) w3s[tid] = P.hy_w3[(l * 64 + tid) * 512 + col];
  __syncthreads();
  const float dec = P.hy_decay[l * 512 + col];
  float asum = 0.f;
  for (int t = tid; t < L; t += NTHREADS) {
    const float* h = P.hm2 + (((size_t)l * 2 + lsel) * 2048 + t) * 64;
    float a = 0.f;
#pragma unroll 8
    for (int i = 0; i < 64; ++i) a += h[i] * w3s[i];
    float tn = (float)t / (float)L;
    a *= expf(-tn * dec);
    kv[t] = a; asum += fabsf(a);
  }
  asum = wave_sum(asum);
  if ((tid & 63) == 0) red[tid >> 6] = asum;
  __syncthreads();
  const float inv = 1.f / (red[0] + red[1] + red[2] + red[3] + 1e-6f);
  const int c = col & 255;
  const bool bwd = col >= 256;
  bf16_t* g0 = gtab_ptr(P, l, lsel, c);
  bf16_t* g1 = g0 + 2 * L;
  for (int d = tid; d < L; d += NTHREADS) {
    if (bwd && d == 0) continue;
    int i = bwd ? (L - 1 + d) : (L - 1 - d);
    bf16_t v = f2bf(kv[d] * inv);
    g0[i] = v;
    if (i >= 1) g1[i - 1] = v;
  }
}

__device__ __forceinline__ int mod_row(int T) { return T < NLAT ? (T >> 11) : 16; }

__device__ __forceinline__ void hmod0_token(const Params& P, int T, int lane) {
  const float* xr = (T < NLAT) ? P.x + (size_t)T * 1024 : P.ctx + (size_t)(T - NLAT) * 1024;
  const float* m = P.mod + (size_t)mod_row(T) * 6144;
#pragma unroll
  for (int i = 0; i < 2; ++i) {
    int d = i * 512 + lane * 8;
    float f[8];
#pragma unroll
    for (int j = 0; j < 8; ++j) f[j] = xr[d + j] * (1.f + m[1024 + d + j]) + m[d + j];
    *(uint4*)(P.Ybuf + (size_t)T * 1024 + d) = pack8(f);
  }
}

__device__ __forceinline__ void r1_token(const Params& P, int l, int T, int lane, const bool dry) {
  const float* xr;
  float* xw;
  if (T < NLAT) { xr = (l == 0) ? P.x + (size_t)T * 1024 : P.out + (size_t)T * 1024; xw = P.out + (size_t)T * 1024; }
  else { xr = (l == 0) ? P.ctx + (size_t)(T - NLAT) * 1024 : P.xc + (size_t)(T - NLAT) * 1024; xw = P.xc + (size_t)(T - NLAT) * 1024; }
  bf16_t* hw = P.Ybuf + (size_t)T * 1024;
  if (dry) { xw = (float*)P.uT + (size_t)(T & 2047) * 1024; hw = P.x0T + (size_t)(T & 2047) * 1024; }
  const float* m = P.mod + ((size_t)l * 17 + mod_row(T)) * 6144;
  const bf16_t* yo = P.Pbuf + (size_t)T * 1024;
  float v[16];
  float s = 0.f;
#pragma unroll
  for (int i = 0; i < 2; ++i) {
    int d = i * 512 + lane * 8;
    float y[8]; unpack8(*(const uint4*)(yo + d), y);
#pragma unroll
    for (int j = 0; j < 8; ++j) { v[i * 8 + j] = ALPHA * xr[d + j] + m[2048 + d + j] * y[j]; s += v[i * 8 + j]; }
  }
  float mean = wave_sum(s) * (1.f / 1024.f);
  float q = 0.f;
#pragma unroll
  for (int i = 0; i < 16; ++i) { v[i] -= mean; q += v[i] * v[i]; }
  float rstd = rsqrtf(wave_sum(q) * (1.f / 1024.f) + LN_EPS);
#pragma unroll
  for (int i = 0; i < 2; ++i) {
    int d = i * 512 + lane * 8;
    float h[8];
#pragma unroll
    for (int j = 0; j < 8; ++j) {
      float x1 = v[i * 8 + j] * rstd * P.ln1_g[l * 1024 + d + j] + P.ln1_b[l * 1024 + d + j];
      xw[d + j] = x1;
      h[j] = x1 * (1.f + m[4096 + d + j]) + m[3072 + d + j];
    }
    *(uint4*)(hw + d) = pack8(h);
  }
}

__device__ __forceinline__ void r1_pair(const Params& P, int l, int Ta, int Tb, bool liveb, int lane) {
  const int Tt[2] = {Ta, Tb};
  const float* xr[2]; float* xw[2]; bf16_t* hw[2]; const float* mm[2];
  float v[2][16]; float s[2] = {0.f, 0.f};
#pragma unroll
  for (int u = 0; u < 2; ++u) {
    const int T = Tt[u];
    if (T < NLAT) { xr[u] = (l == 0) ? P.x + (size_t)T * 1024 : P.out + (size_t)T * 1024; xw[u] = P.out + (size_t)T * 1024; }
    else { xr[u] = (l == 0) ? P.ctx + (size_t)(T - NLAT) * 1024 : P.xc + (size_t)(T - NLAT) * 1024; xw[u] = P.xc + (size_t)(T - NLAT) * 1024; }
    hw[u] = P.Ybuf + (size_t)T * 1024;
    mm[u] = P.mod + ((size_t)l * 17 + mod_row(T)) * 6144;
    const bf16_t* yo = P.Pbuf + (size_t)T * 1024;
#pragma unroll
    for (int i = 0; i < 2; ++i) {
      int d = i * 512 + lane * 8;
      float y[8]; unpack8(*(const uint4*)(yo + d), y);
      const float4 xa = *(const float4*)(xr[u] + d), xb = *(const float4*)(xr[u] + d + 4);
      const float xv[8] = {xa.x, xa.y, xa.z, xa.w, xb.x, xb.y, xb.z, xb.w};
#pragma unroll
      for (int j = 0; j < 8; ++j) { v[u][i * 8 + j] = ALPHA * xv[j] + mm[u][2048 + d + j] * y[j]; s[u] += v[u][i * 8 + j]; }
    }
  }
#pragma unroll
  for (int u = 0; u < 2; ++u) {
    if (u == 1 && !liveb) break;
    float mean = wave_sum(s[u]) * (1.f / 1024.f);
    float q = 0.f;
#pragma unroll
    for (int i = 0; i < 16; ++i) { v[u][i] -= mean; q += v[u][i] * v[u][i]; }
    float rstd = rsqrtf(wave_sum(q) * (1.f / 1024.f) + LN_EPS);
#pragma unroll
    for (int i = 0; i < 2; ++i) {
      int d = i * 512 + lane * 8;
      float h[8], x1[8];
#pragma unroll
      for (int j = 0; j < 8; ++j) {
        x1[j] = v[u][i * 8 + j] * rstd * P.ln1_g[l * 1024 + d + j] + P.ln1_b[l * 1024 + d + j];
        h[j] = x1[j] * (1.f + mm[u][4096 + d + j]) + mm[u][3072 + d + j];
      }
      *(float4*)(xw[u] + d) = make_float4(x1[0], x1[1], x1[2], x1[3]);
      *(float4*)(xw[u] + d + 4) = make_float4(x1[4], x1[5], x1[6], x1[7]);
      *(uint4*)(hw[u] + d) = pack8(h);
    }
  }
}

__device__ __forceinline__ float gelu_tanh(float x) {
  float u = 0.7978845608f * (x + 0.044715f * x * x * x);
  float t = 1.f - 2.f / (1.f + __expf(2.f * u));
  return 0.5f * x * (1.f + t);
}

typedef float f32x2 __attribute__((ext_vector_type(2)));
__device__ __forceinline__ unsigned pack4_fp8(float a, float b, float c, float d) {
  int v = 0;
  v = __builtin_amdgcn_cvt_pk_fp8_f32(a, b, v, false);
  v = __builtin_amdgcn_cvt_pk_fp8_f32(c, d, v, true);
  return (unsigned)v;
}
__device__ __forceinline__ float dot16_fp8(uint4 v, const float* h) {
  f32x2 acc = (f32x2){0.f, 0.f};
  unsigned w[4] = {v.x, v.y, v.z, v.w};
#pragma unroll
  for (int q = 0; q < 4; ++q) {
    acc += __builtin_amdgcn_cvt_pk_f32_fp8((int)w[q], false) * (f32x2){h[q * 4], h[q * 4 + 1]};
    acc += __builtin_amdgcn_cvt_pk_f32_fp8((int)w[q], true) * (f32x2){h[q * 4 + 2], h[q * 4 + 3]};
  }
  return acc[0] + acc[1];
}
typedef float f32x4_t __attribute__((ext_vector_type(4)));
__device__ __forceinline__ void peer_u_phase(const Params& P, int sl, int Tfirst, int Tstride, int ntok, int lane, int* li) {
  const int m = lane & 15, quad = lane >> 4;
  const unsigned char* tu = (const unsigned char*)P.tabu + (size_t)sl * 16384 * 128 + quad * 32;
  const int wpos = (lane & 15) * 8 + (lane >> 4);
  for (int T0 = Tfirst; T0 < ntok; T0 += 4 * Tstride) {
    int Tk[4];
    {
      int ir[4][2];
#pragma unroll
      for (int k = 0; k < 4; ++k) {
        Tk[k] = min(T0 + k * Tstride, ntok - 1);
        const int* er = P.eidx + (size_t)Tk[k] * 128;
        ir[k][0] = er[lane]; ir[k][1] = er[64 + lane];
      }
#pragma unroll
      for (int k = 0; k < 4; ++k) { li[k * 128 + wpos] = ir[k][0]; li[k * 128 + wpos + 4] = ir[k][1]; }
    }
#pragma unroll 1
    for (int k = 0; k < 4; ++k) {
      const int Tc = min(T0 + k * Tstride, ntok - 1);
      uint4 hr[4];
      const bf16_t* hp = P.Ybuf + (size_t)Tc * 1024 + sl * 128 + quad * 32;
#pragma unroll
      for (int q = 0; q < 4; ++q) hr[q] = *(const uint4*)(hp + q * 8);
      uint4 rv[16];
      {
        int idx[8];
#pragma unroll
        for (int q = 0; q < 2; ++q) { int4 v = *(const int4*)(li + k * 128 + m * 8 + q * 4); idx[q * 4] = v.x; idx[q * 4 + 1] = v.y; idx[q * 4 + 2] = v.z; idx[q * 4 + 3] = v.w; }
#pragma unroll
        for (int t = 0; t < 8; ++t) { const unsigned char* rp = tu + (size_t)idx[t] * 128; rv[2 * t] = *(const uint4*)rp; rv[2 * t + 1] = *(const uint4*)(rp + 16); }
      }
      long hb[4];
#pragma unroll
      for (int q = 0; q < 4; ++q) {
        float f[8]; unpack8(hr[q], f);
        unsigned lo = pack4_fp8(f[0], f[1], f[2], f[3]), hi = pack4_fp8(f[4], f[5], f[6], f[7]);
        hb[q] = (long)(((unsigned long long)hi << 32) | (unsigned long long)lo);
      }
      const bool live = (T0 + k * Tstride) < ntok;
      float* po = P.pact + ((size_t)sl * NTOK + Tc) * 128 + quad * 4;
#pragma unroll
      for (int t = 0; t < 8; ++t) {
        f32x4_t acc = (f32x4_t){0.f, 0.f, 0.f, 0.f};
        const uint4 r0 = rv[2 * t], r1 = rv[2 * t + 1];
        acc = __builtin_amdgcn_mfma_f32_16x16x32_fp8_fp8((long)(((unsigned long long)r0.y << 32) | r0.x), hb[0], acc, 0, 0, 0);
        acc = __builtin_amdgcn_mfma_f32_16x16x32_fp8_fp8((long)(((unsigned long long)r0.w << 32) | r0.z), hb[1], acc, 0, 0, 0);
        acc = __builtin_amdgcn_mfma_f32_16x16x32_fp8_fp8((long)(((unsigned long long)r1.y << 32) | r1.x), hb[2], acc, 0, 0, 0);
        acc = __builtin_amdgcn_mfma_f32_16x16x32_fp8_fp8((long)(((unsigned long long)r1.w << 32) | r1.z), hb[3], acc, 0, 0, 0);
        if (m == 0 && live) *(float4*)(po + t * 16) = make_float4(acc[0], acc[1], acc[2], acc[3]);
      }
    }
  }
}
__device__ __forceinline__ void peer_v_phase(const Params& P, int sl, int Tfirst, int Tstride, int ntok, int lane, int* li) {
  const int grp = lane >> 3, j8 = lane & 7;
  const unsigned char* tv = (const unsigned char*)P.tabv + (size_t)sl * 16384 * 128 + j8 * 16;
  float* lw = (float*)(li + 512);
  const int wpos = (lane & 7) * 16 + (lane >> 3);
  for (int T0 = Tfirst; T0 < ntok; T0 += 4 * Tstride) {
    int Tk[4];
    {
      int ir[4][2]; float wr[4][2];
#pragma unroll
      for (int k = 0; k < 4; ++k) {
        Tk[k] = min(T0 + k * Tstride, ntok - 1);
        const int* er = P.eidx + (size_t)Tk[k] * 128; const float* gr = P.egate + (size_t)Tk[k] * 128;
        ir[k][0] = er[lane]; ir[k][1] = er[64 + lane]; wr[k][0] = gr[lane]; wr[k][1] = gr[64 + lane];
      }
#pragma unroll
      for (int k = 0; k < 4; ++k) { li[k * 128 + wpos] = ir[k][0]; li[k * 128 + wpos + 8] = ir[k][1]; lw[k * 128 + wpos] = wr[k][0]; lw[k * 128 + wpos + 8] = wr[k][1]; }
    }
    uint4 rv[1][16];
#pragma unroll
    for (int k = 0; k < 4; ++k) {
      {
        int idx[16];
#pragma unroll
        for (int q = 0; q < 4; ++q) { int4 v = *(const int4*)(li + k * 128 + grp * 16 + q * 4); idx[q * 4] = v.x; idx[q * 4 + 1] = v.y; idx[q * 4 + 2] = v.z; idx[q * 4 + 3] = v.w; }
#pragma unroll
        for (int t = 0; t < 16; ++t) rv[0][t] = *(const uint4*)(tv + (size_t)idx[t] * 128);
      }
      {
        const int kk = k;
        float w[16];
#pragma unroll
        for (int q = 0; q < 4; ++q) { float4 f = *(const float4*)(lw + kk * 128 + grp * 16 + q * 4); w[q * 4] = f.x; w[q * 4 + 1] = f.y; w[q * 4 + 2] = f.z; w[q * 4 + 3] = f.w; }
        f32x2 o[8];
#pragma unroll
        for (int i = 0; i < 8; ++i) o[i] = (f32x2){0.f, 0.f};
#pragma unroll
        for (int t = 0; t < 16; ++t) {
          const f32x2 w2 = (f32x2){w[t], w[t]};
          const uint4 r = rv[0][t];
          unsigned ww[4] = {r.x, r.y, r.z, r.w};
#pragma unroll
          for (int q = 0; q < 4; ++q) {
            o[q * 2] += w2 * __builtin_amdgcn_cvt_pk_f32_fp8((int)ww[q], false);
            o[q * 2 + 1] += w2 * __builtin_amdgcn_cvt_pk_f32_fp8((int)ww[q], true);
          }
        }
        float of[16];
#pragma unroll
        for (int i = 0; i < 8; ++i) { of[2 * i] = o[i][0]; of[2 * i + 1] = o[i][1]; }
#pragma unroll
        for (int i = 0; i < 16; ++i) { of[i] += __shfl_xor(of[i], 8); of[i] += __shfl_xor(of[i], 16); of[i] += __shfl_xor(of[i], 32); }
        if (grp == 0 && (T0 + kk * Tstride) < ntok) {
#pragma unroll
          for (int i = 0; i < 16; ++i) of[i] *= (1.f / 256.f);
          bf16_t* d = P.pout + (size_t)Tk[kk] * 1024 + sl * 128 + j8 * 16;
          *(uint4*)d = pack8(of); *(uint4*)(d + 8) = pack8(of + 8);
        }
      }
    }
  }
}
__device__ __forceinline__ void ln2_token(const Params& P, int l, int T, int lane) {
  float* xw = (T < NLAT) ? P.out + (size_t)T * 1024 : P.xc + (size_t)(T - NLAT) * 1024;
  bf16_t* hw = P.Ybuf + (size_t)T * 1024;
  const float* m = P.mod + ((size_t)l * 17 + mod_row(T)) * 6144;
  const int d0 = lane * 16;
  float o[16];
  unpack8(*(const uint4*)(P.pout + (size_t)T * 1024 + d0), o); unpack8(*(const uint4*)(P.pout + (size_t)T * 1024 + d0 + 8), o + 8);
  float s = 0.f;
#pragma unroll
  for (int i = 0; i < 16; ++i) { o[i] = ALPHA * xw[d0 + i] + m[5120 + d0 + i] * o[i]; s += o[i]; }
  float mean = wave_sum(s) * (1.f / 1024.f);
  float q = 0.f;
#pragma unroll
  for (int i = 0; i < 16; ++i) { o[i] -= mean; q += o[i] * o[i]; }
  float rstd = rsqrtf(wave_sum(q) * (1.f / 1024.f) + LN_EPS);
  const float* mn = P.mod + ((size_t)(l + 1) * 17 + mod_row(T)) * 6144;
  float hh[16];
#pragma unroll
  for (int i = 0; i < 16; ++i) {
    float x2 = o[i] * rstd * P.ln2_g[l * 1024 + d0 + i] + P.ln2_b[l * 1024 + d0 + i];
    o[i] = x2;
    if (l == 0) hh[i] = x2 * (1.f + mn[1024 + d0 + i]) + mn[d0 + i];
  }
#pragma unroll
  for (int i = 0; i < 4; ++i) *(float4*)(xw + d0 + i * 4) = make_float4(o[i * 4], o[i * 4 + 1], o[i * 4 + 2], o[i * 4 + 3]);
  if (l == 0) { *(uint4*)(hw + d0) = pack8(hh); *(uint4*)(hw + d0 + 8) = pack8(hh + 8); }
}

__device__ __forceinline__ void peer_token(const Params& P, int l, int T, int lane, float* wl, const bool dry) {
  const int sub = lane >> 4, j16 = lane & 15;
  float h[64];
  {
    const bf16_t* hr = P.Ybuf + (size_t)T * 1024 + j16 * 16;
#pragma unroll
    for (int i = 0; i < 4; ++i) { unpack8(*(const uint4*)(hr + i * 256), h + i * 16); unpack8(*(const uint4*)(hr + i * 256 + 8), h + i * 16 + 8); }
  }
  const int* er = P.eidx + (size_t)T * 128;
  const float* gr = P.egate + (size_t)T * 128;
  const unsigned char* tu = (const unsigned char*)P.tabu;
  const unsigned char* tv = (const unsigned char*)P.tabv;
  for (int it = 0; it < 32; it += 2) {
    uint4 rv[2][4];
#pragma unroll
    for (int u2 = 0; u2 < 2; ++u2) {
      int e = er[(it + u2) * 4 + sub];
      const unsigned char* row = tu + (size_t)e * 1024 + j16 * 16;
#pragma unroll
      for (int i = 0; i < 4; ++i) rv[u2][i] = *(const uint4*)(row + i * 256);
    }
#pragma unroll
    for (int u2 = 0; u2 < 2; ++u2) {
      float acc = 0.f;
#pragma unroll
      for (int i = 0; i < 4; ++i) acc += dot16_fp8(rv[u2][i], h + i * 16);
      acc += __shfl_xor(acc, 1); acc += __shfl_xor(acc, 2); acc += __shfl_xor(acc, 4); acc += __shfl_xor(acc, 8);
      if (j16 == 0) wl[(it + u2) * 4 + sub] = gr[(it + u2) * 4 + sub] * gelu_tanh(acc * (1.f / 256.f));
    }
  }
  float o[16];
#pragma unroll
  for (int i = 0; i < 16; ++i) o[i] = 0.f;
  for (int e8 = 0; e8 < 128; e8 += 8) {
    uint4 rv[8];
    float w[8];
#pragma unroll
    for (int k = 0; k < 8; ++k) {
      int e = er[e8 + k];
      rv[k] = *(const uint4*)(tv + (size_t)e * 1024 + lane * 16);
      w[k] = wl[e8 + k];
    }
#pragma unroll
    for (int k = 0; k < 8; ++k) {
      unsigned ww[4] = {rv[k].x, rv[k].y, rv[k].z, rv[k].w};
#pragma unroll
      for (int q = 0; q < 4; ++q) {
        f32x2 lo = __builtin_amdgcn_cvt_pk_f32_fp8((int)ww[q], false);
        f32x2 hi = __builtin_amdgcn_cvt_pk_f32_fp8((int)ww[q], true);
        o[q * 4] += w[k] * lo[0]; o[q * 4 + 1] += w[k] * lo[1]; o[q * 4 + 2] += w[k] * hi[0]; o[q * 4 + 3] += w[k] * hi[1];
      }
    }
  }
  float* xw = (T < NLAT) ? P.out + (size_t)T * 1024 : P.xc + (size_t)(T - NLAT) * 1024;
  const float* xrd = xw;
  bf16_t* hw = P.Ybuf + (size_t)T * 1024;
  if (dry) { xw = (float*)P.uT + (size_t)(T & 2047) * 1024; hw = P.x0T + (size_t)(T & 2047) * 1024; }
  const float* m = P.mod + ((size_t)l * 17 + mod_row(T)) * 6144;
  const int d0 = lane * 16;
  float s = 0.f;
#pragma unroll
  for (int i = 0; i < 16; ++i) { o[i] = ALPHA * xrd[d0 + i] + m[5120 + d0 + i] * (o[i] * (1.f / 256.f)); s += o[i]; }
  float mean = wave_sum(s) * (1.f / 1024.f);
  float q = 0.f;
#pragma unroll
  for (int i = 0; i < 16; ++i) { o[i] -= mean; q += o[i] * o[i]; }
  float rstd = rsqrtf(wave_sum(q) * (1.f / 1024.f) + LN_EPS);
  const float* mn = P.mod + ((size_t)(l + 1) * 17 + mod_row(T)) * 6144;
  float hh[16];
#pragma unroll
  for (int i = 0; i < 16; ++i) {
    float x2 = o[i] * rstd * P.ln2_g[l * 1024 + d0 + i] + P.ln2_b[l * 1024 + d0 + i];
    o[i] = x2;
    if (l == 0) hh[i] = x2 * (1.f + mn[1024 + d0 + i]) + mn[d0 + i];
  }
#pragma unroll
  for (int i = 0; i < 4; ++i) *(float4*)(xw + d0 + i * 4) = make_float4(o[i * 4], o[i * 4 + 1], o[i * 4 + 2], o[i * 4 + 3]);
  if (l == 0) { *(uint4*)(hw + d0) = pack8(hh); *(uint4*)(hw + d0 + 8) = pack8(hh + 8); }
}

__device__ __forceinline__ void conf_task(const Params& P, int l, int tok_base, int len, int pos0, unsigned char* smem) {
  _Float16* u = (_Float16*)smem;
  const int c = tidx();
  __syncthreads();
  for (int i = 0; i < 94; ++i) {
    int pos = pos0 - 15 + i;
    float v = 0.f;
    if (pos >= 0 && pos < len) {
      const bf16_t* pr = P.Pbuf + (size_t)(tok_base + pos) * PST;
      v = bf2f(pr[c]) * sigmoidf_(bf2f(pr[256 + c]));
    }
    u[i * 256 + c] = (_Float16)v;
  }
  __syncthreads();
  float w[31];
#pragma unroll
  for (int j = 0; j < 31; ++j) w[j] = P.conf_dw_w[(l * 31 + j) * 256 + c];
  const float bias = P.conf_dw_b[l * 256 + c], ng = P.conf_norm_g[l * 256 + c], nb = P.conf_norm_b[l * 256 + c];
  for (int t = 0; t < 64; ++t) {
    float acc = bias;
#pragma unroll
    for (int j = 0; j < 31; ++j) acc += w[j] * (float)u[(t + j) * 256 + c];
    float mean = wave_sum(acc) * (1.f / 64.f);
    float d = acc - mean;
    float var = wave_sum(d * d) * (1.f / 64.f);
    float un = d * rsqrtf(var + LN_EPS) * ng + nb;
    P.Ybuf[(size_t)(tok_base + pos0 + t) * 1024 + c] = f2bf(siluf_(un));
  }
}

__device__ __forceinline__ void prep_task(const Params& P, int l, bool lat, int b, int pos0) {
  const int c = tidx();
  const int len = lat ? 2048 : 256;
  const int tok0 = lat ? b * 2048 + pos0 : NLAT + b * 256 + pos0;
  {
    bf16_t* dst = (lat ? P.vt_lat : P.vt_ctx) + ((size_t)b * 256 + c) * len + pos0;
    for (int t8 = 0; t8 < 8; ++t8) {
      unsigned wv[4];
#pragma unroll
      for (int k = 0; k < 4; ++k) {
        unsigned a = P.Pbuf[(size_t)(tok0 + t8 * 8 + k * 2) * PST + 1024 + c];
        unsigned bb = P.Pbuf[(size_t)(tok0 + t8 * 8 + k * 2 + 1) * PST + 1024 + c];
        wv[k] = a | (bb << 16);
      }
      *(uint4*)(dst + t8 * 8) = make_uint4(wv[0], wv[1], wv[2], wv[3]);
    }
  }
  if (lat) {
    const int hd = c & 63, i = hd & 31, hbase = c & ~63;
    const bool hi = hd >= 32;
    const int row = pos0 >> 6;
    const float* tc = P.ropetab; const float* ts = P.ropetab + 1024;
    for (int t = 0; t < 64; ++t) {
      const bf16_t* kr = P.Pbuf + (size_t)(tok0 + t) * PST + 768 + hbase;
      float x1 = bf2f(kr[i]), x2 = bf2f(kr[32 + i]);
      int pos = (i < 16) ? row : t;
      float cs = tc[pos * 16 + (i & 15)], sn = ts[pos * 16 + (i & 15)];
      float o = hi ? (x1 * sn + x2 * cs) : (x1 * cs - x2 * sn);
      P.krot[(size_t)(tok0 + t) * 256 + c] = f2bf(o);
    }
  }
  {
    float w[3][3], bsv[3];
#pragma unroll
    for (int q = 0; q < 3; ++q) {
      bsv[q] = P.hy_short_b[l * 768 + q * 256 + c];
#pragma unroll
      for (int k = 0; k < 3; ++k) w[q][k] = P.hy_short_w[(l * 3 + k) * 768 + q * 256 + c];
    }
    const size_t seqoff = lat ? ((size_t)b * 256 + c) * 2048 : (size_t)16 * 256 * 2048 + ((size_t)b * 256 + c) * 256;
    float pv[3], cu[3], nx[3];
#pragma unroll
    for (int q = 0; q < 3; ++q) {
      pv[q] = (pos0 > 0) ? bf2f(P.Pbuf[(size_t)(tok0 - 1) * PST + 1280 + q * 256 + c]) : 0.f;
      cu[q] = bf2f(P.Pbuf[(size_t)tok0 * PST + 1280 + q * 256 + c]);
    }
    for (int t8 = 0; t8 < 8; ++t8) {
      float uo[8], xo[8];
#pragma unroll
      for (int k = 0; k < 8; ++k) {
        int t = t8 * 8 + k;
        float r[3];
#pragma unroll
        for (int q = 0; q < 3; ++q) {
          nx[q] = (pos0 + t + 1 < len) ? bf2f(P.Pbuf[(size_t)(tok0 + t + 1) * PST + 1280 + q * 256 + c]) : 0.f;
          r[q] = w[q][0] * pv[q] + w[q][1] * cu[q] + w[q][2] * nx[q] + bsv[q];
          pv[q] = cu[q]; cu[q] = nx[q];
        }
        xo[k] = r[0]; uo[k] = r[2] * r[1];
      }
      *(uint4*)(P.uT + seqoff + pos0 + t8 * 8) = pack8(uo);
      *(uint4*)(P.x0T + seqoff + pos0 + t8 * 8) = pack8(xo);
    }
  }
}

__device__ __forceinline__ void hyfin_task(const Params& P, int l, bool lat, int b, int pos0) {
  const int c = tidx();
  const int tok0 = lat ? b * 2048 + pos0 : NLAT + b * 256 + pos0;
  const size_t seqoff = lat ? ((size_t)b * 256 + c) * 2048 : (size_t)16 * 256 * 2048 + ((size_t)b * 256 + c) * 256;
  const float skip = P.hy_bias[l * 256 + c];
  for (int t8 = 0; t8 < 8; ++t8) {
    float y[8], u[8], x0[8];
    unpack8(*(const uint4*)(P.yT + seqoff + pos0 + t8 * 8), y);
    unpack8(*(const uint4*)(P.uT + seqoff + pos0 + t8 * 8), u);
    unpack8(*(const uint4*)(P.x0T + seqoff + pos0 + t8 * 8), x0);
#pragma unroll
    for (int k = 0; k < 8; ++k)
      P.Ybuf[(size_t)(tok0 + t8 * 8 + k) * 1024 + 512 + c] = f2bf((y[k] + u[k] * skip) * x0[k]);
  }
}

__device__ __forceinline__ void hyconv_task(const Params& P, int l, bool lat, int c, int tb, unsigned char* smem) {
  const int L = lat ? 2048 : 256;
  unsigned* g = (unsigned*)smem;
  const int tid = tidx(), lane = tid & 63, wave = tid >> 6;
  __syncthreads();
  {
    const uint4* src = (const uint4*)gtab_ptr(P, l, lat ? 0 : 1, c);
    const int n16 = (4 * L * 2) / 16;
    for (int i = tid; i < n16; i += NTHREADS) ((uint4*)g)[i] = src[i];
  }
  __syncthreads();
  const int m = lane & 15, quad = lane >> 4;
  const size_t seqbase = lat ? 0 : (size_t)16 * 256 * 2048;
  bf16_t* ubuf = (bf16_t*)(smem + 4 * L * 2);
  const int pb0 = tid >> 5, pc0 = tid & 31;
  const bf16_t* ug0 = P.uT + seqbase + ((size_t)pb0 * 256 + c) * L + pc0 * 8;
  const bf16_t* ug1 = P.uT + seqbase + ((size_t)(pb0 + 8) * 256 + c) * L + pc0 * 8;
  const int t0 = tb + wave * 64;
  f32x4 acc[4];
#pragma unroll
  for (int i = 0; i < 4; ++i) acc[i] = (f32x4){0.f, 0.f, 0.f, 0.f};
  uint4 r0 = *(const uint4*)ug0, r1 = *(const uint4*)ug1;
  for (int s0 = 0; s0 < L; s0 += 256) {
    __syncthreads();
    *(uint4*)(ubuf + pb0 * 264 + pc0 * 8) = r0; *(uint4*)(ubuf + (pb0 + 8) * 264 + pc0 * 8) = r1;
    __syncthreads();
    if (s0 + 256 < L) { r0 = *(const uint4*)(ug0 + s0 + 256); r1 = *(const uint4*)(ug1 + s0 + 256); }
#pragma unroll
    for (int q = 0; q < 8; ++q) {
      const bf16x8 ufr = *(const bf16x8*)(ubuf + m * 264 + q * 32 + quad * 8);
#pragma unroll
      for (int i = 0; i < 4; ++i) {
        int o = (L - 1) + s0 + q * 32 - (t0 + i * 16) + quad * 8 - m;
        const unsigned* gp = g + (o & 1) * L + (o >> 1);
        uint4 tv = make_uint4(gp[0], gp[1], gp[2], gp[3]);
        acc[i] = mfma16(as_bf8(tv), ufr, acc[i]);
      }
    }
  }
  bf16_t* yb = P.yT + seqbase + ((size_t)m * 256 + c) * L;
#pragma unroll
  for (int i = 0; i < 4; ++i) {
    uint2 v; v.x = pack2(acc[i][0], acc[i][1]); v.y = pack2(acc[i][2], acc[i][3]);
    *(uint2*)(yb + t0 + i * 16 + quad * 4) = v;
  }
}

template <bool LOCAL>
__device__ __forceinline__ void attn_task(const Params& P, int l, int b, int r, int c0, int h, int lane) {
  const int n = lane & 15, quad = lane >> 4;
  const int qtok = LOCAL ? (b * 2048 + r * 64 + c0 + n) : (NLAT + b * 256 + c0 + n);
  const bf16_t* pq = P.Pbuf + (size_t)qtok * PST + 512 + h * 64 + quad * 8;
  const uint4 q0 = *(const uint4*)pq, q1 = *(const uint4*)(pq + 32);
  const bf16x8 qp0 = as_bf8(q0), qp1 = as_bf8(q1);
  bf16x8 qr0 = qp0, qr1 = qp1;
  const int rs = min(max(r - 4, 0), 24), kc0 = min(max(c0 - 8, 0), 32);
  const int cq = c0 + n, cs_ = min(max(cq - 8, 0), 48);
  const float* rpb = P.na_rpb + ((size_t)l * 4 + h) * 15 * 31;
  if (LOCAL) {
    float x1[8], x2[8], a[8], bq[8];
    unpack8(q0, x1); unpack8(q1, x2);
    const int pos = (quad < 2) ? r : (c0 + n);
    const float* tc = P.ropetab + pos * 16 + (quad & 1) * 8;
    const float* ts = tc + 1024;
#pragma unroll
    for (int j = 0; j < 8; ++j) { float cs = tc[j], sn = ts[j]; a[j] = x1[j] * cs - x2[j] * sn; bq[j] = x1[j] * sn + x2[j] * cs; }
    qr0 = as_bf8(pack8(a)); qr1 = as_bf8(pack8(bq));
  }
  auto local_scores = [&](int g) -> f32x4 {
    const int i = g >> 1, half = g & 1;
    const int ktok = b * 2048 + (rs + i) * 64 + kc0 + half * 16 + n;
    const bf16_t* kp = P.krot + (size_t)ktok * 256 + h * 64 + quad * 8;
    f32x4 acc = (f32x4){0.f, 0.f, 0.f, 0.f};
    acc = mfma16(*(const bf16x8*)kp, qr0, acc);
    acc = mfma16(*(const bf16x8*)(kp + 32), qr1, acc);
    const float* rb = rpb + (rs + i - r + 7) * 31;
    f32x4 o;
#pragma unroll
    for (int rr = 0; rr < 4; ++rr) {
      int kcol = kc0 + half * 16 + quad * 4 + rr;
      bool valid = (kcol >= cs_) && (kcol < cs_ + 16);
      int bi = min(max(kcol - cq + 15, 0), 30);
      o[rr] = valid ? (acc[rr] * 0.125f + rb[bi]) : -1e30f;
    }
    return o;
  };
  auto ctx_scores = [&](int g) -> f32x4 {
    const int ktok = NLAT + b * 256 + g * 16 + n;
    const bf16_t* kp = P.Pbuf + (size_t)ktok * PST + 768 + h * 64 + quad * 8;
    f32x4 acc = (f32x4){0.f, 0.f, 0.f, 0.f};
    acc = mfma16(*(const bf16x8*)kp, qp0, acc);
    acc = mfma16(*(const bf16x8*)(kp + 32), qp1, acc);
    return acc * 0.125f;
  };
  float mx = -1e30f, sum = 0.f;
  f32x4 O[4];
#pragma unroll
  for (int i = 0; i < 4; ++i) O[i] = (f32x4){0.f, 0.f, 0.f, 0.f};
  auto block = [&](const bool loc, const int sb) {
    f32x4 sc[8];
#pragma unroll
    for (int q = 0; q < 8; ++q) sc[q] = loc ? local_scores(sb * 8 + q) : ctx_scores(sb * 8 + q);
    float bm = -1e30f;
#pragma unroll
    for (int q = 0; q < 8; ++q) bm = fmaxf(bm, fmaxf(fmaxf(sc[q][0], sc[q][1]), fmaxf(sc[q][2], sc[q][3])));
    bm = fmaxf(bm, __shfl_xor(bm, 16)); bm = fmaxf(bm, __shfl_xor(bm, 32));
    const float mnew = fmaxf(mx, bm);
    const float scale = __expf(mx - mnew);
    mx = mnew; sum *= scale;
#pragma unroll
    for (int dt = 0; dt < 4; ++dt) O[dt] *= scale;
#pragma unroll
    for (int pr = 0; pr < 4; ++pr) {
      const int ip = sb * 4 + pr;
      float pa[4], pbv[4];
#pragma unroll
      for (int rr = 0; rr < 4; ++rr) { pa[rr] = __expf(sc[2 * pr][rr] - mx); pbv[rr] = __expf(sc[2 * pr + 1][rr] - mx); sum += pa[rr] + pbv[rr]; }
      uint4 pb; pb.x = pack2(pa[0], pa[1]); pb.y = pack2(pa[2], pa[3]); pb.z = pack2(pbv[0], pbv[1]); pb.w = pack2(pbv[2], pbv[3]);
#pragma unroll
      for (int dt = 0; dt < 4; ++dt) {
        const bf16_t* vp = loc ? P.vt_lat + ((size_t)(b * 4 + h) * 64 + dt * 16 + n) * 2048 + (rs + ip) * 64 + kc0 + quad * 4
                               : P.vt_ctx + ((size_t)(b * 4 + h) * 64 + dt * 16 + n) * 256 + ip * 32 + quad * 4;
        uint2 lo = *(const uint2*)vp, hi = *(const uint2*)(vp + 16);
        O[dt] = mfma16(as_bf8(make_uint4(lo.x, lo.y, hi.x, hi.y)), as_bf8(pb), O[dt]);
      }
    }
  };
  if (LOCAL) { block(true, 0); block(true, 1); }
  block(false, 0); block(false, 1);
  sum += __shfl_xor(sum, 16); sum += __shfl_xor(sum, 32);
  const float inv = 1.f / sum;
  bf16_t* yo = P.Ybuf + (size_t)qtok * 1024 + 256 + h * 64 + quad * 4;
#pragma unroll
  for (int dt = 0; dt < 4; ++dt) {
    uint2 v; v.x = pack2(O[dt][0] * inv, O[dt][1] * inv); v.y = pack2(O[dt][2] * inv, O[dt][3] * inv);
    *(uint2*)(yo + dt * 16) = v;
  }
}

template <bool PASS3>
__device__ __forceinline__ void ssd_task(const Params& P, int l, int b, int g, int ch, unsigned char* smem) {
  _Float16* xs = (_Float16*)smem;
  _Float16* Bs = xs + 64 * 128;
  _Float16* Cs = Bs + 64 * 64;
  float* dts = (float*)(Cs + 64 * 64);
  float* decs = dts + 256;
  float* as_ = decs + 256;
  _Float16* yt = (_Float16*)(as_ + 256);
  const int tid = tidx();
  const bool lat = ch >= 4;
  const int len = lat ? 2048 : 256;
  const int pos0 = lat ? (ch - 4) * 64 : ch * 64;
  const int tok0 = lat ? b * 2048 + pos0 : NLAT + b * 256 + pos0;
  __syncthreads();
  {
    const int col = (tid < 128) ? g * 128 + tid : (tid < 192 ? 256 + g * 64 + (tid - 128) : 384 + g * 64 + (tid - 192));
    const float w0 = P.ssd_conv_w[(l * 3 + 0) * 512 + col], w1 = P.ssd_conv_w[(l * 3 + 1) * 512 + col], w2 = P.ssd_conv_w[(l * 3 + 2) * 512 + col];
    const float bs = P.ssd_conv_b[l * 512 + col];
    const bf16_t* pp = P.Pbuf + (size_t)tok0 * PST + 2304 + col;
    float pv = (pos0 > 0) ? bf2f(pp[-(ptrdiff_t)PST]) : 0.f;
    float cu = bf2f(pp[0]);
    _Float16* dst = (tid < 128) ? xs + tid : (tid < 192 ? Bs + (tid - 128) : Cs + (tid - 192));
    const int dstride = (tid < 128) ? 128 : 64;
    for (int t = 0; t < 64; ++t) {
      float nx = (pos0 + t + 1 < len) ? bf2f(pp[(size_t)(t + 1) * PST]) : 0.f;
      float v = siluf_(w0 * pv + w1 * cu + w2 * nx + bs);
      dst[t * dstride] = (_Float16)v;
      pv = cu; cu = nx;
    }
    {
      const int t = tid >> 2, k = tid & 3, dir = k >> 1, hh = k & 1, head = g * 2 + hh;
      float raw = P.dtbuf[(size_t)(tok0 + t) * 8 + dir * 4 + head] + P.ssd_dt_bias[(l * 2 + dir) * 4 + head];
      float dtv = (raw > 20.f) ? raw : log1pf(expf(raw));
      float a = -dtv * expf(P.ssd_a_log[(l * 2 + dir) * 4 + head]);
      dts[tid] = dtv; as_[tid] = a; decs[tid] = expf(a);
    }
    if (PASS3) for (int i = tid; i < 64 * 128; i += NTHREADS) yt[i] = (_Float16)0.f;
  }
  __syncthreads();
  const int hh = tid >> 7, p = (tid >> 1) & 63, nh = tid & 1;
  const int head = g * 2 + hh;
  float stf[32], stb[32];
  float* sf = P.sst + ((((size_t)b * 2 + 0) * 4 + head) * NCH + ch) * 4096 + p * 64 + nh * 32;
  float* sb = P.sst + ((((size_t)b * 2 + 1) * 4 + head) * NCH + ch) * 4096 + p * 64 + nh * 32;
  if (PASS3) {
#pragma unroll
    for (int i = 0; i < 8; ++i) {
      float4 a = *(const float4*)(sf + i * 4); stf[i * 4] = a.x; stf[i * 4 + 1] = a.y; stf[i * 4 + 2] = a.z; stf[i * 4 + 3] = a.w;
      float4 c = *(const float4*)(sb + i * 4); stb[i * 4] = c.x; stb[i * 4 + 1] = c.y; stb[i * 4 + 2] = c.z; stb[i * 4 + 3] = c.w;
    }
  } else {
#pragma unroll
    for (int i = 0; i < 32; ++i) { stf[i] = 0.f; stb[i] = 0.f; }
  }
  for (int k = 0; k < 64; ++k) {
    {
      const float dtv = dts[k * 4 + hh], dec = decs[k * 4 + hh];
      const float xd = (float)xs[k * 128 + hh * 64 + p] * dtv;
      const _Float16* br = Bs + k * 64 + nh * 32;
#pragma unroll
      for (int i = 0; i < 32; ++i) stf[i] = stf[i] * dec + xd * (float)br[i];
      if (PASS3) {
        const _Float16* cr = Cs + k * 64 + nh * 32;
        float y0 = 0.f, y1 = 0.f, y2 = 0.f, y3 = 0.f;
#pragma unroll
        for (int i = 0; i < 32; i += 4) { y0 += stf[i] * (float)cr[i]; y1 += stf[i + 1] * (float)cr[i + 1]; y2 += stf[i + 2] * (float)cr[i + 2]; y3 += stf[i + 3] * (float)cr[i + 3]; }
        float y = (y0 + y1) + (y2 + y3);
        y += __shfl_xor(y, 1);
        if (nh == 0) { _Float16* yp = yt + k * 128 + hh * 64 + p; *yp = (_Float16)((float)*yp + y); }
      }
    }
    {
      const int kk = 63 - k;
      const float dtv = dts[kk * 4 + 2 + hh], dec = decs[kk * 4 + 2 + hh];
      const float xd = (float)xs[kk * 128 + hh * 64 + p] * dtv;
      const _Float16* br = Bs + kk * 64 + nh * 32;
#pragma unroll
      for (int i = 0; i < 32; ++i) stb[i] = stb[i] * dec + xd * (float)br[i];
      if (PASS3) {
        const _Float16* cr = Cs + kk * 64 + nh * 32;
        float y0 = 0.f, y1 = 0.f, y2 = 0.f, y3 = 0.f;
#pragma unroll
        for (int i = 0; i < 32; i += 4) { y0 += stb[i] * (float)cr[i]; y1 += stb[i + 1] * (float)cr[i + 1]; y2 += stb[i + 2] * (float)cr[i + 2]; y3 += stb[i + 3] * (float)cr[i + 3]; }
        float y = (y0 + y1) + (y2 + y3);
        y += __shfl_xor(y, 1);
        if (nh == 0) { _Float16* yp = yt + kk * 128 + hh * 64 + p; *yp = (_Float16)((float)*yp + y); }
      }
    }
  }
  if (!PASS3) {
#pragma unroll
    for (int i = 0; i < 8; ++i) {
      *(float4*)(sf + i * 4) = make_float4(stf[i * 4], stf[i * 4 + 1], stf[i * 4 + 2], stf[i * 4 + 3]);
      *(float4*)(sb + i * 4) = make_float4(stb[i * 4], stb[i * 4 + 1], stb[i * 4 + 2], stb[i * 4 + 3]);
    }
    if (tid < 4) {
      const int dir = tid >> 1, h2 = tid & 1;
      float a = 0.f;
      for (int t = 0; t < 64; ++t) a += as_[t * 4 + tid];
      P.ssumA[(((size_t)b * 2 + dir) * 4 + g * 2 + h2) * NCH + ch] = a;
    }
  } else {
    __syncthreads();
    const int t = tid >> 2, part = tid & 3;
    const int hd = g * 2 + (part >> 1);
    const float dsk = P.ssd_d[l * 4 + hd];
    float val[32];
    float sq = 0.f;
    const bf16_t* zr = P.Pbuf + (size_t)(tok0 + t) * PST + 2048 + g * 128 + part * 32;
#pragma unroll
    for (int i = 0; i < 32; ++i) {
      int cc = part * 32 + i;
      float y = (float)yt[t * 128 + cc] + (float)xs[t * 128 + cc] * dsk;
      float z = bf2f(zr[i]);
      y *= siluf_(z);
      val[i] = y; sq += y * y;
    }
    sq += __shfl_xor(sq, 1); sq += __shfl_xor(sq, 2);
    const float rinv = rsqrtf(sq * (1.f / 128.f) + LN_EPS);
    bf16_t* yo = P.Ybuf + (size_t)(tok0 + t) * 1024 + 768 + g * 128 + part * 32;
    const float* ngp = P.ssd_norm_g + l * 256 + g * 128 + part * 32;
#pragma unroll
    for (int i8 = 0; i8 < 4; ++i8) {
      float f[8];
#pragma unroll
      for (int j = 0; j < 8; ++j) f[j] = val[i8 * 8 + j] * rinv * ngp[i8 * 8 + j];
      *(uint4*)(yo + i8 * 8) = pack8(f);
    }
  }
}


typedef _Float16 h8v_t __attribute__((ext_vector_type(8)));
__device__ __forceinline__ void ssd1m_task(const Params& P, int l, int b, int g, int ch, unsigned char* smem) {
  _Float16* xT = (_Float16*)smem;
  _Float16* bT = xT + 128 * 72;
  float* dts = (float*)(bT + 64 * 72);
  float* as_ = dts + 256;
  float* wv = as_ + 256;
  const int tid = tidx(), lane = tid & 63, wave = tid >> 6;
  const bool lat = ch >= 4;
  const int len = lat ? 2048 : 256;
  const int pos0 = lat ? (ch - 4) * 64 : ch * 64;
  const int tok0 = lat ? b * 2048 + pos0 : NLAT + b * 256 + pos0;
  __syncthreads();
  if (tid < 192) {
    const int col = (tid < 128) ? g * 128 + tid : 256 + g * 64 + (tid - 128);
    const float w0 = P.ssd_conv_w[(l * 3 + 0) * 512 + col], w1 = P.ssd_conv_w[(l * 3 + 1) * 512 + col], w2 = P.ssd_conv_w[(l * 3 + 2) * 512 + col];
    const float bs = P.ssd_conv_b[l * 512 + col];
    const bf16_t* pp = P.Pbuf + (size_t)tok0 * PST + 2304 + col;
    float pv = (pos0 > 0) ? bf2f(pp[-(ptrdiff_t)PST]) : 0.f;
    float cu = bf2f(pp[0]);
    _Float16* dst = (tid < 128) ? xT + tid * 72 : bT + (tid - 128) * 72;
    for (int t = 0; t < 64; ++t) {
      float nx = (pos0 + t + 1 < len) ? bf2f(pp[(size_t)(t + 1) * PST]) : 0.f;
      dst[t] = (_Float16)siluf_(w0 * pv + w1 * cu + w2 * nx + bs);
      pv = cu; cu = nx;
    }
  }
  {
    const int t = tid >> 2, k = tid & 3, dir = k >> 1, head = g * 2 + (k & 1);
    float raw = P.dtbuf[(size_t)(tok0 + t) * 8 + dir * 4 + head] + P.ssd_dt_bias[(l * 2 + dir) * 4 + head];
    float dtv = (raw > 20.f) ? raw : log1pf(expf(raw));
    dts[k * 64 + t] = dtv; as_[k * 64 + t] = -dtv * expf(P.ssd_a_log[(l * 2 + dir) * 4 + head]);
  }
  __syncthreads();
  if (tid < 4) {
    const int k = tid, dir = k >> 1;
    float sacc = 0.f;
    if (dir == 0) { for (int t = 63; t >= 0; --t) { wv[k * 64 + t] = dts[k * 64 + t] * expf(sacc); sacc += as_[k * 64 + t]; } }
    else          { for (int t = 0; t < 64; ++t)  { wv[k * 64 + t] = dts[k * 64 + t] * expf(sacc); sacc += as_[k * 64 + t]; } }
    P.ssumA[(((size_t)b * 2 + dir) * 4 + g * 2 + (k & 1)) * NCH + ch] = sacc;
  }
  __syncthreads();
  const int k = wave, dir = k >> 1, hh = k & 1, head = g * 2 + hh;
  const int m = lane & 15, quad = lane >> 4;
  f32x4 acc[4][4];
#pragma unroll
  for (int i = 0; i < 4; ++i)
#pragma unroll
    for (int j = 0; j < 4; ++j) acc[i][j] = (f32x4){0.f, 0.f, 0.f, 0.f};
#pragma unroll
  for (int ks = 0; ks < 2; ++ks) {
    float w8[8];
#pragma unroll
    for (int j = 0; j < 8; ++j) w8[j] = wv[k * 64 + ks * 32 + quad * 8 + j];
    h8v_t bfrag[4];
#pragma unroll
    for (int pi = 0; pi < 4; ++pi) {
      const h8v_t raw = *(const h8v_t*)(xT + (hh * 64 + pi * 16 + m) * 72 + ks * 32 + quad * 8);
#pragma unroll
      for (int j = 0; j < 8; ++j) bfrag[pi][j] = (_Float16)((float)raw[j] * w8[j]);
    }
#pragma unroll
    for (int ni = 0; ni < 4; ++ni) {
      const h8v_t afrag = *(const h8v_t*)(bT + (ni * 16 + m) * 72 + ks * 32 + quad * 8);
#pragma unroll
      for (int pi = 0; pi < 4; ++pi) acc[ni][pi] = __builtin_amdgcn_mfma_f32_16x16x32_f16(afrag, bfrag[pi], acc[ni][pi], 0, 0, 0);
    }
  }
  float* sp = P.sst + ((((size_t)b * 2 + dir) * 4 + head) * NCH + ch) * 4096;
#pragma unroll
  for (int ni = 0; ni < 4; ++ni)
#pragma unroll
    for (int pi = 0; pi < 4; ++pi)
      *(float4*)(sp + (pi * 16 + m) * 64 + ni * 16 + quad * 4) = make_float4(acc[ni][pi][0], acc[ni][pi][1], acc[ni][pi][2], acc[ni][pi][3]);
}

__device__ __forceinline__ void ssd_prefix_task(const Params& P, int bdh, int part) {
  const int dir = (bdh >> 2) & 1;
  float* base = P.sst + (size_t)bdh * NCH * 4096 + part * 256 + tidx();
  const float* sa = P.ssumA + (size_t)bdh * NCH;
  float carry = 0.f;
  for (int i = 0; i < NCH; ++i) {
    int ch = dir ? (i < 4 ? 3 - i : 39 - i) : i;
    float loc = base[(size_t)ch * 4096];
    base[(size_t)ch * 4096] = carry;
    carry = expf(sa[ch]) * carry + loc;
  }
}

__device__ __forceinline__ int f2key(float f) { int b = __float_as_int(f); return b ^ ((b >> 31) & 0x7FFFFFFF); }
__device__ __forceinline__ float key2f(int k) { return __int_as_float(k ^ ((k >> 31) & 0x7FFFFFFF)); }
#define CE_DESC(a, b) { int _x = max(a, b); int _y = min(a, b); a = _x; b = _y; }
#define CE_ASC(a, b) { int _x = min(a, b); int _y = max(a, b); a = _x; b = _y; }
__device__ __forceinline__ void sort16_desc(int* a) {
#pragma unroll
  for (int k = 2; k <= 16; k <<= 1)
#pragma unroll
    for (int j = k >> 1; j > 0; j >>= 1)
#pragma unroll
      for (int i = 0; i < 16; ++i) {
        int lq = i ^ j;
        if (lq > i) { if ((i & k) == 0) CE_DESC(a[i], a[lq]) else CE_ASC(a[i], a[lq]) }
      }
}
__device__ __forceinline__ void merge16_desc(int* a, const int* b) {
#pragma unroll
  for (int i = 0; i < 16; ++i) a[i] = max(a[i], b[15 - i]);
#pragma unroll
  for (int j = 8; j > 0; j >>= 1)
#pragma unroll
    for (int i = 0; i < 16; ++i) {
      int lq = i ^ j;
      if (lq > i) CE_DESC(a[i], a[lq])
    }
}

__device__ __forceinline__ void gemm_acc32(const bf16_t* __restrict__ A, int lda, const bf16_t* __restrict__ Bt, int ldb,
                                           int K, int m0, int n0, unsigned char* smem, f32x4 (&acc)[4][4]) {
  bf16_t* As = (bf16_t*)smem;
  bf16_t* Bs = As + 2 * 128 * 40;
  const int tid = tidx(), lane = tid & 63, wave = tid >> 6;
  const int wm = wave >> 1, wn = wave & 1;
  const int lr = tid >> 1, lh = tid & 1;
  const bf16_t* ag = A + (size_t)(m0 + lr) * lda + lh * 16;
  const bf16_t* bg = Bt + (size_t)(n0 + lr) * ldb + lh * 16;
#pragma unroll
  for (int i = 0; i < 4; ++i)
#pragma unroll
    for (int j = 0; j < 4; ++j) acc[i][j] = (f32x4){0.f, 0.f, 0.f, 0.f};
  uint4 ra0 = *(const uint4*)ag, ra1 = *(const uint4*)(ag + 8);
  uint4 rb0 = *(const uint4*)bg, rb1 = *(const uint4*)(bg + 8);
  __syncthreads();
  {
    bf16_t* pa = As + lr * 40 + lh * 16; bf16_t* pb = Bs + lr * 40 + lh * 16;
    *(uint4*)pa = ra0; *(uint4*)(pa + 8) = ra1; *(uint4*)pb = rb0; *(uint4*)(pb + 8) = rb1;
  }
  __syncthreads();
  const int nk = K >> 5;
  for (int kt = 0; kt < nk; ++kt) {
    const int cur = kt & 1;
    if (kt + 1 < nk) {
      const bf16_t* a2 = ag + (kt + 1) * 32; const bf16_t* b2 = bg + (kt + 1) * 32;
      ra0 = *(const uint4*)a2; ra1 = *(const uint4*)(a2 + 8); rb0 = *(const uint4*)b2; rb1 = *(const uint4*)(b2 + 8);
    }
    const bf16_t* as = As + cur * 5120 + (wm * 64 + (lane & 15)) * 40 + (lane >> 4) * 8;
    const bf16_t* bs = Bs + cur * 5120 + (wn * 64 + (lane & 15)) * 40 + (lane >> 4) * 8;
    bf16x8 afr[4];
#pragma unroll
    for (int j = 0; j < 4; ++j) afr[j] = *(const bf16x8*)(bs + j * 16 * 40);
#pragma unroll
    for (int i = 0; i < 4; ++i) {
      const bf16x8 bfr = *(const bf16x8*)(as + i * 16 * 40);
#pragma unroll
      for (int j = 0; j < 4; ++j) acc[i][j] = mfma16(afr[j], bfr, acc[i][j]);
    }
    if (kt + 1 < nk) {
      bf16_t* pa = As + (cur ^ 1) * 5120 + lr * 40 + lh * 16; bf16_t* pb = Bs + (cur ^ 1) * 5120 + lr * 40 + lh * 16;
      *(uint4*)pa = ra0; *(uint4*)(pa + 8) = ra1; *(uint4*)pb = rb0; *(uint4*)(pb + 8) = rb1;
    }
    __syncthreads();
  }
}

__device__ __forceinline__ void peer_topk_task(const Params& P, int l, int tm, int h, unsigned char* smem) {
  float* sc = (float*)smem;
  int* fin = (int*)(smem + 33280);
  const int tid = tidx(), lane = tid & 63, wave = tid >> 6;
  const int wm = wave >> 1, wn = wave & 1;
  const int row64 = tid & 63, quarter = tid >> 6;
  int* K1 = (int*)(smem + 40960);
  int* K2a = (int*)(smem + 49152);
#pragma unroll
  for (int pp = 0; pp < 2; ++pp) {
    const bf16_t* A = P.qbuf + (h * 2 + pp) * 128;
    const bf16_t* Bt = P.keysb + ((size_t)(l * 8 + h) * 2 + pp) * 128 * 128;
#pragma unroll 1
    for (int half = 0; half < 2; ++half) {
      {
        f32x4 acc[4][4];
        gemm_acc32(A, 2048, Bt, 128, 128, tm * 128, 0, smem, acc);
        if (wm == half) {
#pragma unroll
          for (int i = 0; i < 4; ++i)
#pragma unroll
            for (int j = 0; j < 4; ++j) {
              float* d = sc + (i * 16 + (lane & 15)) * 129 + wn * 64 + j * 16 + (lane >> 4) * 4;
              d[0] = acc[i][j][0]; d[1] = acc[i][j][1]; d[2] = acc[i][j][2]; d[3] = acc[i][j][3];
            }
        }
      }
      __syncthreads();
      int run[16];
#pragma unroll
      for (int i = 0; i < 16; ++i) run[i] = (int)0x80000000;
#pragma unroll 1
      for (int grp = 0; grp < 2; ++grp) {
        int cur[16];
#pragma unroll
        for (int i = 0; i < 16; ++i) {
          int col = quarter * 32 + grp * 16 + i;
          cur[i] = (f2key(sc[row64 * 129 + col]) & ~127) | col;
        }
        sort16_desc(cur);
        merge16_desc(run, cur);
      }
      if (quarter != 0) {
#pragma unroll
        for (int i = 0; i < 16; ++i) sc[row64 * 129 + quarter * 32 + i] = __int_as_float(run[i]);
      }
      __syncthreads();
      if (quarter == 0) {
#pragma unroll 1
        for (int q = 1; q < 4; ++q) {
          int oth[16];
#pragma unroll
          for (int i = 0; i < 16; ++i) oth[i] = __float_as_int(sc[row64 * 129 + q * 32 + i]);
          merge16_desc(run, oth);
        }
        if (half == 0) {
#pragma unroll
          for (int i = 0; i < 16; ++i) { if (pp == 0) K1[row64 * 16 + i] = run[i]; else K2a[row64 * 16 + i] = run[i]; }
        } else {
#pragma unroll
          for (int i = 0; i < 16; ++i) fin[row64 * 16 + i] = run[i];
        }
      }
      __syncthreads();
    }
    if (pp == 0 && tid >= 64 && tid < 128) {
#pragma unroll
      for (int i = 0; i < 16; ++i) K1[tid * 16 + i] = fin[(tid - 64) * 16 + i];
    }
    __syncthreads();
  }
  const int row = tid & 127, half = tid >> 7;
  int* lists = (int*)smem;
  if (half == 0) {
#pragma unroll
    for (int i = 0; i < 16; ++i) { lists[row * 33 + i] = K1[row * 16 + i]; lists[row * 33 + 16 + i] = (row < 64) ? K2a[row * 16 + i] : fin[(row - 64) * 16 + i]; }
  }
  if (half == 0) {
    float v2[16];
#pragma unroll
    for (int i = 0; i < 16; ++i) v2[i] = key2f(lists[row * 33 + 16 + i] & ~127);
    int run[16];
    {
      const float v0 = key2f(lists[row * 33] & ~127);
#pragma unroll
      for (int j = 0; j < 16; ++j) run[j] = (f2key(v0 + v2[j]) & ~255) | (15 - j);
    }
#pragma unroll 1
    for (int i = 1; i < 16; ++i) {
      int cur[16];
      const float vi = key2f(lists[row * 33 + i] & ~127);
#pragma unroll
      for (int j = 0; j < 16; ++j) cur[j] = (f2key(vi + v2[j]) & ~255) | (i * 16 + 15 - j);
      merge16_desc(run, cur);
    }
    const float c0 = key2f(run[0] & ~255);
    float sum = 0.f;
#pragma unroll
    for (int k = 0; k < 16; ++k) sum += __expf(key2f(run[k] & ~255) - c0);
    const float inv = 1.f / sum;
    const int T = tm * 128 + row;
    int* eo = P.eidx + (size_t)T * 128 + h * 16;
    float* go = P.egate + (size_t)T * 128 + h * 16;
#pragma unroll
    for (int k = 0; k < 16; ++k) {
      int ci = run[k] & 255;
      int i = ci >> 4, j = 15 - (ci & 15);
      int i1 = lists[row * 33 + i] & 127, i2 = lists[row * 33 + 16 + j] & 127;
      eo[k] = i1 * 128 + i2;
      go[k] = __expf(key2f(run[k] & ~255) - c0) * inv;
    }
  }
}

#define XB_TMO      128
#define XB_XCNT(j)  (256  + 64 * (j))
#define XB_XSUB(j)  (1280 + 64 * (j))
#define XB_XGEN(j)  (2304 + 64 * (j))
#define XB_TOP      3328
#define XB_TOPGEN   3392
#define XCD_BAR_WORDS 3456
#define XB_SPIN_CAP (1u << 18)
#define LAS __attribute__((address_space(3)))

__device__ __forceinline__ unsigned xb_ld(unsigned* p)              { return __hip_atomic_load(p, __ATOMIC_RELAXED, __HIP_MEMORY_SCOPE_AGENT); }
__device__ __forceinline__ unsigned xb_add(unsigned* p, unsigned v) { return __hip_atomic_fetch_add(p, v, __ATOMIC_RELAXED, __HIP_MEMORY_SCOPE_AGENT); }
__device__ __forceinline__ unsigned xb_xcc_id() { return (unsigned)__builtin_amdgcn_s_getreg((3 << 11) | 20) & 0xFu; }
#define XB_SPIN(cond, bar) do { unsigned _sp = 0; while (cond) { __builtin_amdgcn_s_sleep(1); \
    if ((++_sp & 255u) == 0u) { if (xb_ld(&(bar)[XB_TMO])) break; if (_sp > XB_SPIN_CAP) { atomicAdd(&(bar)[XB_TMO], 1u); break; } } } } while (0)

struct XcdBarrier {
    unsigned* bar; unsigned x;
    volatile LAS unsigned* st;
};

__device__ __forceinline__ XcdBarrier xcd_barrier_post(unsigned* bar, volatile LAS unsigned* st) {
    XcdBarrier b; b.bar = bar; b.x = xb_xcc_id(); b.st = st;
    if (threadIdx.x == 0) (void)xb_add(&bar[XB_XCNT(b.x)], 1u);
    return b;
}
__device__ __forceinline__ void xcd_barrier_complete(unsigned* bar, unsigned x, unsigned& nloc, unsigned& nx) {
    const unsigned G = gridDim.x * gridDim.y * gridDim.z;
    unsigned sum, cnt, mine, sp = 0u;
    for (;;) {
        sum = 0u; cnt = 0u; mine = 0u;
#pragma unroll
        for (unsigned j = 0; j < 16; ++j) { const unsigned c = xb_ld(&bar[XB_XCNT(j)]); sum += c; cnt += (c > 0u) ? 1u : 0u; mine = (j == x) ? c : mine; }
        if (sum == G) break;
        __builtin_amdgcn_s_sleep(1);
        if ((++sp & 255u) == 0u) { if (xb_ld(&bar[XB_TMO])) break; if (sp > XB_SPIN_CAP) { atomicAdd(&bar[XB_TMO], 1u); break; } }
    }
    nloc = mine > 0u ? mine : 1u; nx = cnt > 0u ? cnt : 1u;
}

__device__ __forceinline__ void xcd_barrier(const XcdBarrier& b) {
    asm volatile("s_waitcnt vmcnt(0)" ::: "memory");
    __syncthreads();
    if (threadIdx.x == 0) {
        unsigned* bar = b.bar;
        __builtin_amdgcn_s_waitcnt(0);
        unsigned nloc = b.st[0], nx = b.st[1];
        if (nloc == 0u) { xcd_barrier_complete(bar, b.x, nloc, nx); b.st[0] = nloc; b.st[1] = nx; }
        const unsigned old = xb_add(&bar[XB_XSUB(b.x)], 1u);
        const unsigned gen = old / nloc;
        if (old + 1u == (gen + 1u) * nloc) {
            __builtin_amdgcn_fence(__ATOMIC_RELEASE, "agent");
            asm volatile("s_waitcnt vmcnt(0)" ::: "memory");
            const unsigned og = xb_add(&bar[XB_TOP], 1u);
            const unsigned tg = og / nx;
            if (og + 1u == (tg + 1u) * nx) xb_add(&bar[XB_TOPGEN], 1u);
            else XB_SPIN(xb_ld(&bar[XB_TOPGEN]) == tg, bar);
            __builtin_amdgcn_fence(__ATOMIC_ACQUIRE, "agent");
            xb_add(&bar[XB_XGEN(b.x)], 1u);
            asm volatile("s_waitcnt vmcnt(0)" ::: "memory");
        } else {
            XB_SPIN(xb_ld(&bar[XB_XGEN(b.x)]) == gen, bar);
            __builtin_amdgcn_fence(__ATOMIC_ACQUIRE, "agent");
            asm volatile("s_waitcnt vmcnt(0)" ::: "memory");
        }
    }
    __syncthreads();
}


__device__ __forceinline__ int next_task(unsigned* cnt, int* slot) {
  __syncthreads();
  if (tidx() == 0) *slot = (int)__hip_atomic_fetch_add(cnt, 1u, __ATOMIC_RELAXED, __HIP_MEMORY_SCOPE_AGENT);
  __syncthreads();
  return *slot;
}
enum { PH_PRE0 = 0, PH_PRE1, PH_PRE2, PH_L1, PH_L2, PH_L3, PH_L4, PH_L5, PH_L6, PH_L7, PH_L8, PH_L9, PH_L9W, PH_L9B, PH_L9C, PH_COUNT };
struct XInfo { int slot, nx, rank, nloc; };
#define QCNT(i) (XCD_BAR_WORDS + 16 * 64 + 64 * (i))

template <int ph>
__device__ __forceinline__ void run_phase(const Params& P, const XInfo& X, int l, unsigned char* smem, const bool rep = false) {
  const int nb = gridDim.x, bid = blockIdx.x, tid = tidx(), lane = tid & 63, wave = tid >> 6;
  const int rbid = nb - 1 - bid;
  __shared__ int sQ;
  const int ntok = (l == 0) ? NTOK : NLAT;
  const int mt_out = ntok / 128;
  switch (ph) {
    case PH_PRE0: {
      for (int u = bid; u < 768; u += nb) modpart_task(P, u / 384, (u / 24) % 16, u % 24, smem);
      for (int u = rbid; u < 2 * 46 * 16; u += nb) { int ll = u / 736, r = u % 736; transpose_task(P.w_in + (size_t)ll * 1024 * 2824, P.wt_in + (size_t)ll * 2944 * 1024, 1024, 2824, (r % 16) * 64, (r / 16) * 64, smem); }
      for (int u = bid; u < 2 * 16 * 16; u += nb) { int ll = u / 256, r = u % 256; transpose_task(P.w_out + (size_t)ll * 1024 * 1024, P.wt_out + (size_t)ll * 1024 * 1024, 1024, 1024, (r % 16) * 64, (r / 16) * 64, smem); }
      for (int u = rbid; u < 2 * 32 * 16; u += nb) { int ll = u / 512, r = u % 512; transpose_task(P.peer_wq + (size_t)ll * 1024 * 2048, P.wt_q + (size_t)ll * 2048 * 1024, 1024, 2048, (r % 16) * 64, (r / 16) * 64, smem); }
      for (int u = bid; u < 256; u += nb) {
        size_t o = ((size_t)u * 256 + tid) * 8; float f[8];
#pragma unroll
        for (int j = 0; j < 8; ++j) f[j] = P.peer_keys[o + j];
        *(uint4*)(P.keysb + o) = pack8(f);
      }
      for (int u = rbid; u < 2 * 576; u += nb) { int ll = u / 576, r = u % 576; if (r < 512) hm2_task(P, ll, 0, r, smem); else hm2_task(P, ll, 1, r - 512, smem); }
      if (bid == nb - 1) {
        for (int i = tid; i < 1024; i += NTHREADS) {
          int pos = i >> 4, f = i & 15;
          float inv = powf(10000.f, -(float)f / 16.f);
          float ang = (float)pos * inv;
          P.ropetab[i] = cosf(ang); P.ropetab[1024 + i] = sinf(ang);
        }
      }
    } break;
    case PH_PRE1: {
      for (int t = bid; t < 816; t += nb) {
        int i = t * 256 + tid;
        int ll = i / (17 * 6144), rem = i % (17 * 6144), col = rem % 6144;
        float a = P.b_ada[ll * 6144 + col];
#pragma unroll
        for (int ks = 0; ks < 16; ++ks) a += P.modp[((size_t)ll * 16 + ks) * 17 * 6144 + rem];
        P.mod[i] = a;
      }
      for (int u = rbid; u < 2048; u += nb) filt_task(P, u >> 10, (u >> 9) & 1, u & 511, smem);
    } break;
    case PH_PRE2: {
      for (int T = bid * 4 + wave; T < NTOK; T += nb * 4) hmod0_token(P, T, lane);
    } break;
    case PH_L1: {
      const int ntile = (NTOK / 128) * 23;
      bf16_t* Pb = P.Pbuf; float* dtb = P.dtbuf;
      const bf16_t* Ain = P.Ybuf; const bf16_t* Win = P.wt_in + (size_t)l * 2944 * 1024;
      for (int t = bid; t < ntile; t += nb) {
        int tm = t / 23, tn = t % 23;
        gemm_tile32(Ain, 1024, Win, 1024, 1024, tm * 128, tn * 128, smem, [&](int m, int n, f32x4 v) {
          if (n < 2816) { uint2 o; o.x = pack2(v[0], v[1]); o.y = pack2(v[2], v[3]); *(uint2*)(Pb + (size_t)m * PST + n) = o; }
          else if (n < 2824) { *(float4*)(dtb + (size_t)m * 8 + (n - 2816)) = make_float4(v[0], v[1], v[2], v[3]); }
        });
      }
    } break;
    case PH_L2: {
      const int nS = NB * 2 * NCH, nCf = 512 + (l == 0 ? 64 : 0), nPr = 576;
      unsigned* cnt = P.bar + QCNT(l * 3 + 0);
      for (;;) {
        int u = next_task(cnt, &sQ);
        if (u >= nS + nCf + nPr) break;
        if (u < nS) { ssd1m_task(P, l, u / (2 * NCH), (u / NCH) & 1, u % NCH, smem); continue; }
        u -= nS;
        if (u < nCf) { if (u < 512) conf_task(P, l, (u >> 5) * 2048, 2048, (u & 31) * 64, smem); else { int v = u - 512; conf_task(P, l, NLAT + (v >> 2) * 256, 256, (v & 3) * 64, smem); } continue; }
        u -= nCf;
        if (u < 512) prep_task(P, l, true, u >> 5, (u & 31) * 64); else { int v = u - 512; prep_task(P, l, false, v >> 2, (v & 3) * 64); }
      }
    } break;
    case PH_L3: {
      const int nH = 2048 + (l == 0 ? 256 : 0), nA = 2048, nAc = (l == 0 ? 256 : 0), nPf = rep ? 0 : 2048;
      unsigned* cnt = P.bar + QCNT(l * 3 + 1);
      for (;;) {
        int u = next_task(cnt, &sQ);
        if (u >= nH + nA + nAc + nPf) break;
        if (u < nH) { if (u < 2048) hyconv_task(P, l, true, u >> 3, (u & 7) * 256, smem); else hyconv_task(P, l, false, u - 2048, 0, smem); continue; }
        u -= nH;
        if (u < nA) { int b = u >> 7, r = (u >> 2) & 31, c0 = (u & 3) * 16; attn_task<true>(P, l, b, r, c0, wave, lane); continue; }
        u -= nA;
        if (u < nAc) { attn_task<false>(P, l, u >> 4, 0, (u & 15) * 16, wave, lane); continue; }
        u -= nAc;
        ssd_prefix_task(P, u >> 4, u & 15);
      }
    } break;
    case PH_L4: {
      const int nS = (l == 0) ? NB * 2 * NCH : NB * 2 * 32, nHf = 512 + (l == 0 ? 64 : 0);
      unsigned* cnt = P.bar + QCNT(l * 3 + 2);
      for (;;) {
        int u = next_task(cnt, &sQ);
        if (u >= nS + nHf) break;
        if (u < nS) {
          if (l == 0) ssd_task<true>(P, l, u / (2 * NCH), (u / NCH) & 1, u % NCH, smem);
          else ssd_task<true>(P, l, u / 64, (u / 32) & 1, 4 + (u % 32), smem);
          continue;
        }
        u -= nS;
        if (u < 512) hyfin_task(P, l, true, u >> 5, (u & 31) * 64); else { int v = u - 512; hyfin_task(P, l, false, v >> 2, (v & 3) * 64); }
      }
    } break;
    case PH_L5: {
      const int ng = mt_out * 8;
      bf16_t* Yo = P.Pbuf;
      const bf16_t* Ain = P.Ybuf; const bf16_t* Wt = P.wt_out + (size_t)l * 1024 * 1024;
      for (int t = bid; t < ng; t += nb) {
        int tm = t >> 3, tn = t & 7;
        gemm_tile32(Ain, 1024, Wt, 1024, 1024, tm * 128, tn * 128, smem, [&](int m, int n, f32x4 v) {
          uint2 o; o.x = pack2(v[0], v[1]); o.y = pack2(v[2], v[3]); *(uint2*)(Yo + (size_t)m * 1024 + n) = o;
        });
      }
      for (int u = rbid; u < 4096; u += nb) {
        const bool isv = u >= 2048;
        const int e0 = (u & 2047) * 8;
        const float* src = (isv ? P.peer_v : P.peer_u) + (size_t)l * 16384 * 1024 + (size_t)e0 * 1024;
        unsigned char* dstb = (unsigned char*)(isv ? P.tabv : P.tabu);
#pragma unroll
        for (int i = 0; i < 2; ++i) {
          int o = (i * 256 + tid) * 16;
          float4 a = *(const float4*)(src + o), bq = *(const float4*)(src + o + 4), c = *(const float4*)(src + o + 8), d = *(const float4*)(src + o + 12);
          uint4 r;
          r.x = pack4_fp8(a.x * 256.f, a.y * 256.f, a.z * 256.f, a.w * 256.f);
          r.y = pack4_fp8(bq.x * 256.f, bq.y * 256.f, bq.z * 256.f, bq.w * 256.f);
          r.z = pack4_fp8(c.x * 256.f, c.y * 256.f, c.z * 256.f, c.w * 256.f);
          r.w = pack4_fp8(d.x * 256.f, d.y * 256.f, d.z * 256.f, d.w * 256.f);
          *(uint4*)(dstb + (size_t)e0 * 1024 + o) = r;
        }
      }
    } break;
    case PH_L6: {
      if (rep) { for (int T = bid * 4 + wave; T < ntok; T += nb * 4) r1_token(P, l, T, lane, rep); }
      else for (int T = bid * 4 + wave; T < ntok; T += nb * 8) { const int Tb = T + nb * 4; r1_pair(P, l, T, min(Tb, ntok - 1), Tb < ntok, lane); }
    } break;
    case PH_L7: {
      const int ng = mt_out * 16;
      bf16_t* Q = P.qbuf;
      for (int t = bid; t < ng; t += nb) {
        int tm = t >> 4, tn = t & 15;
        gemm_tile32(P.Ybuf, 1024, P.wt_q + (size_t)l * 2048 * 1024, 1024, 1024, tm * 128, tn * 128, smem, [&](int m, int n, f32x4 v) {
          uint2 o; o.x = pack2(v[0], v[1]); o.y = pack2(v[2], v[3]); *(uint2*)(Q + (size_t)m * 2048 + n) = o;
        });
      }
    } break;
    case PH_L8: {
      const int ng = mt_out * 8;
      for (int t = bid; t < ng; t += nb) peer_topk_task(P, l, t >> 3, t & 7, smem);
    } break;
    case PH_L9: {
      float* wl = (float*)smem + wave * 128;
      __syncthreads();
      for (int T0 = bid * 4 + wave; T0 < ntok; T0 += nb * 4) { const int T = __builtin_amdgcn_readfirstlane(T0); peer_token(P, l, T, lane, wl, false); }
    } break;
    case PH_L9W: {
      const size_t n = (size_t)ntok * 128;
      for (size_t i = (size_t)bid * 256 + tid; i < n; i += (size_t)nb * 256) {
        float a = 0.f;
#pragma unroll
        for (int x = 0; x < 8; ++x) a += P.pact[(size_t)x * NTOK * 128 + i];
        P.egate[i] = P.egate[i] * gelu_tanh(a * (1.f / 256.f));
      }
    } break;
    case PH_L9B: {
      int* li = (int*)smem + wave * 1024;
      __syncthreads();
      for (int sl = X.slot; sl < 8; sl += X.nx)
        { const int pw = (ntok + X.nloc * 4 - 1) / (X.nloc * 4); const int tf = __builtin_amdgcn_readfirstlane((X.rank * 4 + wave) * pw); peer_v_phase(P, sl, tf, 1, min(ntok, tf + pw), lane, li); }
    } break;
    case PH_L9C: {
      for (int T0 = bid * 4 + wave; T0 < ntok; T0 += nb * 4) { const int T = __builtin_amdgcn_readfirstlane(T0); ln2_token(P, l, T, lane); }
    } break;
  }
}

#if MULTI_LAUNCH
__global__ void __launch_bounds__(NTHREADS) phase_kernel(Params P, int ph, int l) {
  extern __shared__ __attribute__((aligned(16))) unsigned char smem[];
  __shared__ Params sP;
  if (threadIdx.x == 0) sP = P;
  __syncthreads();
  switch (ph) {
    case 0: run_phase<0>(sP, sX, l, smem); break; case 1: run_phase<1>(sP, sX, l, smem); break; case 2: run_phase<2>(sP, sX, l, smem); break;
    case 3: run_phase<3>(sP, sX, l, smem); break; case 4: run_phase<4>(sP, sX, l, smem); break; case 5: run_phase<5>(sP, sX, l, smem); break;
    case 6: run_phase<6>(sP, sX, l, smem); break; case 7: run_phase<7>(sP, sX, l, smem); break; case 8: run_phase<8>(sP, sX, l, smem); break;
    case 9: run_phase<9>(sP, sX, l, smem); break; case 10: run_phase<10>(sP, sX, l, smem); break; case 11: run_phase<11>(sP, sX, l, smem); break;
  }
}
#else
__global__ void __launch_bounds__(NTHREADS, 3) mega_kernel(Params P) {
  extern __shared__ __attribute__((aligned(16))) unsigned char smem[];
  cg::grid_group grid = cg::this_grid();
  __shared__ uint4 xb_words;
  if (threadIdx.x == 0) xb_words = make_uint4(0u, 0u, 0u, 0u);
  __syncthreads();
  XcdBarrier xb = xcd_barrier_post(P.bar, (volatile LAS unsigned*)&xb_words);
  __shared__ XInfo sX;
  if (threadIdx.x == 0) sX.rank = (int)xb_add(&P.bar[XCD_BAR_WORDS + 64 * xb.x], 1u);
  run_phase<PH_PRE0>(P, sX, 0, smem);
  if (P.bar == nullptr) grid.sync();
  xcd_barrier(xb);
  if (threadIdx.x == 0) {
    int slot = 0, nx = 0, nloc = 1;
    for (unsigned j = 0; j < 16; ++j) {
      const int c = (int)xb_ld(&P.bar[XCD_BAR_WORDS + 64 * j]);
      if (c > 0) { if (j < xb.x) ++slot; ++nx; }
      if (j == xb.x) nloc = c > 0 ? c : 1;
    }
    sX.slot = slot; sX.nx = nx > 0 ? nx : 1; sX.nloc = nloc;
  }
  __syncthreads();
  run_phase<PH_PRE1>(P, sX, 0, smem); xcd_barrier(xb);
  run_phase<PH_PRE2>(P, sX, 0, smem); xcd_barrier(xb);
  {
    constexpr int l = 0;
    run_phase<PH_L1>(P, sX, l, smem); xcd_barrier(xb);
#if defined(REPEAT_PH)
    if (REPEAT_PH == PH_L1) { run_phase<PH_L1>(P, sX, l, smem, true); xcd_barrier(xb); }
#endif
    run_phase<PH_L2>(P, sX, l, smem); xcd_barrier(xb);
#if defined(REPEAT_PH)
    if (REPEAT_PH == PH_L2) { run_phase<PH_L2>(P, sX, l, smem, true); xcd_barrier(xb); }
#endif
    run_phase<PH_L3>(P, sX, l, smem); xcd_barrier(xb);
#if defined(REPEAT_PH)
    if (REPEAT_PH == PH_L3) { run_phase<PH_L3>(P, sX, l, smem, true); xcd_barrier(xb); }
#endif
    run_phase<PH_L4>(P, sX, l, smem); xcd_barrier(xb);
#if defined(REPEAT_PH)
    if (REPEAT_PH == PH_L4) { run_phase<PH_L4>(P, sX, l, smem, true); xcd_barrier(xb); }
#endif
    run_phase<PH_L5>(P, sX, l, smem); xcd_barrier(xb);
#if defined(REPEAT_PH)
    if (REPEAT_PH == PH_L5) { run_phase<PH_L5>(P, sX, l, smem, true); xcd_barrier(xb); }
#endif
    run_phase<PH_L6>(P, sX, l, smem); xcd_barrier(xb);
#if defined(REPEAT_PH)
    if (REPEAT_PH == PH_L6) { run_phase<PH_L6>(P, sX, l, smem, true); xcd_barrier(xb); }
#endif
    run_phase<PH_L7>(P, sX, l, smem); xcd_barrier(xb);
#if defined(REPEAT_PH)
    if (REPEAT_PH == PH_L7) { run_phase<PH_L7>(P, sX, l, smem, true); xcd_barrier(xb); }
#endif
    run_phase<PH_L8>(P, sX, l, smem); xcd_barrier(xb);
#if defined(REPEAT_PH)
    if (REPEAT_PH == PH_L8) { run_phase<PH_L8>(P, sX, l, smem, true); xcd_barrier(xb); }
#endif
    run_phase<PH_L9>(P, sX, l, smem); xcd_barrier(xb);
#if defined(REPEAT_PH)
    if (REPEAT_PH == PH_L9) { run_phase<PH_L9>(P, sX, l, smem, true); xcd_barrier(xb); }
#endif
  }
  {
    constexpr int l = 1;
    run_phase<PH_L1>(P, sX, l, smem); xcd_barrier(xb);
#if defined(REPEAT_PH)
    if (REPEAT_PH == PH_L1) { run_phase<PH_L1>(P, sX, l, smem, true); xcd_barrier(xb); }
#endif
    run_phase<PH_L2>(P, sX, l, smem); xcd_barrier(xb);
#if defined(REPEAT_PH)
    if (REPEAT_PH == PH_L2) { run_phase<PH_L2>(P, sX, l, smem, true); xcd_barrier(xb); }
#endif
    run_phase<PH_L3>(P, sX, l, smem); xcd_barrier(xb);
#if defined(REPEAT_PH)
    if (REPEAT_PH == PH_L3) { run_phase<PH_L3>(P, sX, l, smem, true); xcd_barrier(xb); }
#endif
    run_phase<PH_L4>(P, sX, l, smem); xcd_barrier(xb);
#if defined(REPEAT_PH)
    if (REPEAT_PH == PH_L4) { run_phase<PH_L4>(P, sX, l, smem, true); xcd_barrier(xb); }
#endif
    run_phase<PH_L5>(P, sX, l, smem); xcd_barrier(xb);
#if defined(REPEAT_PH)
    if (REPEAT_PH == PH_L5) { run_phase<PH_L5>(P, sX, l, smem, true); xcd_barrier(xb); }
#endif
    run_phase<PH_L6>(P, sX, l, smem); xcd_barrier(xb);
#if defined(REPEAT_PH)
    if (REPEAT_PH == PH_L6) { run_phase<PH_L6>(P, sX, l, smem, true); xcd_barrier(xb); }
#endif
    run_phase<PH_L7>(P, sX, l, smem); xcd_barrier(xb);
#if defined(REPEAT_PH)
    if (REPEAT_PH == PH_L7) { run_phase<PH_L7>(P, sX, l, smem, true); xcd_barrier(xb); }
#endif
    run_phase<PH_L8>(P, sX, l, smem); xcd_barrier(xb);
#if defined(REPEAT_PH)
    if (REPEAT_PH == PH_L8) { run_phase<PH_L8>(P, sX, l, smem, true); xcd_barrier(xb); }
#endif
    run_phase<PH_L9>(P, sX, l, smem); xcd_barrier(xb);
#if defined(REPEAT_PH)
    if (REPEAT_PH == PH_L9) { run_phase<PH_L9>(P, sX, l, smem, true); xcd_barrier(xb); }
#endif
  }
}
#endif

extern "C" void kernel_launch(void* const* d_in, const int* in_sizes, int n_in, void* d_out, int out_size, void* d_ws, size_t ws_size, hipStream_t stream) {
  Params P{};
  const float** pf = (const float**)&P;
  for (int i = 0; i < 36; ++i) pf[i] = (const float*)d_in[i];
  P.out = (float*)d_out;
  unsigned char* w = (unsigned char*)d_ws;
  size_t off = 0;
  auto take = [&](size_t bytes) { unsigned char* p = w + off; off += (bytes + 255) & ~(size_t)255; return p; };
  P.Pbuf = (bf16_t*)take((size_t)NTOK * PST * 2);
  P.Ybuf = (bf16_t*)take((size_t)NTOK * 1024 * 2);
  P.xc = (float*)take((size_t)4096 * 1024 * 4);
  P.dtbuf = (float*)take((size_t)NTOK * 8 * 4);
  P.wt_in = (bf16_t*)take((size_t)2 * 2944 * 1024 * 2);
  P.wt_out = (bf16_t*)take((size_t)2 * 1024 * 1024 * 2);
  P.wt_q = (bf16_t*)take((size_t)2 * 2048 * 1024 * 2);
  P.keysb = (bf16_t*)take((size_t)2 * 8 * 2 * 128 * 128 * 2);
  P.modp = (float*)take((size_t)2 * 16 * 17 * 6144 * 4);
  P.mod = (float*)take((size_t)3 * 17 * 6144 * 4);
  P.hm2 = (float*)take((size_t)2 * 2 * 2048 * 64 * 4);
  P.gtab = (bf16_t*)take((size_t)2 * (256 * 2 * 4096 + 256 * 2 * 512) * 2);
  P.ropetab = (float*)take(2048 * 4);
  P.bar = (unsigned*)take((XCD_BAR_WORDS + 16 * 64 + 8 * 64) * 4);
  unsigned char* treg = w + off;
  P.krot = (bf16_t*)take((size_t)NLAT * 256 * 2);
  P.vt_lat = (bf16_t*)take((size_t)16 * 256 * 2048 * 2);
  P.vt_ctx = (bf16_t*)take((size_t)16 * 256 * 256 * 2);
  P.sst = (float*)take((size_t)16 * 2 * 4 * NCH * 4096 * 4);
  P.ssumA = (float*)take((size_t)16 * 2 * 4 * NCH * 4);
  const size_t hysz = (size_t)16 * 256 * (2048 + 256) * 2;
  P.uT = (bf16_t*)take(hysz);
  P.x0T = (bf16_t*)take(hysz);
  P.yT = (bf16_t*)take(hysz);
  P.tabu = (bf16_t*)treg;
  P.tabv = (bf16_t*)(treg + (size_t)16384 * 1024);
  P.pout = (bf16_t*)(treg + (size_t)40 * 1024 * 1024);
  P.pact = (float*)P.Pbuf;
  P.qbuf = P.Pbuf;
  P.eidx = (int*)((unsigned char*)P.Pbuf + (size_t)NTOK * 2048 * 2);
  P.egate = (float*)((unsigned char*)P.eidx + (size_t)NTOK * 128 * 4);
  if (off > ws_size || n_in != 36) { fprintf(stderr, "kernel_launch: workspace too small (%zu > %zu) or n_in %d != 36\n", off, ws_size, n_in); return; }

  static int grid = 0;
#if MULTI_LAUNCH
  if (!grid) {
    hipFuncSetAttribute((const void*)phase_kernel, hipFuncAttributeMaxDynamicSharedMemorySize, LDS_BYTES);
    grid = 512;
  }
  hipLaunchKernelGGL(phase_kernel, dim3(grid), dim3(NTHREADS), LDS_BYTES, stream, P, PH_PRE0, 0);
  hipLaunchKernelGGL(phase_kernel, dim3(grid), dim3(NTHREADS), LDS_BYTES, stream, P, PH_PRE1, 0);
  hipLaunchKernelGGL(phase_kernel, dim3(grid), dim3(NTHREADS), LDS_BYTES, stream, P, PH_PRE2, 0);
  for (int l = 0; l < 2; ++l)
    for (int ph = PH_L1; ph <= PH_L9; ++ph) hipLaunchKernelGGL(phase_kernel, dim3(grid), dim3(NTHREADS), LDS_BYTES, stream, P, ph, l);
#else
  if (!grid) {
    int dev = 0, cus = 0, per_cu = 0;
    hipGetDevice(&dev);
    hipDeviceGetAttribute(&cus, hipDeviceAttributeMultiprocessorCount, dev);
    hipFuncSetAttribute((const void*)mega_kernel, hipFuncAttributeMaxDynamicSharedMemorySize, LDS_BYTES);
    hipOccupancyMaxActiveBlocksPerMultiprocessor(&per_cu, (const void*)mega_kernel, NTHREADS, LDS_BYTES);
    if (per_cu < 1) { fprintf(stderr, "kernel_launch: occupancy query returned %d\n", per_cu); per_cu = 1; }
    if (per_cu > 3) per_cu = 3;
    grid = cus * per_cu;
  }
  if (hipMemsetAsync(P.bar, 0, (XCD_BAR_WORDS + 16 * 64 + 8 * 64) * 4, stream) != hipSuccess) { fprintf(stderr, "kernel_launch: memset of barrier words failed\n"); return; }
  void* args[] = {&P};
  hipError_t e = hipLaunchCooperativeKernel((const void*)mega_kernel, dim3(grid), dim3(NTHREADS), args, LDS_BYTES, stream);
  if (e != hipSuccess) fprintf(stderr, "cooperative launch failed: %s (grid %d)\n", hipGetErrorString(e), grid);
#endif
}
```
